# Optimizing an MI355X kernel written in HIP

```python
import math
import jax, jax.numpy as jnp
from jax import lax
import numpy as np

D_MODEL = 2048
BATCH = 2
SEQ = 4096
DEPTH = 2

GRID_W = 64
CTX_LEN = 256
N_MIXERS = 2
S5_GROUP_CH = 16
S5_GROUPS = D_MODEL // S5_GROUP_CH
S5_STATE = 64
S5_DT_MIN = 1e-3
S5_DT_MAX = 1e-1
SGU_CHUNK = 128
SGU_DIM = 2 * D_MODEL
SGU_HEADS = 16
SGU_HEAD_DIM = SGU_DIM // SGU_HEADS
FFN_DIM = 5632
CONV_K = 3
N_MOD = 6
RMS_EPS = 1e-6
LN_EPS = 1e-5

kernel_name = 'hybrid_s5_sgu_convffn_prefix_dit'


def _rmsnorm(x, g):
    x32 = x.astype(jnp.float32)
    y = x32 * lax.rsqrt(jnp.mean(x32 * x32, axis=-1, keepdims=True) + RMS_EPS)
    return (y * g.astype(jnp.float32)).astype(x.dtype)


def _layernorm(x, g, b):
    x32 = x.astype(jnp.float32)
    mu = jnp.mean(x32, axis=-1, keepdims=True)
    xc = x32 - mu
    y = xc * lax.rsqrt(jnp.mean(xc * xc, axis=-1, keepdims=True) + LN_EPS)
    return (y * g.astype(jnp.float32) + b.astype(jnp.float32)).astype(x.dtype)


def _modulate(h, shift, scale):
    return h * (1 + scale) + shift


def _s5_discretize(a_re, a_im, b_re, b_im, log_step):
    a_re = a_re.astype(jnp.float32); a_im = a_im.astype(jnp.float32)
    b_re = b_re.astype(jnp.float32); b_im = b_im.astype(jnp.float32)
    dt = jnp.exp(log_step.astype(jnp.float32))[:, None]
    mag = jnp.exp(a_re * dt)
    lb_re = mag * jnp.cos(a_im * dt)
    lb_im = mag * jnp.sin(a_im * dt)
    den = a_re * a_re + a_im * a_im
    k_re = ((lb_re - 1.0) * a_re + lb_im * a_im) / den
    k_im = (lb_im * a_re - (lb_re - 1.0) * a_im) / den
    bb_re = k_re[..., None] * b_re - k_im[..., None] * b_im
    bb_im = k_re[..., None] * b_im + k_im[..., None] * b_re
    return lb_re, lb_im, bb_re, bb_im


def _lin_rec_combine(e1, e2):
    a1r, a1i, b1r, b1i = e1
    a2r, a2i, b2r, b2i = e2
    return (a1r * a2r - a1i * a2i,
            a1r * a2i + a1i * a2r,
            a2r * b1r - a2i * b1i + b2r,
            a2r * b1i + a2i * b1r + b2i)


def _s5_scan(u, lb_re, lb_im, bb_re, bb_im, s0, reverse):
    x_re = jnp.einsum('blgh,gph->blgp', u, bb_re)
    x_im = jnp.einsum('blgh,gph->blgp', u, bb_im)
    if s0 is not None:
        s0_re, s0_im = s0
        t0 = -1 if reverse else 0
        x_re = x_re.at[:, t0].add(lb_re * s0_re - lb_im * s0_im)
        x_im = x_im.at[:, t0].add(lb_re * s0_im + lb_im * s0_re)
    n = u.shape[1]
    a_re = jnp.broadcast_to(lb_re, (1, n) + lb_re.shape)
    a_im = jnp.broadcast_to(lb_im, (1, n) + lb_im.shape)
    _, _, s_re, s_im = lax.associative_scan(_lin_rec_combine, (a_re, a_im, x_re, x_im), reverse=reverse, axis=1)
    return s_re, s_im


def _s5_readout(s_re, s_im, c_re, c_im):
    return jnp.einsum('blgp,ghp->blgh', s_re, c_re) - jnp.einsum('blgp,ghp->blgh', s_im, c_im)


def _half_glu(y, w_glu, b_glu, w_out, dtype):
    g = jax.nn.gelu(y).astype(dtype)
    return (g * jax.nn.sigmoid(g @ w_glu + b_glu)) @ w_out


def _s5_mixer(h_lat, h_ctx, w_in, a_re, a_im, b_re, b_im, c_re, c_im, log_step, d_skip, w_glu, b_glu, w_out, ctx_out):
    dtype = h_lat.dtype
    def to_groups(h):
        u = (h @ w_in).astype(jnp.float32)
        return u.reshape(u.shape[0], u.shape[1], S5_GROUPS, S5_GROUP_CH)
    u_lat = to_groups(h_lat)
    u_ctx = to_groups(h_ctx)
    d_g = d_skip.astype(jnp.float32).reshape(S5_GROUPS, S5_GROUP_CH)
    y_lat = d_g * u_lat
    y_ctx = d_g * u_ctx if ctx_out else None
    for d, reverse in enumerate((False, True)):
        c_r = c_re[d].astype(jnp.float32)
        c_i = c_im[d].astype(jnp.float32)
        lb_re, lb_im, bb_re, bb_im = _s5_discretize(a_re[d], a_im[d], b_re[d], b_im[d], log_step[d])
        cs_re, cs_im = _s5_scan(u_ctx, lb_re, lb_im, bb_re, bb_im, None, reverse)
        t_end = 0 if reverse else -1
        ls_re, ls_im = _s5_scan(u_lat, lb_re, lb_im, bb_re, bb_im, (cs_re[:, t_end], cs_im[:, t_end]), reverse)
        y_lat = y_lat + _s5_readout(ls_re, ls_im, c_r, c_i)
        if ctx_out:
            y_ctx = y_ctx + _s5_readout(cs_re, cs_im, c_r, c_i)
    bsz, n = h_lat.shape[0], h_lat.shape[1]
    out_lat = _half_glu(y_lat.reshape(bsz, n, D_MODEL), w_glu, b_glu, w_out, dtype)
    out_ctx = None
    if ctx_out:
        out_ctx = _half_glu(y_ctx.reshape(bsz, h_ctx.shape[1], D_MODEL), w_glu, b_glu, w_out, dtype)
    return out_lat, out_ctx


def _sgu_mixer(h, w_in, ln_g, ln_b, w_s, b_s, w_out):
    bsz, n, _ = h.shape
    z = jax.nn.gelu(h @ w_in)
    u, v = jnp.split(z, 2, axis=-1)
    v = _layernorm(v, ln_g, ln_b).reshape(bsz, n // SGU_CHUNK, SGU_CHUNK, SGU_HEADS, SGU_HEAD_DIM)
    sv = jnp.einsum('gqk,bnkgc->bnqgc', w_s, v) + b_s.T[:, :, None]
    return (u * sv.reshape(bsz, n, SGU_DIM)) @ w_out


def _dwconv3x3(z, w, b):
    r, wd = z.shape[1], z.shape[2]
    zp = jnp.pad(z, ((0, 0), (1, 1), (1, 1), (0, 0)))
    w = w.astype(z.dtype)
    out = b.astype(z.dtype) + zp[:, 1:1 + r, 1:1 + wd] * w[1, 1]
    for di in range(CONV_K):
        for dj in range(CONV_K):
            if di == 1 and dj == 1:
                continue
            out = out + zp[:, di:di + r, dj:dj + wd] * w[di, dj]
    return out


def _conv_ffn(h, rows, cols, w_up, conv_w, conv_b, w_down):
    bsz = h.shape[0]
    z = h @ w_up
    ch = z.shape[-1]
    z = _dwconv3x3(z.reshape(bsz, rows, cols, ch), conv_w, conv_b).reshape(bsz, rows * cols, ch)
    gate, val = jnp.split(z, 2, axis=-1)
    return (jax.nn.silu(gate) * val) @ w_down


def setup_inputs(seed: int = 0) -> dict:
    key = jax.random.key(seed)
    ks = iter(jax.random.split(key, 64))
    f32 = jnp.float32
    def nrm(shape, s):
        return jax.random.normal(next(ks), shape, f32) * s
    D, G, P, H = D_MODEL, S5_GROUPS, S5_STATE, S5_GROUP_CH
    F2 = 2 * FFN_DIM
    n_a = len(range(0, DEPTH, N_MIXERS))
    n_b = len(range(1, DEPTH, N_MIXERS))
    n_idx = jnp.arange(P, dtype=f32)
    return {
        'x': nrm((BATCH, SEQ, D), 1.0),
        'c': nrm((BATCH, D), 1.0),
        'ctx': nrm((BATCH, CTX_LEN, D), 1.0),
        'c_ctx': nrm((D,), 1.0),
        'mix_norm_g': 1.0 + nrm((DEPTH, D), 0.02),
        'ffn_norm_g': 1.0 + nrm((DEPTH, D), 0.02),
        'w_mod': nrm((DEPTH, D, N_MOD * D), 0.5 * D ** -0.5),
        'b_mod': nrm((DEPTH, N_MOD * D), 0.01),
        'ffn_w_up': nrm((DEPTH, D, F2), D ** -0.5),
        'ffn_conv_w': nrm((DEPTH, CONV_K, CONV_K, F2), 1.0 / CONV_K),
        'ffn_conv_b': nrm((DEPTH, F2), 0.01),
        'ffn_w_down': nrm((DEPTH, FFN_DIM, D), FFN_DIM ** -0.5),
        's5_w_in': nrm((n_a, D, D), D ** -0.5),
        's5_a_re': -0.5 * jnp.exp(nrm((n_a, 2, G, P), 0.02)),
        's5_a_im': math.pi * n_idx + nrm((n_a, 2, G, P), 0.01),
        's5_b_re': nrm((n_a, 2, G, P, H), (2 * H) ** -0.5),
        's5_b_im': nrm((n_a, 2, G, P, H), (2 * H) ** -0.5),
        's5_c_re': nrm((n_a, 2, G, H, P), P ** -0.5),
        's5_c_im': nrm((n_a, 2, G, H, P), P ** -0.5),
        's5_log_step': jax.random.uniform(next(ks), (n_a, 2, G), f32, math.log(S5_DT_MIN), math.log(S5_DT_MAX)),
        's5_d': nrm((n_a, D), 1.0),
        's5_w_glu': nrm((n_a, D, D), D ** -0.5),
        's5_b_glu': nrm((n_a, D), 0.01),
        's5_w_out': nrm((n_a, D, D), D ** -0.5),
        'sgu_w_in': nrm((n_b, D, 2 * SGU_DIM), D ** -0.5),
        'sgu_ln_g': 1.0 + nrm((n_b, SGU_DIM), 0.02),
        'sgu_ln_b': nrm((n_b, SGU_DIM), 0.01),
        'sgu_w_s': nrm((n_b, SGU_HEADS, SGU_CHUNK, SGU_CHUNK), SGU_CHUNK ** -0.5),
        'sgu_b_s': 1.0 + nrm((n_b, SGU_HEADS, SGU_CHUNK), 0.02),
        'sgu_w_out': nrm((n_b, SGU_DIM, D), SGU_DIM ** -0.5),
        'final_norm_g': 1.0 + nrm((D,), 0.02),
    }


def reference(x, c, ctx, c_ctx, mix_norm_g, ffn_norm_g, w_mod, b_mod, ffn_w_up, ffn_conv_w, ffn_conv_b, ffn_w_down,
              s5_w_in, s5_a_re, s5_a_im, s5_b_re, s5_b_im, s5_c_re, s5_c_im, s5_log_step, s5_d, s5_w_glu, s5_b_glu, s5_w_out,
              sgu_w_in, sgu_ln_g, sgu_ln_b, sgu_w_s, sgu_b_s, sgu_w_out, final_norm_g):
    n_lat = x.shape[1]
    rows = n_lat // GRID_W
    n_ctx = ctx.shape[1]
    ctx_needed_after = [any(j % N_MIXERS == 0 for j in range(i + 1, DEPTH)) for i in range(DEPTH)]
    s = ctx
    for i in range(DEPTH):
        keep_ctx = ctx_needed_after[i]
        is_s5 = i % N_MIXERS == 0
        k = i // N_MIXERS
        m_lat = jnp.split((jax.nn.silu(c) @ w_mod[i] + b_mod[i])[:, None, :], N_MOD, axis=-1)
        hl = _modulate(_rmsnorm(x, mix_norm_g[i]), m_lat[0], m_lat[1])
        if is_s5 or keep_ctx:
            m_ctx = jnp.split(jax.nn.silu(c_ctx) @ w_mod[i] + b_mod[i], N_MOD, axis=-1)
            hc = _modulate(_rmsnorm(s, mix_norm_g[i]), m_ctx[0], m_ctx[1])
        if is_s5:
            ml, mc = _s5_mixer(hl, hc, s5_w_in[k], s5_a_re[k], s5_a_im[k], s5_b_re[k], s5_b_im[k], s5_c_re[k], s5_c_im[k],
                               s5_log_step[k], s5_d[k], s5_w_glu[k], s5_b_glu[k], s5_w_out[k], keep_ctx)
        else:
            ml = _sgu_mixer(hl, sgu_w_in[k], sgu_ln_g[k], sgu_ln_b[k], sgu_w_s[k], sgu_b_s[k], sgu_w_out[k])
            mc = _sgu_mixer(hc, sgu_w_in[k], sgu_ln_g[k], sgu_ln_b[k], sgu_w_s[k], sgu_b_s[k], sgu_w_out[k]) if keep_ctx else None
        x = x + m_lat[2] * ml
        hl = _modulate(_rmsnorm(x, ffn_norm_g[i]), m_lat[3], m_lat[4])
        x = x + m_lat[5] * _conv_ffn(hl, rows, GRID_W, ffn_w_up[i], ffn_conv_w[i], ffn_conv_b[i], ffn_w_down[i])
        if keep_ctx:
            s = s + m_ctx[2] * mc
            hc = _modulate(_rmsnorm(s, ffn_norm_g[i]), m_ctx[3], m_ctx[4])
            s = s + m_ctx[5] * _conv_ffn(hc, 1, n_ctx, ffn_w_up[i], ffn_conv_w[i], ffn_conv_b[i], ffn_w_down[i])
    return _rmsnorm(x, final_norm_g)
```

```cpp
#include <hip/hip_runtime.h>
#include <hip/hip_cooperative_groups.h>
#include <cstdio>
#include <cstdint>
namespace cg = cooperative_groups;

#define LAS __attribute__((address_space(3)))
typedef unsigned short bf16_t;
typedef short bf16x8 __attribute__((ext_vector_type(8)));
typedef float f32x2 __attribute__((ext_vector_type(2)));
typedef float f32x4 __attribute__((ext_vector_type(4)));
typedef float f32x16 __attribute__((ext_vector_type(16)));
typedef unsigned u32x2 __attribute__((ext_vector_type(2)));
typedef unsigned u32x4 __attribute__((ext_vector_type(4)));
typedef __bf16 bf16x2v __attribute__((ext_vector_type(2)));

constexpr int D = 2048, NB = 2, SEQ = 4096, CTXL = 256, M = NB * SEQ, LT = SEQ + CTXL, MU = NB * LT;
constexpr int NG = 128, NP = 64, NH = 16, TC = 34, NCOL = 256;
constexpr int F2 = 11264, FF = 5632, SD = 4096, SD2 = 8192, D6 = 12288;
constexpr int NTHREADS = 512, NWAVES = 8;
constexpr int LDS_BYTES = 147456;

constexpr size_t MiB = 1u << 20;
constexpr size_t WS_MOD = 0;
constexpr size_t WS_LAM = 512 * 1024;
constexpr size_t WS_LAMT = 768 * 1024;
constexpr size_t WS_BCAT = 1 * MiB;
constexpr size_t WS_CCAT = 2 * MiB;
constexpr size_t WS_LNST = 3 * MiB;
constexpr size_t WS_W = 16 * MiB;
constexpr size_t WS_WIN = WS_W, WS_WGLU = WS_WIN + 8 * MiB, WS_WOUT = WS_WGLU + 8 * MiB;
constexpr size_t WS_UP0 = WS_WOUT + 8 * MiB, WS_UP1 = WS_UP0 + 44 * MiB;
constexpr size_t WS_DN0 = WS_UP1 + 44 * MiB, WS_DN1 = WS_DN0 + 22 * MiB;
constexpr size_t WS_SIN_W = WS_DN1 + 22 * MiB, WS_SOUT_W = WS_SIN_W + 32 * MiB;
constexpr size_t WS_X = WS_SOUT_W + 16 * MiB;
constexpr size_t WS_A0 = WS_X + 64 * MiB;
constexpr size_t WS_G = WS_A0 + 34 * MiB;
constexpr size_t WS_A2 = WS_G + 32 * MiB;
constexpr size_t WS_BIG1 = WS_A2 + 32 * MiB;
constexpr size_t WS_U = WS_BIG1;
constexpr size_t WS_YF = WS_BIG1 + 68 * MiB;
constexpr size_t WS_Z = WS_BIG1;
constexpr size_t WS_ZS = WS_BIG1;
constexpr size_t WS_BIG2 = WS_BIG1 + 176 * MiB;
constexpr size_t WS_YR = WS_BIG2;
constexpr size_t WS_E = WS_BIG2 + 64 * MiB;
constexpr size_t WS_SI = WS_BIG2 + 96 * MiB;
constexpr size_t WS_A3 = WS_BIG2;
constexpr size_t WS_GT = WS_BIG2;
constexpr size_t WS_END = WS_BIG2 + 128 * MiB;

struct Args { const float* in[31]; float* out; unsigned char* ws; int ph_lo, ph_hi; };
typedef const Args __attribute__((address_space(4)))* CArgsP;
__device__ __forceinline__ CArgsP get_args() { CArgsP p = (CArgsP)__builtin_amdgcn_kernarg_segment_ptr(); asm volatile("" : "+s"(p)); return p; }

__device__ __forceinline__ int launder_i(int v) { asm volatile("" : "+v"(v)); return v; }
__device__ __forceinline__ int tid_opaque() { int t = threadIdx.x; asm volatile("" : "+v"(t)); return t; }
__device__ __forceinline__ unsigned pk2(float lo, float hi) { f32x2 v = {lo, hi}; bf16x2v r = __builtin_convertvector(v, bf16x2v); return __builtin_bit_cast(unsigned, r); }
__device__ __forceinline__ bf16_t f2bf(float f) { return (bf16_t)(pk2(f, 0.f) & 0xffffu); }
__device__ __forceinline__ float bf_lo(unsigned w) { return __builtin_bit_cast(float, w << 16); }
__device__ __forceinline__ float bf_hi(unsigned w) { return __builtin_bit_cast(float, w & 0xffff0000u); }
__device__ __forceinline__ float shfl_xor_l(float v, int m, int lane) { return __builtin_bit_cast(float, __builtin_amdgcn_ds_bpermute((lane ^ m) << 2, __builtin_bit_cast(int, v))); }
__device__ __forceinline__ float wave_sum(float v, int lane) {
#pragma unroll
    for (int o = 1; o < 64; o <<= 1) v += shfl_xor_l(v, o, lane);
    return v;
}
__device__ __forceinline__ float sigmoid_f(float x) { return __builtin_amdgcn_rcpf(1.f + __expf(-x)); }
__device__ __forceinline__ float silu_f(float x) { return x * sigmoid_f(x); }
__device__ __forceinline__ float gelu_tanh_f(float x) { const float t = 1.5957691216f * (x + 0.044715f * x * x * x); return x * sigmoid_f(t); }

namespace pg8 {
constexpr int BM = 256, BK = 64, HALF = 128, HTB = HALF * BK * 2, STAGE_BYTES = 8 * HTB, NXCD = 8, WGM = 8;
__device__ __forceinline__ int lds_byte(int r, int c) { const int st = (r >> 4) * 2 + (c >> 5), rr = r & 15, cc = c & 31, ob = rr * 64 + cc * 2; return st * 1024 + (ob ^ (((ob >> 9) & 1) << 5)); }
__device__ __forceinline__ void stage_rc(int b, int& R, int& C) { const int st = b / 1024, sb = b % 1024, swz = sb ^ (((sb >> 9) & 1) << 5); R = (st >> 1) * 16 + swz / 64; C = (st & 1) * 32 + (swz % 64) / 2; }
__device__ __forceinline__ int perm32(int rho) { const int n = rho >> 4, i = rho & 15; return 8 * (i >> 2) + 4 * n + (i & 3); }
struct Unit { int pm, pn; };
struct Gemm { const bf16_t* A; const bf16_t* Bt; int M, N, K; };
struct StaticOrder {
    int nM, nN, nwg, G, c;
    __device__ void init(int M_, int N_, int G_, int c_) { nM = M_ / BM; nN = N_ / BM; nwg = nM * nN; G = G_; c = c_; }
    __device__ bool next(int i, Unit& u) const {
        const long L = (long)i * G + c; if (L >= nwg) return false;
        int wgid = (int)L; { const int q = nwg / NXCD, r = nwg % NXCD, xcd = wgid % NXCD, off = wgid / NXCD; wgid = (xcd < r ? xcd * (q + 1) : r * (q + 1) + (xcd - r) * q) + off; }
        const int nig = WGM * nN, gid = wgid / nig, fm = gid * WGM, gsz = (nM - fm) < WGM ? (nM - fm) : WGM;
        u.pm = fm + ((wgid % nig) % gsz); u.pn = (wgid % nig) / gsz; return true;
    }
};

template <class Epi, bool ALIGN_EPI, bool SP2>
__device__ __forceinline__ void gemm_phase(LAS unsigned char* lds, const Gemm g, const StaticOrder& S, const Epi& E) {
    const int tid = tid_opaque(), wid = __builtin_amdgcn_readfirstlane(tid >> 6), lane = tid & 63, wr = wid >> 2, wc = wid & 3, fr = lane & 15, fq = lane >> 4;
    const int K = g.K, nt = K / BK;
    unsigned voffA[2], voffB[2];
#pragma unroll
    for (int i = 0; i < 2; ++i) { int R, C; stage_rc(tid * 16 + i * 8192, R, C); const int Rb = Epi::PERM ? ((R & ~31) + perm32(R & 31)) : R;
        voffA[i] = (unsigned)(R * K + C) * 2u; voffB[i] = (unsigned)(Rb * K + C) * 2u; }
    const size_t kstep = (size_t)(BK * 2);
    const size_t hstep = (size_t)HALF * K * 2;
    const size_t tstep = 2 * hstep;
    const unsigned ldsw = (unsigned)wid * 1024u;
    const int aoff = lds_byte(wr * 64 + fr, fq * 8), boff = lds_byte(wc * 32 + fr, fq * 8);
#define PG8_SA(b, h) (((b) * 2 + (h)) * HTB)
#define PG8_SB(b, h) ((4 + (b) * 2 + (h)) * HTB)
#define PG8_STAGE(bufoff, gbase, voff) do { _Pragma("unroll") for (int _i = 0; _i < 2; ++_i) \
        __builtin_amdgcn_global_load_lds((const unsigned*)((const char*)(gbase) + (voff)[_i]), (LAS unsigned*)(lds + (bufoff) + ldsw + _i * 8192), 16, 0, 0); } while (0)
#define PG8_LDA(dst, b, h) do { _Pragma("unroll") for (int m = 0; m < 4; ++m) _Pragma("unroll") for (int k = 0; k < 2; ++k) dst[m][k] = *(const LAS bf16x8*)(lds + PG8_SA(b, h) + aoff + m * 2048 + k * 1024); } while (0)
#define PG8_LDB(dst, b, h) do { _Pragma("unroll") for (int n = 0; n < 2; ++n) _Pragma("unroll") for (int k = 0; k < 2; ++k) dst[n][k] = *(const LAS bf16x8*)(lds + PG8_SB(b, h) + boff + n * 2048 + k * 1024); } while (0)
#define PG8_MMA(ai, bj, At, Bt) do { __builtin_amdgcn_s_setprio(1); _Pragma("unroll") for (int m = 0; m < 4; ++m) _Pragma("unroll") for (int n = 0; n < 2; ++n) _Pragma("unroll") for (int k = 0; k < 2; ++k) \
        acc[ai][bj][m][n] = __builtin_amdgcn_mfma_f32_16x16x32_bf16(Bt[n][k], At[m][k], acc[ai][bj][m][n], 0, 0, 0); __builtin_amdgcn_s_setprio(0); } while (0)
#define PG8_WAIT_V(n) asm volatile("s_waitcnt vmcnt(" #n ")" ::: "memory")
#define PG8_WAIT_L(n) asm volatile("s_waitcnt lgkmcnt(" #n ")" ::: "memory")
#define PG8_BAR __builtin_amdgcn_s_barrier()
#define PG8_SCHED __builtin_amdgcn_sched_barrier(0)
    Unit cur, nxt; int ui = 0;
    if (!S.next(0, cur)) return;
    f32x4 acc[2][2][4][2];
#pragma unroll
    for (int a = 0; a < 2; ++a)
#pragma unroll
        for (int b = 0; b < 2; ++b)
#pragma unroll
            for (int m = 0; m < 4; ++m)
#pragma unroll
                for (int n = 0; n < 2; ++n) acc[a][b][m][n] = (f32x4){0.f, 0.f, 0.f, 0.f};
    bf16x8 At[4][2], B0[2][2], B1[2][2];
    const char* cA = (const char*)g.A + (size_t)cur.pm * tstep; const char* cB = (const char*)g.Bt + (size_t)cur.pn * tstep;
    if constexpr (SP2) {
        PG8_STAGE(PG8_SB(0, 0), cB, voffB); PG8_STAGE(PG8_SB(0, 1), cB + hstep, voffB); PG8_STAGE(PG8_SA(0, 0), cA, voffA); PG8_STAGE(PG8_SA(0, 1), cA + hstep, voffA);
        if (wr == 1) PG8_BAR;
        PG8_WAIT_V(2); PG8_BAR;
        PG8_STAGE(PG8_SB(1, 0), cB + kstep, voffB); PG8_STAGE(PG8_SA(1, 0), cA + kstep, voffA); PG8_STAGE(PG8_SB(1, 1), cB + hstep + kstep, voffB);
        PG8_WAIT_V(6); PG8_BAR;
    } else {
        PG8_STAGE(PG8_SB(0, 0), cB, voffB); PG8_STAGE(PG8_SA(0, 0), cA, voffA); PG8_STAGE(PG8_SB(0, 1), cB + hstep, voffB); PG8_STAGE(PG8_SA(0, 1), cA + hstep, voffA);
        if (wr == 1) PG8_BAR;
        PG8_WAIT_V(4); PG8_BAR;
        PG8_STAGE(PG8_SB(1, 0), cB + kstep, voffB); PG8_STAGE(PG8_SA(1, 0), cA + kstep, voffA); PG8_STAGE(PG8_SB(1, 1), cB + hstep + kstep, voffB);
        PG8_WAIT_V(6); PG8_BAR;
    }
    for (;;) {
        const bool has_next = S.next(ui + 1, nxt);
        const char* nA = has_next ? (const char*)g.A + (size_t)nxt.pm * tstep : cA; const char* nB = has_next ? (const char*)g.Bt + (size_t)nxt.pn * tstep : cB;
        for (int t = 0; t < nt; t += 2) {
            const bool last = (t == nt - 2);
            const char* a1 = cA + (size_t)(t + 1) * kstep;
            const char* a2 = last ? nA : cA + (size_t)(t + 2) * kstep; const char* b2 = last ? nB : cB + (size_t)(t + 2) * kstep;
            const char* a3 = a2 + kstep; const char* b3 = b2 + kstep;
            if constexpr (SP2) {
            PG8_LDB(B0, 0, 0); PG8_LDB(B1, 0, 1); PG8_SCHED; PG8_LDA(At, 0, 0); PG8_STAGE(PG8_SA(1, 1), a1 + hstep, voffA);
            PG8_WAIT_V(8); PG8_WAIT_L(0); PG8_BAR; PG8_MMA(0, 0, At, B0); PG8_MMA(0, 1, At, B1); PG8_BAR; PG8_SCHED;
            PG8_LDA(At, 0, 1); PG8_STAGE(PG8_SB(0, 0), b2, voffB); PG8_STAGE(PG8_SB(0, 1), b2 + hstep, voffB); PG8_STAGE(PG8_SA(0, 0), a2, voffA);
            PG8_WAIT_V(8); PG8_WAIT_L(0); PG8_BAR; PG8_MMA(1, 0, At, B0); PG8_MMA(1, 1, At, B1); PG8_BAR; PG8_SCHED;
            PG8_LDB(B0, 1, 0); PG8_LDB(B1, 1, 1); PG8_SCHED; PG8_LDA(At, 1, 0); PG8_STAGE(PG8_SA(0, 1), a2 + hstep, voffA);
            PG8_WAIT_V(8); PG8_WAIT_L(0); PG8_BAR; PG8_MMA(0, 0, At, B0); PG8_MMA(0, 1, At, B1); PG8_BAR; PG8_SCHED;
            PG8_LDA(At, 1, 1); PG8_STAGE(PG8_SB(1, 0), b3, voffB); PG8_STAGE(PG8_SB(1, 1), b3 + hstep, voffB); PG8_STAGE(PG8_SA(1, 0), a3, voffA);
            PG8_WAIT_V(8); PG8_WAIT_L(0); PG8_BAR; PG8_MMA(1, 0, At, B0); PG8_MMA(1, 1, At, B1); PG8_BAR; PG8_SCHED;
            } else {
            PG8_LDB(B0, 0, 0); PG8_SCHED; PG8_LDA(At, 0, 0); PG8_STAGE(PG8_SA(1, 1), a1 + hstep, voffA);
            PG8_WAIT_L(8); PG8_BAR; PG8_WAIT_L(0); PG8_MMA(0, 0, At, B0); PG8_BAR; PG8_SCHED;
            PG8_LDB(B1, 0, 1); PG8_STAGE(PG8_SB(0, 0), b2, voffB);
            PG8_BAR; PG8_WAIT_L(0); PG8_MMA(0, 1, At, B1); PG8_BAR;
            PG8_LDA(At, 0, 1); PG8_STAGE(PG8_SA(0, 0), a2, voffA);
            PG8_BAR; PG8_WAIT_L(0); PG8_MMA(1, 0, At, B0); PG8_BAR; PG8_SCHED;
            PG8_STAGE(PG8_SB(0, 1), b2 + hstep, voffB);
            PG8_WAIT_V(6); PG8_BAR; PG8_MMA(1, 1, At, B1); PG8_BAR;
            PG8_LDB(B0, 1, 0); PG8_SCHED; PG8_LDA(At, 1, 0); PG8_STAGE(PG8_SA(0, 1), a2 + hstep, voffA);
            PG8_WAIT_L(8); PG8_BAR; PG8_WAIT_L(0); PG8_MMA(0, 0, At, B0); PG8_BAR; PG8_SCHED;
            PG8_LDB(B1, 1, 1); PG8_STAGE(PG8_SB(1, 0), b3, voffB);
            PG8_BAR; PG8_WAIT_L(0); PG8_MMA(0, 1, At, B1); PG8_BAR;
            PG8_LDA(At, 1, 1); PG8_STAGE(PG8_SA(1, 0), a3, voffA);
            PG8_BAR; PG8_WAIT_L(0); PG8_MMA(1, 0, At, B0); PG8_BAR; PG8_SCHED;
            PG8_STAGE(PG8_SB(1, 1), b3 + hstep, voffB);
            PG8_WAIT_V(6); PG8_BAR; PG8_MMA(1, 1, At, B1); PG8_BAR;
            }
        }
        if constexpr (ALIGN_EPI) { if (wr == 0) PG8_BAR; }
        E(acc, cur, wr, wc, fr, fq);
        if (!has_next) break;
#pragma unroll
        for (int a = 0; a < 2; ++a)
#pragma unroll
            for (int b = 0; b < 2; ++b)
#pragma unroll
                for (int m = 0; m < 4; ++m)
#pragma unroll
                    for (int n = 0; n < 2; ++n) acc[a][b][m][n] = (f32x4){0.f, 0.f, 0.f, 0.f};
        cur = nxt; cA = nA; cB = nB; ++ui;
        if constexpr (ALIGN_EPI) { if (wr == 1) PG8_BAR; }
    }
    PG8_WAIT_V(0);
    if constexpr (!ALIGN_EPI) { if (wr == 0) PG8_BAR; }
    PG8_BAR;
#undef PG8_SA
#undef PG8_SB
#undef PG8_STAGE
#undef PG8_LDA
#undef PG8_LDB
#undef PG8_MMA
#undef PG8_WAIT_V
#undef PG8_WAIT_L
#undef PG8_BAR
#undef PG8_SCHED
}

typedef f32x4 AccT[2][2][4][2];
struct EpiF32 {
    static constexpr bool PERM = false;
    float* C; int ldc;
    __device__ __forceinline__ void operator()(const AccT& acc, const Unit& u, int wr, int wc, int fr, int fq) const {
        const int row0 = u.pm * BM + wr * 64 + fr, col0 = u.pn * BM + wc * 32 + 4 * fq;
#pragma unroll
        for (int ai = 0; ai < 2; ++ai)
#pragma unroll
            for (int m = 0; m < 4; ++m) { float* rowp = C + (size_t)(row0 + ai * HALF + m * 16) * ldc + col0;
#pragma unroll
                for (int bj = 0; bj < 2; ++bj)
#pragma unroll
                    for (int n = 0; n < 2; ++n) *(f32x4*)(rowp + bj * HALF + n * 16) = acc[ai][bj][m][n]; }
    }
};
struct EpiResid {
    static constexpr bool PERM = false;
    const float* base; float* out; const float* gate0;
    __device__ __forceinline__ void operator()(const AccT& acc, const Unit& u, int wr, int wc, int fr, int fq) const {
        const int row0 = u.pm * BM + wr * 64 + fr, col0 = u.pn * BM + wc * 32 + 4 * fq;
        const float* gate = gate0 + (u.pm >> 4) * D6;
        f32x4 gv[2][2];
#pragma unroll
        for (int bj = 0; bj < 2; ++bj)
#pragma unroll
            for (int n = 0; n < 2; ++n) gv[bj][n] = *(const f32x4*)(gate + col0 + bj * HALF + n * 16);
#pragma unroll
        for (int ai = 0; ai < 2; ++ai)
#pragma unroll
            for (int m = 0; m < 4; ++m) { const size_t off = (size_t)(row0 + ai * HALF + m * 16) * D + col0;
#pragma unroll
                for (int bj = 0; bj < 2; ++bj)
#pragma unroll
                    for (int n = 0; n < 2; ++n) { const f32x4 bs = *(const f32x4*)(base + off + bj * HALF + n * 16); *(f32x4*)(out + off + bj * HALF + n * 16) = bs + gv[bj][n] * acc[ai][bj][m][n]; }
                asm volatile("" ::: "memory"); }
    }
};
template <int ACT> struct EpiBf16 {
    static constexpr bool PERM = true;
    bf16_t* O; int ldc; float* stats; int stat_pn0;
    __device__ __forceinline__ void operator()(const AccT& acc, const Unit& u, int wr, int wc, int fr, int fq) const {
        const int row0 = u.pm * BM + wr * 64 + fr, col0 = u.pn * BM + wc * 32 + 8 * fq;
        const bool do_stats = (ACT == 1) && (u.pn >= stat_pn0);
#pragma unroll
        for (int ai = 0; ai < 2; ++ai)
#pragma unroll
            for (int m = 0; m < 4; ++m) { const int row = row0 + ai * HALF + m * 16; bf16_t* rowp = O + (size_t)row * ldc + col0; float s = 0.f, q = 0.f;
#pragma unroll
                for (int bj = 0; bj < 2; ++bj) { f32x4 v0 = acc[ai][bj][m][0], v1 = acc[ai][bj][m][1];
                    if (ACT == 1) {
#pragma unroll
                        for (int j = 0; j < 4; ++j) { v0[j] = gelu_tanh_f(v0[j]); v1[j] = gelu_tanh_f(v1[j]); s += v0[j] + v1[j]; q += v0[j] * v0[j] + v1[j] * v1[j]; } }
                    u32x4 w; w.x = pk2(v0[0], v0[1]); w.y = pk2(v0[2], v0[3]); w.z = pk2(v1[0], v1[1]); w.w = pk2(v1[2], v1[3]);
                    *(u32x4*)(rowp + bj * HALF) = w; }
                if (ACT == 1) { if (do_stats) { const int ln = fr + 16 * fq; s += shfl_xor_l(s, 16, ln); s += shfl_xor_l(s, 32, ln); q += shfl_xor_l(q, 16, ln); q += shfl_xor_l(q, 32, ln);
                    if (fq == 0) { atomicAdd(stats + 2 * row, s); atomicAdd(stats + 2 * row + 1, q); } } } }
    }
};
struct EpiGlu {
    static constexpr bool PERM = true;
    const bf16_t* Gm; bf16_t* O; const float* bias;
    __device__ __forceinline__ void operator()(const AccT& acc, const Unit& u, int wr, int wc, int fr, int fq) const {
        const int row0 = u.pm * BM + wr * 64 + fr, col0 = u.pn * BM + wc * 32 + 8 * fq;
        f32x4 bv[2][2];
#pragma unroll
        for (int bj = 0; bj < 2; ++bj)
#pragma unroll
            for (int n = 0; n < 2; ++n) bv[bj][n] = *(const f32x4*)(bias + col0 + bj * HALF + 4 * n);
#pragma unroll
        for (int ai = 0; ai < 2; ++ai)
#pragma unroll
            for (int m = 0; m < 4; ++m) { const size_t off = (size_t)(row0 + ai * HALF + m * 16) * D + col0;
#pragma unroll
                for (int bj = 0; bj < 2; ++bj) { const f32x4 v0 = acc[ai][bj][m][0] + bv[bj][0], v1 = acc[ai][bj][m][1] + bv[bj][1];
                    const u32x4 gw = *(const u32x4*)(Gm + off + bj * HALF);
                    u32x4 w;
                    w.x = pk2(bf_lo(gw.x) * sigmoid_f(v0[0]), bf_hi(gw.x) * sigmoid_f(v0[1]));
                    w.y = pk2(bf_lo(gw.y) * sigmoid_f(v0[2]), bf_hi(gw.y) * sigmoid_f(v0[3]));
                    w.z = pk2(bf_lo(gw.z) * sigmoid_f(v1[0]), bf_hi(gw.z) * sigmoid_f(v1[1]));
                    w.w = pk2(bf_lo(gw.w) * sigmoid_f(v1[2]), bf_hi(gw.w) * sigmoid_f(v1[3]));
                    *(u32x4*)(O + off + bj * HALF) = w; } }
    }
};
}

__device__ __forceinline__ void p0_gemv_task(CArgsP a, LAS unsigned char* lds, int tk) {
    const int t = tid_opaque();
    LAS float* sv = (LAS float*)lds;
    LAS float* red = (LAS float*)(lds + 24576);
    const int l = tk / 192, n0 = (tk % 192) * 64;
    const float* c = a->in[1]; const float* cc = a->in[3];
    for (int i = t; i < 3 * D; i += NTHREADS) { const float x = i < 2 * D ? c[i] : cc[i - 2 * D]; sv[i] = silu_f(x); }
    __syncthreads();
    const int cq = t & 15, ks = t >> 4;
    const float* W = a->in[6] + (size_t)l * D * D6 + n0 + 4 * cq;
    f32x4 acc0 = {0.f, 0.f, 0.f, 0.f}, acc1 = acc0, acc2 = acc0;
#pragma unroll 8
    for (int kk = 0; kk < 64; ++kk) { const int k = ks * 64 + kk; const f32x4 w = *(const f32x4*)(W + (size_t)k * D6);
        const float s0 = sv[k], s1 = sv[D + k], s2 = sv[2 * D + k]; acc0 += w * s0; acc1 += w * s1; acc2 += w * s2; }
    LAS float* rp = red + ks * 192 + cq * 12;
#pragma unroll
    for (int j = 0; j < 4; ++j) { rp[j] = acc0[j]; rp[4 + j] = acc1[j]; rp[8 + j] = acc2[j]; }
    __syncthreads();
    if (t < 192) { float s = 0.f;
#pragma unroll 8
        for (int j = 0; j < 32; ++j) s += red[j * 192 + t];
        const int q = t / 12, i = t % 12, v = i >> 2, comp = i & 3, n = n0 + 4 * q + comp;
        float* modbuf = (float*)(a->ws + WS_MOD);
        modbuf[(l * 3 + v) * D6 + n] = s + a->in[7][l * D6 + n]; }
    __syncthreads();
}

struct TMat { const float* W; bf16_t* Wt; int K, N; };
__device__ __forceinline__ bool tr_decode(CArgsP a, int task, TMat& m, int& k0, int& n0) {
    constexpr int C0 = 512, C1 = 1024, C2 = 1536, C3 = C2 + 2816, C4 = C3 + 2816, C5 = C4 + 1408, C6 = C5 + 1408, C7 = C6 + 2048, C8 = C7 + 1024;
    if (task >= C8) return false;
    int base;
    if (task < C0) { m = {a->in[12], (bf16_t*)(a->ws + WS_WIN), D, D}; base = 0; }
    else if (task < C1) { m = {a->in[21], (bf16_t*)(a->ws + WS_WGLU), D, D}; base = C0; }
    else if (task < C2) { m = {a->in[23], (bf16_t*)(a->ws + WS_WOUT), D, D}; base = C1; }
    else if (task < C3) { m = {a->in[8], (bf16_t*)(a->ws + WS_UP0), D, F2}; base = C2; }
    else if (task < C4) { m = {a->in[8] + (size_t)D * F2, (bf16_t*)(a->ws + WS_UP1), D, F2}; base = C3; }
    else if (task < C5) { m = {a->in[11], (bf16_t*)(a->ws + WS_DN0), FF, D}; base = C4; }
    else if (task < C6) { m = {a->in[11] + (size_t)FF * D, (bf16_t*)(a->ws + WS_DN1), FF, D}; base = C5; }
    else if (task < C7) { m = {a->in[24], (bf16_t*)(a->ws + WS_SIN_W), D, SD2}; base = C6; }
    else { m = {a->in[29], (bf16_t*)(a->ws + WS_SOUT_W), SD, D}; base = C7; }
    const int idx = task - base, ntn = m.N >> 7;
    k0 = (idx / ntn) * 64; n0 = (idx % ntn) * 128;
    return true;
}
__device__ __forceinline__ void tr_load(const TMat& m, int k0, int n0, int t, f32x4 (&r)[4]) {
    const int c4 = t & 31, rr = t >> 5;
#pragma unroll
    for (int i = 0; i < 4; ++i) r[i] = *(const f32x4*)(m.W + (size_t)(k0 + rr + 16 * i) * m.N + n0 + 4 * c4);
}
constexpr int TR_PITCH = 132;
__device__ __forceinline__ void p0_transpose_all(CArgsP a, LAS unsigned char* lds, int first, int stride) {
    const int t = tid_opaque();
    LAS float* tile = (LAS float*)lds;
    TMat m; int k0, n0; f32x4 r[4];
    int task = first;
    bool ok = tr_decode(a, task, m, k0, n0);
    if (ok) tr_load(m, k0, n0, t, r);
    while (ok) {
        { const int c4 = t & 31, rr = t >> 5;
#pragma unroll
          for (int i = 0; i < 4; ++i) *(LAS f32x4*)(tile + (rr + 16 * i) * TR_PITCH + 4 * c4) = r[i]; }
        __syncthreads();
        const TMat cm = m; const int ck0 = k0, cn0 = n0;
        task += stride; ok = tr_decode(a, task, m, k0, n0);
        if (ok) tr_load(m, k0, n0, t, r);
        { const int n = t & 127, kq = t >> 7; const LAS float* s = tile + (16 * kq) * TR_PITCH + n;
          u32x4 o0, o1;
          o0.x = pk2(s[0 * TR_PITCH], s[1 * TR_PITCH]); o0.y = pk2(s[2 * TR_PITCH], s[3 * TR_PITCH]); o0.z = pk2(s[4 * TR_PITCH], s[5 * TR_PITCH]); o0.w = pk2(s[6 * TR_PITCH], s[7 * TR_PITCH]);
          o1.x = pk2(s[8 * TR_PITCH], s[9 * TR_PITCH]); o1.y = pk2(s[10 * TR_PITCH], s[11 * TR_PITCH]); o1.z = pk2(s[12 * TR_PITCH], s[13 * TR_PITCH]); o1.w = pk2(s[14 * TR_PITCH], s[15 * TR_PITCH]);
          bf16_t* dst = cm.Wt + (size_t)(cn0 + n) * cm.K + ck0 + 16 * kq;
          *(u32x4*)dst = o0; *(u32x4*)(dst + 8) = o1; }
        __syncthreads();
    }
}

__device__ __forceinline__ void sincos_d(double x, double& s, double& c) {
    const double k = __builtin_rint(x * 0.63661977236758134308);
    double r = __builtin_fma(-k, 1.57079632679489655800e+00, x);
    r = __builtin_fma(-k, 6.12323399573676603587e-17, r);
    const double r2 = r * r;
    double sp = -7.6471637318198164759e-13; sp = sp * r2 + 1.6059043836821614599e-10; sp = sp * r2 - 2.5052108385441718775e-08; sp = sp * r2 + 2.7557319223985890653e-06;
    sp = sp * r2 - 1.9841269841269841270e-04; sp = sp * r2 + 8.3333333333333333333e-03; sp = sp * r2 - 1.6666666666666666667e-01; sp = r + r * r2 * sp;
    double cp = 4.7794773323873852974e-14; cp = cp * r2 - 1.1470745597729724714e-11; cp = cp * r2 + 2.0876756987868098979e-09; cp = cp * r2 - 2.7557319223985890653e-07;
    cp = cp * r2 + 2.4801587301587301587e-05; cp = cp * r2 - 1.3888888888888888889e-03; cp = cp * r2 + 4.1666666666666666667e-02; cp = cp * r2 - 0.5; cp = 1.0 + r2 * cp;
    const int q = ((int)(long long)k) & 3;
    s = (q == 0) ? sp : (q == 1) ? cp : (q == 2) ? -sp : -cp;
    c = (q == 0) ? cp : (q == 1) ? -sp : (q == 2) ? -cp : sp;
}
__device__ __forceinline__ double exp_d(double x) {
    const double k = __builtin_rint(x * 1.44269504088896340736);
    double r = __builtin_fma(-k, 6.93147180369123816490e-01, x);
    r = __builtin_fma(-k, 1.90821492927058770002e-10, r);
    double p = 1.0 / 479001600.0;
    p = p * r + 1.0 / 39916800.0; p = p * r + 1.0 / 3628800.0; p = p * r + 1.0 / 362880.0; p = p * r + 1.0 / 40320.0; p = p * r + 1.0 / 5040.0;
    p = p * r + 1.0 / 720.0; p = p * r + 1.0 / 120.0; p = p * r + 1.0 / 24.0; p = p * r + 1.0 / 6.0; p = p * r + 0.5; p = p * r + 1.0; p = p * r + 1.0;
    const long long e = (long long)k + 1023;
    return p * __builtin_bit_cast(double, (unsigned long long)e << 52);
}
__device__ __forceinline__ void p0_s5_tables(CArgsP a, int idx) {
    const int d = idx >> 13, g = (idx >> 6) & 127, p = idx & 63, gd = g * 2 + d;
    const double are = a->in[13][idx], aim = a->in[14][idx];
    const double dt = exp_d((double)a->in[19][d * NG + g]);
    const double mag = exp_d(are * dt); double sn, cs; sincos_d(aim * dt, sn, cs);
    const double lr = mag * cs, li = mag * sn, den = are * are + aim * aim;
    const double kr = ((lr - 1.0) * are + li * aim) / den, ki = (li * are - (lr - 1.0) * aim) / den;
    const double magT = exp_d(are * dt * (double)TC); double snT, csT; sincos_d(aim * dt * (double)TC, snT, csT);
    f32x2* lam = (f32x2*)(a->ws + WS_LAM); f32x2* lamT = (f32x2*)(a->ws + WS_LAMT);
    lam[gd * 64 + p] = (f32x2){(float)lr, (float)li};
    lamT[gd * 64 + p] = (f32x2){(float)(magT * csT), (float)(magT * snT)};
    bf16_t* Bcat = (bf16_t*)(a->ws + WS_BCAT) + (size_t)(gd * 128 + 2 * p) * 16;
    const float* bre = a->in[15] + (size_t)idx * 16; const float* bim = a->in[16] + (size_t)idx * 16;
#pragma unroll
    for (int h = 0; h < 16; h += 2) {
        const double br0 = bre[h], bi0 = bim[h], br1 = bre[h + 1], bi1 = bim[h + 1];
        *(unsigned*)(Bcat + h) = pk2((float)(kr * br0 - ki * bi0), (float)(kr * br1 - ki * bi1));
        *(unsigned*)(Bcat + 16 + h) = pk2((float)(kr * bi0 + ki * br0), (float)(kr * bi1 + ki * br1));
    }
    bf16_t* Cc = (bf16_t*)(a->ws + WS_CCAT);
    const float* cre = a->in[17] + (size_t)(d * NG + g) * 16 * 64 + p; const float* cim = a->in[18] + (size_t)(d * NG + g) * 16 * 64 + p;
#pragma unroll
    for (int part = 0; part < 2; ++part) {
        const int R = 2 * p + part, tau = R >> 5, rho = R & 31, s = rho >> 4, hh = (rho >> 2) & 1, j = ((rho >> 3) & 1) * 4 + (rho & 3);
        bf16_t* dst = Cc + ((size_t)(((gd * 4 + tau) * 2 + s) * 2 + hh) * 16) * 8 + j;
        for (int h = 0; h < 16; ++h) dst[h * 8] = f2bf(part == 0 ? cre[h * 64] : -cim[h * 64]);
    }
}

template <bool OUT_F32>
__device__ __forceinline__ void norm_row(const float* src, const float* g, const float* shift, const float* scale, void* dst, int lane) {
    f32x4 v[8]; float ss = 0.f;
#pragma unroll
    for (int j = 0; j < 8; ++j) { v[j] = ((const f32x4*)src)[lane + 64 * j]; ss += (v[j].x * v[j].x + v[j].y * v[j].y) + (v[j].z * v[j].z + v[j].w * v[j].w); }
    ss = wave_sum(ss, lane);
    const float rstd = __builtin_amdgcn_rsqf(ss * (1.f / D) + 1e-6f);
#pragma unroll
    for (int j = 0; j < 8; ++j) {
        const f32x4 gv = ((const f32x4*)g)[lane + 64 * j]; f32x4 y = v[j] * rstd * gv;
        if (OUT_F32) ((f32x4*)dst)[lane + 64 * j] = y;
        else { const f32x4 sc = ((const f32x4*)scale)[lane + 64 * j], sh = ((const f32x4*)shift)[lane + 64 * j]; y = y * (sc + 1.f) + sh;
            u32x2 w; w.x = pk2(y.x, y.y); w.y = pk2(y.z, y.w); ((u32x2*)dst)[lane + 64 * j] = w; }
    }
}

#define MFMA32(a, b, c) __builtin_amdgcn_mfma_f32_32x32x16_bf16((a), (b), (c), 0, 0, 0)
__device__ __forceinline__ bf16x8 pack8(const f32x4& a, const f32x4& b) { u32x4 p; p.x = pk2(a.x, a.y); p.y = pk2(a.z, a.w); p.z = pk2(b.x, b.y); p.w = pk2(b.z, b.w); return __builtin_bit_cast(bf16x8, p); }
template <bool PASSB>
__device__ __forceinline__ void s5_pass(CArgsP a, LAS unsigned char* lds, int gw, int nw, int lane) {
    LAS unsigned char* cfl = lds + tid_opaque() * 16;
    LAS unsigned char* lamL = lds + 65536 + (tid_opaque() >> 6) * 512;
    const float* U = (const float*)(a->ws + WS_U);
    const f32x2* lam = (const f32x2*)(a->ws + WS_LAM);
    const bf16_t* Bcat = (const bf16_t*)(a->ws + WS_BCAT);
    const bf16_t* Cc = (const bf16_t*)(a->ws + WS_CCAT);
    for (int item = gw; item < 2048; item += nw) {
        const int g = item & 127, tile = (item >> 7) & 7, d = item >> 10, gd = g * 2 + d;
        const int r = lane & 31, hh = lane >> 5, col = tile * 32 + r, b = col >> 7, c = col & 127;
        bf16x8 Bf[4];
#pragma unroll
        for (int tau = 0; tau < 4; ++tau) Bf[tau] = *(const bf16x8*)(Bcat + (size_t)(gd * 128 + 32 * tau + r) * 16 + 8 * hh);
        { const int p = lane, tau = p >> 4, pl = p & 15, q = ((pl >> 2) << 1) | (pl & 1), h2 = (pl >> 1) & 1;
          *(LAS f32x2*)(lamL + ((tau * 2 + h2) * 8 + q) * 8) = lam[gd * 64 + p]; }
        f32x16 S[4];
        float* Ebuf = (float*)(a->ws + (PASSB ? WS_SI : WS_E)) + ((size_t)gd * NCOL + col) * 128 + 4 * hh;
        if (PASSB) {
#pragma unroll
            for (int tau = 0; tau < 4; ++tau)
#pragma unroll
                for (int i4 = 0; i4 < 4; ++i4) { const f32x4 v = *(const f32x4*)(Ebuf + 32 * tau + 8 * i4); S[tau][4 * i4] = v.x; S[tau][4 * i4 + 1] = v.y; S[tau][4 * i4 + 2] = v.z; S[tau][4 * i4 + 3] = v.w; }
        } else {
#pragma unroll
            for (int tau = 0; tau < 4; ++tau)
#pragma unroll
                for (int i = 0; i < 16; ++i) S[tau][i] = 0.f;
        }
        if (PASSB) {
#pragma unroll
            for (int tau = 0; tau < 4; ++tau)
#pragma unroll
                for (int s = 0; s < 2; ++s) {
                    u32x4 z = {0u, 0u, 0u, 0u};
                    if (r < 16) z = *(const u32x4*)(Cc + ((size_t)((((gd * 4 + tau) * 2 + s) * 2 + hh) * 16 + r)) * 8);
                    *(LAS u32x4*)(cfl + (tau * 2 + s) * 8192) = z;
                }
        }
        float* Yd = (float*)(a->ws + (d == 0 ? WS_YF : WS_YR));
        const int pos0 = TC * c;
        auto memidx = [&](int pos) -> int { return d == 0 ? pos : (pos < CTXL ? (CTXL - 1 - pos) : (LT + CTXL - 1 - pos)); };
        const float* ub = U + (size_t)b * LT * D + g * 16 + 8 * hh;
        f32x4 u0, u1;
        { const float* up = ub + (size_t)memidx(pos0) * D; u0 = *(const f32x4*)up; u1 = *(const f32x4*)(up + 4); }
#pragma unroll 1
        for (int t = 0; t < TC; ++t) {
            asm volatile("" ::: "memory");
            const bf16x8 uf = pack8(u0, u1);
            const int pos = pos0 + t, mem = memidx(pos);
            if (t + 1 < TC) { const float* up = ub + (size_t)memidx(pos + 1) * D; u0 = *(const f32x4*)up; u1 = *(const f32x4*)(up + 4); }
#pragma unroll
            for (int tau = 0; tau < 4; ++tau) {
                f32x16 C;
                const LAS f32x4* lp = (const LAS f32x4*)(lamL + (tau * 2 + hh) * 64);
                const f32x4 l0 = lp[0], l1 = lp[1], l2 = lp[2], l3 = lp[3];
                const float lrr[8] = {l0.x, l0.z, l1.x, l1.z, l2.x, l2.z, l3.x, l3.z}, lii[8] = {l0.y, l0.w, l1.y, l1.w, l2.y, l2.w, l3.y, l3.w};
#pragma unroll
                for (int q = 0; q < 8; ++q) { const float sr = S[tau][2 * q], si = S[tau][2 * q + 1];
                    C[2 * q] = lrr[q] * sr - lii[q] * si; C[2 * q + 1] = lrr[q] * si + lii[q] * sr; }
                S[tau] = MFMA32(Bf[tau], uf, C);
            }
            if (PASSB) {
                f32x16 Y;
#pragma unroll
                for (int i = 0; i < 16; ++i) Y[i] = 0.f;
#pragma unroll
                for (int tau = 0; tau < 4; ++tau)
#pragma unroll
                    for (int s = 0; s < 2; ++s) {
                        u32x4 p; p.x = pk2(S[tau][8 * s], S[tau][8 * s + 1]); p.y = pk2(S[tau][8 * s + 2], S[tau][8 * s + 3]); p.z = pk2(S[tau][8 * s + 4], S[tau][8 * s + 5]); p.w = pk2(S[tau][8 * s + 6], S[tau][8 * s + 7]);
                        const bf16x8 cf = *(const LAS bf16x8*)(cfl + (tau * 2 + s) * 8192);
                        Y = MFMA32(cf, __builtin_bit_cast(bf16x8, p), Y);
                    }
                if (pos >= CTXL) {
                    float* yp = Yd + ((size_t)b * SEQ + (mem - CTXL)) * D + g * 16 + 4 * hh;
                    *(f32x4*)yp = (f32x4){Y[0], Y[1], Y[2], Y[3]};
                    *(f32x4*)(yp + 8) = (f32x4){Y[4], Y[5], Y[6], Y[7]};
                }
            }
        }
        if (!PASSB) {
#pragma unroll
            for (int tau = 0; tau < 4; ++tau)
#pragma unroll
                for (int i4 = 0; i4 < 4; ++i4) *(f32x4*)(Ebuf + 32 * tau + 8 * i4) = (f32x4){S[tau][4 * i4], S[tau][4 * i4 + 1], S[tau][4 * i4 + 2], S[tau][4 * i4 + 3]};
        }
    }
}

__device__ __forceinline__ void conv_phase(CArgsP a, LAS unsigned char* lds, int layer, int first, int stride) {
    const int t0 = tid_opaque();
    const bf16_t* Z = (const bf16_t*)(a->ws + WS_Z); bf16_t* A3 = (bf16_t*)(a->ws + WS_A3);
    const float* cw = a->in[9] + (size_t)layer * 9 * F2; const float* cb = a->in[10] + (size_t)layer * F2;
    LAS float* wl = (LAS float*)lds;
    for (int task = first; task < 1408; task += stride) {
        const int t = launder_i(t0), o = t & 7, c = t >> 3;
        const int cbk = task % 88, rb = (task / 88) & 7, b = task / 704;
        __syncthreads();
#pragma unroll
        for (int it = 0; it < 3; ++it) { const int i = t + it * NTHREADS; if (i < 10 * 128) { const int tap = i >> 7, half = (i >> 6) & 1, ch = i & 63; const int gch = half * FF + cbk * 64 + ch;
            wl[i] = tap < 9 ? cw[(size_t)tap * F2 + gch] : cb[gch]; } }
        __syncthreads();
        const u32x4 zero4 = {0u, 0u, 0u, 0u};
        u32x4 win[3][3][2];
        const size_t chg = (size_t)cbk * 64 + 8 * o;
        auto ldrow = [&](int rrow, u32x4 (&w)[3][2]) {
#pragma unroll
            for (int dj = 0; dj < 3; ++dj) { const int cc2 = c + dj - 1; const bool ok = (rrow >= 0) && (rrow < 64) && (cc2 >= 0) && (cc2 < 64);
                if (ok) { const bf16_t* zp = Z + ((size_t)b * SEQ + rrow * 64 + cc2) * F2 + chg; w[dj][0] = *(const u32x4*)zp; w[dj][1] = *(const u32x4*)(zp + FF); }
                else { w[dj][0] = zero4; w[dj][1] = zero4; } }
        };
        const int r0 = rb * 8;
        ldrow(r0 - 1, win[0]); ldrow(r0, win[1]);
#pragma unroll 1
        for (int rr = 0; rr < 8; ++rr) {
            asm volatile("" ::: "memory");
            const int row = r0 + rr;
            ldrow(row + 1, win[2]);
            float ag[8], av[8];
            { const f32x4 b0 = *(const LAS f32x4*)(wl + 9 * 128 + 8 * o), b1 = *(const LAS f32x4*)(wl + 9 * 128 + 8 * o + 4), b2 = *(const LAS f32x4*)(wl + 9 * 128 + 64 + 8 * o), b3 = *(const LAS f32x4*)(wl + 9 * 128 + 64 + 8 * o + 4);
#pragma unroll
              for (int j = 0; j < 4; ++j) { ag[j] = b0[j]; ag[4 + j] = b1[j]; av[j] = b2[j]; av[4 + j] = b3[j]; } }
#pragma unroll
            for (int di = 0; di < 3; ++di)
#pragma unroll
                for (int dj = 0; dj < 3; ++dj) {
                    asm volatile("" ::: "memory");
                    const LAS float* wp = wl + (di * 3 + dj) * 128 + 8 * o;
                    const f32x4 wg0 = *(const LAS f32x4*)wp, wg1 = *(const LAS f32x4*)(wp + 4), wv0 = *(const LAS f32x4*)(wp + 64), wv1 = *(const LAS f32x4*)(wp + 68);
                    const u32x4 zg = win[di][dj][0], zv = win[di][dj][1];
                    ag[0] += bf_lo(zg.x) * wg0[0]; ag[1] += bf_hi(zg.x) * wg0[1]; ag[2] += bf_lo(zg.y) * wg0[2]; ag[3] += bf_hi(zg.y) * wg0[3];
                    ag[4] += bf_lo(zg.z) * wg1[0]; ag[5] += bf_hi(zg.z) * wg1[1]; ag[6] += bf_lo(zg.w) * wg1[2]; ag[7] += bf_hi(zg.w) * wg1[3];
                    av[0] += bf_lo(zv.x) * wv0[0]; av[1] += bf_hi(zv.x) * wv0[1]; av[2] += bf_lo(zv.y) * wv0[2]; av[3] += bf_hi(zv.y) * wv0[3];
                    av[4] += bf_lo(zv.z) * wv1[0]; av[5] += bf_hi(zv.z) * wv1[1]; av[6] += bf_lo(zv.w) * wv1[2]; av[7] += bf_hi(zv.w) * wv1[3];
                }
            u32x4 w;
            w.x = pk2(silu_f(ag[0]) * av[0], silu_f(ag[1]) * av[1]); w.y = pk2(silu_f(ag[2]) * av[2], silu_f(ag[3]) * av[3]);
            w.z = pk2(silu_f(ag[4]) * av[4], silu_f(ag[5]) * av[5]); w.w = pk2(silu_f(ag[6]) * av[6], silu_f(ag[7]) * av[7]);
            *(u32x4*)(A3 + ((size_t)b * SEQ + row * 64 + c) * FF + chg) = w;
#pragma unroll
            for (int dj = 0; dj < 3; ++dj) { win[0][dj][0] = win[1][dj][0]; win[0][dj][1] = win[1][dj][1]; win[1][dj][0] = win[2][dj][0]; win[1][dj][1] = win[2][dj][1]; }
        }
    }
}

constexpr int SP_PITCH = 136;
constexpr int SP_WS_OFF = 0, SP_VT_OFF = 128 * SP_PITCH * 2  , SP_O_OFF = 0, SP_OPITCH = 264;
__device__ __forceinline__ void spatial_phase(CArgsP a, LAS unsigned char* lds, int first, int stride) {
    const int t = tid_opaque(), lane = t & 63, wid = t >> 6;
    const bf16_t* ZS = (const bf16_t*)(a->ws + WS_ZS); bf16_t* GT = (bf16_t*)(a->ws + WS_GT);
    const float* st = (const float*)(a->ws + WS_LNST);
    const float* lng = a->in[25]; const float* lnb = a->in[26]; const float* wsp = a->in[27]; const float* bsp = a->in[28];
    LAS bf16_t* Ws = (LAS bf16_t*)(lds + SP_WS_OFF); LAS bf16_t* Vt = (LAS bf16_t*)(lds + SP_VT_OFF); LAS bf16_t* Ot = (LAS bf16_t*)(lds + SP_O_OFF);
    for (int item = first; item < 1024; item += stride) {
        const int g = item & 15, cn = item >> 4;
        const size_t tok0 = (size_t)cn * 128;
        __syncthreads();
        for (int i = t; i < 128 * 32; i += NTHREADS) { const int q = i >> 5, k4 = i & 31; const f32x4 w = *(const f32x4*)(wsp + ((size_t)g * 128 + q) * 128 + 4 * k4);
            u32x2 pw; pw.x = pk2(w.x, w.y); pw.y = pk2(w.z, w.w); *(LAS u32x2*)(Ws + q * SP_PITCH + 4 * k4) = pw; }
        for (int i = t; i < 64 * 32; i += NTHREADS) {
            const int oc = i & 3, kp = (i >> 2) & 63, og = i >> 8;
            const int oct = og * 4 + oc, c0 = oct * 8;
            const size_t ra = tok0 + 2 * kp;
            const u32x4 va = *(const u32x4*)(ZS + ra * SD2 + SD + g * 256 + c0), vb = *(const u32x4*)(ZS + (ra + 1) * SD2 + SD + g * 256 + c0);
            const float sa = st[2 * ra], qa = st[2 * ra + 1], sb = st[2 * ra + 2], qb = st[2 * ra + 3];
            const float mua = sa * (1.f / SD), mub = sb * (1.f / SD);
            const float rsa = __builtin_amdgcn_rsqf(qa * (1.f / SD) - mua * mua + 1e-5f), rsb = __builtin_amdgcn_rsqf(qb * (1.f / SD) - mub * mub + 1e-5f);
            const f32x4 g0 = *(const f32x4*)(lng + g * 256 + c0), g1 = *(const f32x4*)(lng + g * 256 + c0 + 4), b0 = *(const f32x4*)(lnb + g * 256 + c0), b1 = *(const f32x4*)(lnb + g * 256 + c0 + 4);
            const unsigned wa[4] = {va.x, va.y, va.z, va.w}, wb[4] = {vb.x, vb.y, vb.z, vb.w};
#pragma unroll
            for (int j = 0; j < 4; ++j) {
                const float gl = j < 2 ? g0[2 * j] : g1[2 * j - 4], gh = j < 2 ? g0[2 * j + 1] : g1[2 * j - 3];
                const float bl = j < 2 ? b0[2 * j] : b1[2 * j - 4], bh = j < 2 ? b0[2 * j + 1] : b1[2 * j - 3];
                const float al = (bf_lo(wa[j]) - mua) * rsa * gl + bl, ah = (bf_hi(wa[j]) - mua) * rsa * gh + bh;
                const float bl2 = (bf_lo(wb[j]) - mub) * rsb * gl + bl, bh2 = (bf_hi(wb[j]) - mub) * rsb * gh + bh;
                *(LAS unsigned*)(Vt + (c0 + 2 * j) * SP_PITCH + 2 * kp) = pk2(al, bl2);
                *(LAS unsigned*)(Vt + (c0 + 2 * j + 1) * SP_PITCH + 2 * kp) = pk2(ah, bh2);
            }
        }
        __syncthreads();
        const int r = lane & 31, hh = lane >> 5;
        f32x16 acc[4];
#pragma unroll
        for (int mt = 0; mt < 4; ++mt)
#pragma unroll
            for (int i = 0; i < 16; ++i) acc[mt][i] = 0.f;
#pragma unroll
        for (int ks = 0; ks < 8; ++ks) {
            const bf16x8 bfr = *(const LAS bf16x8*)(Vt + (32 * wid + r) * SP_PITCH + 16 * ks + 8 * hh);
#pragma unroll
            for (int mt = 0; mt < 4; ++mt) { const bf16x8 afr = *(const LAS bf16x8*)(Ws + (32 * mt + r) * SP_PITCH + 16 * ks + 8 * hh); acc[mt] = MFMA32(afr, bfr, acc[mt]); }
        }
        __syncthreads();
#pragma unroll
        for (int mt = 0; mt < 4; ++mt)
#pragma unroll
            for (int i = 0; i < 16; ++i) { const int q = 32 * mt + (i & 3) + 8 * (i >> 2) + 4 * hh; Ot[q * SP_OPITCH + 32 * wid + r] = f2bf(acc[mt][i] + bsp[g * 128 + q]); }
        __syncthreads();
        for (int i = t; i < 128 * 32; i += NTHREADS) { const int q = i >> 5, oct = i & 31;
            const u32x4 uv = *(const u32x4*)(ZS + (tok0 + q) * SD2 + g * 256 + 8 * oct);
            const u32x4 sv = *(const LAS u32x4*)(Ot + q * SP_OPITCH + 8 * oct);
            u32x4 w;
            w.x = pk2(bf_lo(uv.x) * bf_lo(sv.x), bf_hi(uv.x) * bf_hi(sv.x)); w.y = pk2(bf_lo(uv.y) * bf_lo(sv.y), bf_hi(uv.y) * bf_hi(sv.y));
            w.z = pk2(bf_lo(uv.z) * bf_lo(sv.z), bf_hi(uv.z) * bf_hi(sv.z)); w.w = pk2(bf_lo(uv.w) * bf_lo(sv.w), bf_hi(uv.w) * bf_hi(sv.w));
            *(u32x4*)(GT + (tok0 + q) * SD + g * 256 + 8 * oct) = w; }
    }
}

__global__ void __launch_bounds__(NTHREADS, 2) fwd_kernel(Args a_unused) {
    extern __shared__ __attribute__((aligned(16))) unsigned char lds_raw[];
    LAS unsigned char* lds = (LAS unsigned char*)lds_raw;
    cg::grid_group grid = cg::this_grid();
        int lo, hi; { CArgsP a0 = get_args(); lo = a0->ph_lo; hi = a0->ph_hi; }
    int ph = 0;
#ifndef ONLY_KIND
#define ONLY_KIND -1
#endif
#define PHASE_BEGIN(kind) if ((ONLY_KIND < 0 || ONLY_KIND == (kind)) && ph >= lo && ph < hi) { CArgsP a = get_args(); unsigned char* ws = a->ws; float* modbuf = (float*)(ws + WS_MOD); (void)modbuf; const int t = tid_opaque(), lane = t & 63, wave = __builtin_amdgcn_readfirstlane(t >> 6); const int G = gridDim.x, bx = blockIdx.x; const int gw = bx * NWAVES + wave, NGW = G * NWAVES; (void)lane; (void)gw; (void)NGW;
#define PHASE_END   if (ph + 1 < hi) grid.sync(); } ++ph;

    PHASE_BEGIN(0)
        for (int i = bx * NTHREADS + t; i < M * 2; i += G * NTHREADS) ((float*)(ws + WS_LNST))[i] = 0.f;
        for (int tk = bx; tk < 384; tk += G) p0_gemv_task(a, lds, tk);
        for (int idx = bx * NTHREADS + t; idx < 2 * NG * NP; idx += G * NTHREADS) p0_s5_tables(a, idx);
        __syncthreads();
        p0_transpose_all(a, lds, bx, G);
    PHASE_END
    PHASE_BEGIN(1)
        for (int m = gw; m < MU; m += NGW) { const int b = m / LT, j = m % LT;
            const float* src = j < CTXL ? a->in[2] + ((size_t)b * CTXL + j) * D : a->in[0] + ((size_t)b * SEQ + (j - CTXL)) * D;
            const float* md = modbuf + (j < CTXL ? 2 : b) * D6;
            norm_row<false>(src, a->in[4], md, md + D, (bf16_t*)(ws + WS_A0) + (size_t)m * D, lane); }
    PHASE_END
    PHASE_BEGIN(2)
        pg8::Gemm g{(const bf16_t*)(ws + WS_A0), (const bf16_t*)(ws + WS_WIN), MU, D, D}; pg8::StaticOrder S; S.init(MU, D, G, bx);
        pg8::EpiF32 E{(float*)(ws + WS_U), D};
        pg8::gemm_phase<pg8::EpiF32, true, true>(lds, g, S, E);
    PHASE_END
    PHASE_BEGIN(3)
        s5_pass<false>(a, lds, gw, NGW, lane);
    PHASE_END
    PHASE_BEGIN(4)
        if (t < 128) {
            const f32x2* lamT = (const f32x2*)(ws + WS_LAMT);
            for (int idx = bx * 128 + t; idx < 2 * NG * 2 * NP; idx += G * 128) {
                const int p = idx & 63, b = (idx >> 6) & 1, gd = idx >> 7;
                const f32x2 lt = lamT[gd * 64 + p]; float sr = 0.f, si = 0.f;
                const f32x2* e = (const f32x2*)((const float*)(ws + WS_E) + ((size_t)gd * NCOL + b * 128) * 128) + p;
                f32x2* so = (f32x2*)((float*)(ws + WS_SI) + ((size_t)gd * NCOL + b * 128) * 128) + p;
#pragma unroll 8
                for (int c = 0; c < 128; ++c) { so[c * 64] = (f32x2){sr, si}; const f32x2 ev = e[c * 64];
                    const float nr = lt.x * sr - lt.y * si + ev.x, ni = lt.x * si + lt.y * sr + ev.y; sr = nr; si = ni; }
            }
        }
    PHASE_END
    PHASE_BEGIN(5)
        s5_pass<true>(a, lds, gw, NGW, lane);
    PHASE_END
    PHASE_BEGIN(6)
        const float* U = (const float*)(ws + WS_U); const float* YF = (const float*)(ws + WS_YF); const float* YR = (const float*)(ws + WS_YR);
        const float* dsk = a->in[20]; bf16_t* Gm = (bf16_t*)(ws + WS_G);
        for (int i = bx * NTHREADS + t; i < M * (D / 4); i += G * NTHREADS) {
            const int m = i >> 9, c4 = i & 511, b = m >> 12, tt = m & 4095;
            const f32x4 u = *(const f32x4*)(U + ((size_t)b * LT + CTXL + tt) * D + 4 * c4);
            const f32x4 yf = ((const f32x4*)YF)[i], yr = ((const f32x4*)YR)[i], dv = ((const f32x4*)dsk)[c4];
            const f32x4 y = dv * u + yf + yr;
            u32x2 w; w.x = pk2(gelu_tanh_f(y.x), gelu_tanh_f(y.y)); w.y = pk2(gelu_tanh_f(y.z), gelu_tanh_f(y.w));
            ((u32x2*)Gm)[i] = w; }
    PHASE_END
    PHASE_BEGIN(7)
        pg8::Gemm g{(const bf16_t*)(ws + WS_G), (const bf16_t*)(ws + WS_WGLU), M, D, D}; pg8::StaticOrder S; S.init(M, D, G, bx);
        pg8::EpiGlu E{(const bf16_t*)(ws + WS_G), (bf16_t*)(ws + WS_A2), a->in[22]};
        pg8::gemm_phase<pg8::EpiGlu, true, true>(lds, g, S, E);
    PHASE_END
    PHASE_BEGIN(8)
        pg8::Gemm g{(const bf16_t*)(ws + WS_A2), (const bf16_t*)(ws + WS_WOUT), M, D, D}; pg8::StaticOrder S; S.init(M, D, G, bx);
        pg8::EpiResid E{a->in[0], (float*)(ws + WS_X), modbuf + 2 * D};
        pg8::gemm_phase<pg8::EpiResid, true, true>(lds, g, S, E);
    PHASE_END
#pragma unroll
    for (int layer = 0; layer < 2; ++layer) {
        if (layer == 1) {
            PHASE_BEGIN(9)
                for (int m = gw; m < M; m += NGW) { const int b = m >> 12; const float* md = modbuf + (3 + b) * D6;
                    norm_row<false>((const float*)(ws + WS_X) + (size_t)m * D, a->in[4] + D, md, md + D, (bf16_t*)(ws + WS_A0) + (size_t)m * D, lane); }
            PHASE_END
            PHASE_BEGIN(10)
                pg8::Gemm g{(const bf16_t*)(ws + WS_A0), (const bf16_t*)(ws + WS_SIN_W), M, SD2, D}; pg8::StaticOrder S; S.init(M, SD2, G, bx);
                pg8::EpiBf16<1> E{(bf16_t*)(ws + WS_ZS), SD2, (float*)(ws + WS_LNST), 16};
                pg8::gemm_phase<pg8::EpiBf16<1>, true, true>(lds, g, S, E);
            PHASE_END
            PHASE_BEGIN(11)
                spatial_phase(a, lds, bx, G);
            PHASE_END
            PHASE_BEGIN(12)
                pg8::Gemm g{(const bf16_t*)(ws + WS_GT), (const bf16_t*)(ws + WS_SOUT_W), M, D, SD}; pg8::StaticOrder S; S.init(M, D, G, bx);
                pg8::EpiResid E{(const float*)(ws + WS_X), (float*)(ws + WS_X), modbuf + 3 * D6 + 2 * D};
                pg8::gemm_phase<pg8::EpiResid, true, true>(lds, g, S, E);
            PHASE_END
        }
        PHASE_BEGIN(13)
            for (int m = gw; m < M; m += NGW) { const int b = m >> 12; const float* md = modbuf + (layer * 3 + b) * D6 + 3 * D;
                norm_row<false>((const float*)(ws + WS_X) + (size_t)m * D, a->in[5] + layer * D, md, md + D, (bf16_t*)(ws + WS_A0) + (size_t)m * D, lane); }
        PHASE_END
        PHASE_BEGIN(14)
            pg8::Gemm g{(const bf16_t*)(ws + WS_A0), (const bf16_t*)(ws + (layer ? WS_UP1 : WS_UP0)), M, F2, D}; pg8::StaticOrder S; S.init(M, F2, G, bx);
            pg8::EpiBf16<0> E{(bf16_t*)(ws + WS_Z), F2, nullptr, 1 << 30};
            pg8::gemm_phase<pg8::EpiBf16<0>, true, true>(lds, g, S, E);
        PHASE_END
        PHASE_BEGIN(15)
            conv_phase(a, lds, layer, bx, G);
        PHASE_END
        PHASE_BEGIN(16)
            pg8::Gemm g{(const bf16_t*)(ws + WS_A3), (const bf16_t*)(ws + (layer ? WS_DN1 : WS_DN0)), M, D, FF}; pg8::StaticOrder S; S.init(M, D, G, bx);
            pg8::EpiResid E{(const float*)(ws + WS_X), (float*)(ws + WS_X), modbuf + layer * 3 * D6 + 5 * D};
            pg8::gemm_phase<pg8::EpiResid, true, true>(lds, g, S, E);
        PHASE_END
    }
    PHASE_BEGIN(17)
        for (int m = gw; m < M; m += NGW) norm_row<true>((const float*)(ws + WS_X) + (size_t)m * D, a->in[30], nullptr, nullptr, a->out + (size_t)m * D, lane);
    PHASE_END
}
constexpr int N_PHASES = 22;

extern "C" void kernel_launch(void* const* d_in, const int* in_sizes, int n_in, void* d_out, int out_size, void* d_ws, size_t ws_size, hipStream_t stream) {
    static int grid = 0;
    if (grid == 0) {
        if (n_in != 31 || out_size != M * D || ws_size < WS_END) { fprintf(stderr, "kernel_launch: unexpected shapes (n_in %d out %d ws %zu need %zu)\n", n_in, out_size, ws_size, (size_t)WS_END); grid = -1; return; }
        int dev = 0, cus = 0, per_cu = 0;
        hipGetDevice(&dev); hipDeviceGetAttribute(&cus, hipDeviceAttributeMultiprocessorCount, dev);
        if (hipFuncSetAttribute((const void*)fwd_kernel, hipFuncAttributeMaxDynamicSharedMemorySize, LDS_BYTES) != hipSuccess) { fprintf(stderr, "kernel_launch: hipFuncSetAttribute failed\n"); grid = -1; return; }
        if (hipOccupancyMaxActiveBlocksPerMultiprocessor(&per_cu, (const void*)fwd_kernel, NTHREADS, LDS_BYTES) != hipSuccess || per_cu < 1) { fprintf(stderr, "kernel_launch: occupancy query gave %d\n", per_cu); per_cu = 1; }
        (void)hipGetLastError();
        grid = cus * 1;
    }
    if (grid < 0) return;
    Args a{};
    for (int i = 0; i < 31; ++i) a.in[i] = (const float*)d_in[i];
    a.out = (float*)d_out; a.ws = (unsigned char*)d_ws; a.ph_lo = 0; a.ph_hi = N_PHASES;
    void* args[] = {&a};
    hipError_t e = hipLaunchCooperativeKernel((const void*)fwd_kernel, dim3(grid), dim3(NTHREADS), args, LDS_BYTES, stream);
    if (e != hipSuccess) fprintf(stderr, "kernel_launch: cooperative launch failed: %s (grid %d)\n", hipGetErrorString(e), grid);
}
```

```cpp
#include <hip/hip_runtime.h>
#include <hip/hip_cooperative_groups.h>
#include <cstdio>
#include <cstdint>
namespace cg = cooperative_groups;

#ifndef PROBE_MASK
#define PROBE_MASK 0u
#endif
#define LAS __attribute__((address_space(3)))
typedef unsigned short bf16_t;
typedef short bf16x8 __attribute__((ext_vector_type(8)));
typedef float f32x2 __attribute__((ext_vector_type(2)));
typedef float f32x4 __attribute__((ext_vector_type(4)));
typedef float f32x16 __attribute__((ext_vector_type(16)));
typedef unsigned u32x2 __attribute__((ext_vector_type(2)));
typedef unsigned u32x4 __attribute__((ext_vector_type(4)));
typedef __bf16 bf16x2v __attribute__((ext_vector_type(2)));

constexpr int D = 2048, NB = 2, SEQ = 4096, CTXL = 256, M = NB * SEQ, LT = SEQ + CTXL, MU = NB * LT;
constexpr int NG = 128, NP = 64, NH = 16, TC = 34, NCOL = 256;
constexpr int F2 = 11264, FF = 5632, SD = 4096, SD2 = 8192, D6 = 12288;
constexpr int NTHREADS = 512, NWAVES = 8;
constexpr int LDS_BYTES = 147456;

constexpr size_t MiB = 1u << 20;
constexpr size_t WS_MOD = 0;
constexpr size_t WS_LAM = 512 * 1024;
constexpr size_t WS_LAMT = 768 * 1024;
constexpr size_t WS_BCAT = 1 * MiB;
constexpr size_t WS_CCAT = 2 * MiB;
constexpr size_t WS_LNST = 3 * MiB;
constexpr size_t WS_PROBE = 4 * MiB;
constexpr size_t WS_BIAS = 6 * MiB;
constexpr size_t WS_ROWSS = 7 * MiB;
constexpr size_t WS_GP = 7 * MiB + 512 * 1024;
constexpr size_t WS_BAR = 5 * MiB;
constexpr int LDS_BARST = LDS_BYTES - 64;
constexpr size_t WS_W = 16 * MiB;
constexpr size_t WS_WIN = WS_W, WS_WGLU = WS_WIN + 8 * MiB, WS_WOUT = WS_WGLU + 8 * MiB;
constexpr size_t WS_UP0 = WS_WOUT + 8 * MiB, WS_UP1 = WS_UP0 + 44 * MiB;
constexpr size_t WS_DN0 = WS_UP1 + 44 * MiB, WS_DN1 = WS_DN0 + 22 * MiB;
constexpr size_t WS_SIN_W = WS_DN1 + 22 * MiB, WS_SOUT_W = WS_SIN_W + 32 * MiB;
constexpr size_t WS_X = WS_SOUT_W + 16 * MiB;
constexpr size_t WS_A0 = WS_X + 64 * MiB;
constexpr size_t WS_G = WS_A0 + 34 * MiB;
constexpr size_t WS_A2 = WS_G + 32 * MiB;
constexpr size_t WS_BIG1 = WS_A2 + 32 * MiB;
constexpr size_t WS_U = WS_BIG1;
constexpr size_t WS_YF = WS_BIG1 + 68 * MiB;
constexpr size_t WS_Z = WS_BIG1;
constexpr size_t WS_ZS = WS_BIG1;
constexpr size_t WS_BIG2 = WS_BIG1 + 176 * MiB;
constexpr size_t WS_YR = WS_BIG2;
constexpr size_t WS_E = WS_BIG2 + 64 * MiB;
constexpr size_t WS_SI = WS_BIG2 + 96 * MiB;
constexpr size_t WS_A3 = WS_BIG2;
constexpr size_t WS_GT = WS_BIG2;
constexpr size_t WS_UB = WS_BIG2 + 128 * MiB;
constexpr size_t WS_KEND = WS_UB + 34 * MiB;
constexpr size_t WS_END = WS_KEND + 36 * MiB;

struct Args { const float* in[31]; float* out; unsigned char* ws; int ph_lo, ph_hi; };
typedef const Args __attribute__((address_space(4)))* CArgsP;
__device__ __forceinline__ CArgsP get_args() { CArgsP p = (CArgsP)__builtin_amdgcn_kernarg_segment_ptr(); asm volatile("" : "+s"(p)); return p; }

__device__ __forceinline__ void store16_wt(void* p, f32x4 v) { asm volatile("global_store_dwordx4 %0, %1, off sc1" :: "v"(p), "v"(v) : "memory"); }
__device__ __forceinline__ int launder_i(int v) { asm volatile("" : "+v"(v)); return v; }
__device__ __forceinline__ int tid_opaque() { int t = threadIdx.x; asm volatile("" : "+v"(t)); return t; }
__device__ __forceinline__ unsigned pk2(float lo, float hi) { f32x2 v = {lo, hi}; bf16x2v r = __builtin_convertvector(v, bf16x2v); return __builtin_bit_cast(unsigned, r); }
__device__ __forceinline__ bf16_t f2bf(float f) { return (bf16_t)(pk2(f, 0.f) & 0xffffu); }
__device__ __forceinline__ float bf_lo(unsigned w) { return __builtin_bit_cast(float, w << 16); }
__device__ __forceinline__ float bf_hi(unsigned w) { return __builtin_bit_cast(float, w & 0xffff0000u); }
__device__ __forceinline__ float shfl_xor_l(float v, int m, int lane) { return __builtin_bit_cast(float, __builtin_amdgcn_ds_bpermute((lane ^ m) << 2, __builtin_bit_cast(int, v))); }
__device__ __forceinline__ float wave_sum(float v, int lane) {
#pragma unroll
    for (int o = 1; o < 64; o <<= 1) v += shfl_xor_l(v, o, lane);
    return v;
}
__device__ __forceinline__ float sigmoid_f(float x) { return __builtin_amdgcn_rcpf(1.f + __expf(-x)); }
__device__ __forceinline__ float silu_f(float x) { return x * sigmoid_f(x); }
__device__ __forceinline__ float gelu_tanh_f(float x) { const float t = 1.5957691216f * (x + 0.044715f * x * x * x); return x * sigmoid_f(t); }

namespace pg8 {
constexpr int BM = 256, BK = 64, HALF = 128, HTB = HALF * BK * 2, STAGE_BYTES = 8 * HTB, NXCD = 8, WGM = 8;
__device__ __forceinline__ int lds_byte(int r, int c) { const int st = (r >> 4) * 2 + (c >> 5), rr = r & 15, cc = c & 31, ob = rr * 64 + cc * 2; return st * 1024 + (ob ^ (((ob >> 9) & 1) << 5)); }
__device__ __forceinline__ void stage_rc(int b, int& R, int& C) { const int st = b / 1024, sb = b % 1024, swz = sb ^ (((sb >> 9) & 1) << 5); R = (st >> 1) * 16 + swz / 64; C = (st & 1) * 32 + (swz % 64) / 2; }
__device__ __forceinline__ int perm32(int rho) { const int n = rho >> 4, i = rho & 15; return 8 * (i >> 2) + 4 * n + (i & 3); }
struct Unit { int pm, pn; };
struct Gemm { const bf16_t* A; const bf16_t* Bt; int M, N, K, ld; };
struct StaticOrder {
    int nM, nN, nwg, G, c;
    __device__ void init(int M_, int N_, int G_, int c_) { nM = M_ / BM; nN = N_ / BM; nwg = nM * nN; G = G_; c = c_; }
    __device__ bool next(int i, Unit& u) const {
        const long L = (long)i * G + c; if (L >= nwg) return false;
        int wgid = (int)L; { const int q = nwg / NXCD, r = nwg % NXCD, xcd = wgid % NXCD, off = wgid / NXCD; wgid = (xcd < r ? xcd * (q + 1) : r * (q + 1) + (xcd - r) * q) + off; }
        const int nig = WGM * nN, gid = wgid / nig, fm = gid * WGM, gsz = (nM - fm) < WGM ? (nM - fm) : WGM;
        u.pm = fm + ((wgid % nig) % gsz); u.pn = (wgid % nig) / gsz; return true;
    }
};

template <class Epi, bool ALIGN_EPI, bool SP2>
__device__ __forceinline__ void gemm_phase(LAS unsigned char* lds, const Gemm g, const StaticOrder& S, const Epi& E) {
    const int tid = tid_opaque(), wid = __builtin_amdgcn_readfirstlane(tid >> 6), lane = tid & 63, wr = wid >> 2, wc = wid & 3, fr = lane & 15, fq = lane >> 4;
    const int K = g.ld, nt = g.K / BK;
    unsigned voffA[2], voffB[2];
#pragma unroll
    for (int i = 0; i < 2; ++i) { int R, C; stage_rc(tid * 16 + i * 8192, R, C); const int Rb = Epi::PERM ? ((R & ~31) + perm32(R & 31)) : R;
        voffA[i] = (unsigned)(R * K + C) * 2u; voffB[i] = (unsigned)(Rb * K + C) * 2u; }
    const size_t kstep = (size_t)(BK * 2);
    const size_t hstep = (size_t)HALF * K * 2;
    const size_t tstep = 2 * hstep;
    const unsigned ldsw = (unsigned)wid * 1024u;
    const int aoff = lds_byte(wr * 64 + fr, fq * 8), boff = lds_byte(wc * 32 + fr, fq * 8);
#define PG8_SA(b, h) (((b) * 2 + (h)) * HTB)
#define PG8_SB(b, h) ((4 + (b) * 2 + (h)) * HTB)
#define PG8_STAGE(bufoff, gbase, voff) do { _Pragma("unroll") for (int _i = 0; _i < 2; ++_i) \
        __builtin_amdgcn_global_load_lds((const unsigned*)((const char*)(gbase) + (voff)[_i]), (LAS unsigned*)(lds + (bufoff) + ldsw + _i * 8192), 16, 0, 0); } while (0)
#define PG8_LDA(dst, b, h) do { _Pragma("unroll") for (int m = 0; m < 4; ++m) _Pragma("unroll") for (int k = 0; k < 2; ++k) dst[m][k] = *(const LAS bf16x8*)(lds + PG8_SA(b, h) + aoff + m * 2048 + k * 1024); } while (0)
#define PG8_LDB(dst, b, h) do { _Pragma("unroll") for (int n = 0; n < 2; ++n) _Pragma("unroll") for (int k = 0; k < 2; ++k) dst[n][k] = *(const LAS bf16x8*)(lds + PG8_SB(b, h) + boff + n * 2048 + k * 1024); } while (0)
#define PG8_MMA(ai, bj, At, Bt) do { __builtin_amdgcn_s_setprio(1); _Pragma("unroll") for (int m = 0; m < 4; ++m) _Pragma("unroll") for (int n = 0; n < 2; ++n) _Pragma("unroll") for (int k = 0; k < 2; ++k) \
        acc[ai][bj][m][n] = __builtin_amdgcn_mfma_f32_16x16x32_bf16(Bt[n][k], At[m][k], acc[ai][bj][m][n], 0, 0, 0); __builtin_amdgcn_s_setprio(0); } while (0)
#define PG8_WAIT_V(n) asm volatile("s_waitcnt vmcnt(" #n ")" ::: "memory")
#define PG8_WAIT_L(n) asm volatile("s_waitcnt lgkmcnt(" #n ")" ::: "memory")
#define PG8_BAR __builtin_amdgcn_s_barrier()
#define PG8_SCHED __builtin_amdgcn_sched_barrier(0)
    Unit cur, nxt; int ui = 0;
    if (!S.next(0, cur)) return;
    f32x4 acc[2][2][4][2];
#pragma unroll
    for (int a = 0; a < 2; ++a)
#pragma unroll
        for (int b = 0; b < 2; ++b)
#pragma unroll
            for (int m = 0; m < 4; ++m)
#pragma unroll
                for (int n = 0; n < 2; ++n) acc[a][b][m][n] = (f32x4){0.f, 0.f, 0.f, 0.f};
    bf16x8 At[4][2], B0[2][2], B1[2][2];
    const char* cA = (const char*)g.A + (size_t)cur.pm * tstep; const char* cB = (const char*)g.Bt + (size_t)cur.pn * tstep;
    if constexpr (SP2) {
        PG8_STAGE(PG8_SB(0, 0), cB, voffB); PG8_STAGE(PG8_SB(0, 1), cB + hstep, voffB); PG8_STAGE(PG8_SA(0, 0), cA, voffA); PG8_STAGE(PG8_SA(0, 1), cA + hstep, voffA);
        if (wr == 1) PG8_BAR;
        PG8_WAIT_V(2); PG8_BAR;
        PG8_STAGE(PG8_SB(1, 0), cB + kstep, voffB); PG8_STAGE(PG8_SA(1, 0), cA + kstep, voffA); PG8_STAGE(PG8_SB(1, 1), cB + hstep + kstep, voffB);
        PG8_WAIT_V(6); PG8_BAR;
    } else {
        PG8_STAGE(PG8_SB(0, 0), cB, voffB); PG8_STAGE(PG8_SA(0, 0), cA, voffA); PG8_STAGE(PG8_SB(0, 1), cB + hstep, voffB); PG8_STAGE(PG8_SA(0, 1), cA + hstep, voffA);
        if (wr == 1) PG8_BAR;
        PG8_WAIT_V(4); PG8_BAR;
        PG8_STAGE(PG8_SB(1, 0), cB + kstep, voffB); PG8_STAGE(PG8_SA(1, 0), cA + kstep, voffA); PG8_STAGE(PG8_SB(1, 1), cB + hstep + kstep, voffB);
        PG8_WAIT_V(6); PG8_BAR;
    }
    for (;;) {
        const bool has_next = S.next(ui + 1, nxt);
        const char* nA = has_next ? (const char*)g.A + (size_t)nxt.pm * tstep : cA; const char* nB = has_next ? (const char*)g.Bt + (size_t)nxt.pn * tstep : cB;
        for (int t = 0; t < nt; t += 2) {
            const bool last = (t == nt - 2);
            const char* a1 = cA + (size_t)(t + 1) * kstep;
            const char* a2 = last ? nA : cA + (size_t)(t + 2) * kstep; const char* b2 = last ? nB : cB + (size_t)(t + 2) * kstep;
            const char* a3 = a2 + kstep; const char* b3 = b2 + kstep;
            if constexpr (SP2) {
            PG8_LDB(B0, 0, 0); PG8_LDB(B1, 0, 1); PG8_SCHED; PG8_LDA(At, 0, 0); PG8_STAGE(PG8_SA(1, 1), a1 + hstep, voffA);
            PG8_WAIT_V(8); PG8_WAIT_L(0); PG8_BAR; PG8_MMA(0, 0, At, B0); PG8_MMA(0, 1, At, B1); PG8_BAR; PG8_SCHED;
            PG8_LDA(At, 0, 1); PG8_STAGE(PG8_SB(0, 0), b2, voffB); PG8_STAGE(PG8_SB(0, 1), b2 + hstep, voffB); PG8_STAGE(PG8_SA(0, 0), a2, voffA);
            PG8_WAIT_V(8); PG8_WAIT_L(0); PG8_BAR; PG8_MMA(1, 0, At, B0); PG8_MMA(1, 1, At, B1); PG8_BAR; PG8_SCHED;
            PG8_LDB(B0, 1, 0); PG8_LDB(B1, 1, 1); PG8_SCHED; PG8_LDA(At, 1, 0); PG8_STAGE(PG8_SA(0, 1), a2 + hstep, voffA);
            PG8_WAIT_V(8); PG8_WAIT_L(0); PG8_BAR; PG8_MMA(0, 0, At, B0); PG8_MMA(0, 1, At, B1); PG8_BAR; PG8_SCHED;
            PG8_LDA(At, 1, 1); PG8_STAGE(PG8_SB(1, 0), b3, voffB); PG8_STAGE(PG8_SB(1, 1), b3 + hstep, voffB); PG8_STAGE(PG8_SA(1, 0), a3, voffA);
            PG8_WAIT_V(8); PG8_WAIT_L(0); PG8_BAR; PG8_MMA(1, 0, At, B0); PG8_MMA(1, 1, At, B1); PG8_BAR; PG8_SCHED;
            } else {
            PG8_LDB(B0, 0, 0); PG8_SCHED; PG8_LDA(At, 0, 0); PG8_STAGE(PG8_SA(1, 1), a1 + hstep, voffA);
            PG8_WAIT_L(8); PG8_BAR; PG8_WAIT_L(0); PG8_MMA(0, 0, At, B0); PG8_BAR; PG8_SCHED;
            PG8_LDB(B1, 0, 1); PG8_STAGE(PG8_SB(0, 0), b2, voffB);
            PG8_BAR; PG8_WAIT_L(0); PG8_MMA(0, 1, At, B1); PG8_BAR;
            PG8_LDA(At, 0, 1); PG8_STAGE(PG8_SA(0, 0), a2, voffA);
            PG8_BAR; PG8_WAIT_L(0); PG8_MMA(1, 0, At, B0); PG8_BAR; PG8_SCHED;
            PG8_STAGE(PG8_SB(0, 1), b2 + hstep, voffB);
            PG8_WAIT_V(6); PG8_BAR; PG8_MMA(1, 1, At, B1); PG8_BAR;
            PG8_LDB(B0, 1, 0); PG8_SCHED; PG8_LDA(At, 1, 0); PG8_STAGE(PG8_SA(0, 1), a2 + hstep, voffA);
            PG8_WAIT_L(8); PG8_BAR; PG8_WAIT_L(0); PG8_MMA(0, 0, At, B0); PG8_BAR; PG8_SCHED;
            PG8_LDB(B1, 1, 1); PG8_STAGE(PG8_SB(1, 0), b3, voffB);
            PG8_BAR; PG8_WAIT_L(0); PG8_MMA(0, 1, At, B1); PG8_BAR;
            PG8_LDA(At, 1, 1); PG8_STAGE(PG8_SA(1, 0), a3, voffA);
            PG8_BAR; PG8_WAIT_L(0); PG8_MMA(1, 0, At, B0); PG8_BAR; PG8_SCHED;
            PG8_STAGE(PG8_SB(1, 1), b3 + hstep, voffB);
            PG8_WAIT_V(6); PG8_BAR; PG8_MMA(1, 1, At, B1); PG8_BAR;
            }
        }
        if constexpr (ALIGN_EPI) { if (wr == 0) PG8_BAR; }
        E(acc, cur, wr, wc, fr, fq);
        if (!has_next) break;
#pragma unroll
        for (int a = 0; a < 2; ++a)
#pragma unroll
            for (int b = 0; b < 2; ++b)
#pragma unroll
                for (int m = 0; m < 4; ++m)
#pragma unroll
                    for (int n = 0; n < 2; ++n) acc[a][b][m][n] = (f32x4){0.f, 0.f, 0.f, 0.f};
        cur = nxt; cA = nA; cB = nB; ++ui;
        if constexpr (ALIGN_EPI) { if (wr == 1) PG8_BAR; }
    }
    PG8_WAIT_V(0);
    if constexpr (!ALIGN_EPI) { if (wr == 0) PG8_BAR; }
    PG8_BAR;
#undef PG8_SA
#undef PG8_SB
#undef PG8_STAGE
#undef PG8_LDA
#undef PG8_LDB
#undef PG8_MMA
#undef PG8_WAIT_V
#undef PG8_WAIT_L
#undef PG8_BAR
#undef PG8_SCHED
}

typedef f32x4 AccT[2][2][4][2];
struct EpiF32 {
    static constexpr bool PERM = false;
    float* C; int ldc; bf16_t* Cb;
    __device__ __forceinline__ void operator()(const AccT& acc, const Unit& u, int wr, int wc, int fr, int fq) const {
        const int row0 = u.pm * BM + wr * 64 + fr, col0 = u.pn * BM + wc * 32 + 4 * fq;
#pragma unroll
        for (int ai = 0; ai < 2; ++ai)
#pragma unroll
            for (int m = 0; m < 4; ++m) { float* rowp = C + (size_t)(row0 + ai * HALF + m * 16) * ldc + col0;
#pragma unroll
                for (int bj = 0; bj < 2; ++bj)
#pragma unroll
                    for (int n = 0; n < 2; ++n) { const f32x4 v = acc[ai][bj][m][n]; if (C) *(f32x4*)(rowp + bj * HALF + n * 16) = v;
                        u32x2 w; w.x = pk2(v.x, v.y); w.y = pk2(v.z, v.w); *(u32x2*)(Cb + (size_t)(row0 + ai * HALF + m * 16) * ldc + col0 + bj * HALF + n * 16) = w; } }
    }
};
struct EpiF32Atomic {
    static constexpr bool PERM = false;
    float* C; int ldc;
    __device__ __forceinline__ void operator()(const AccT& acc, const Unit& u, int wr, int wc, int fr, int fq) const {
        const int row0 = u.pm * BM + wr * 64 + fr, col0 = u.pn * BM + wc * 32 + 4 * fq;
#pragma unroll
        for (int ai = 0; ai < 2; ++ai)
#pragma unroll
            for (int m = 0; m < 4; ++m) { float* rowp = C + (size_t)(row0 + ai * HALF + m * 16) * ldc + col0;
#pragma unroll
                for (int bj = 0; bj < 2; ++bj)
#pragma unroll
                    for (int n = 0; n < 2; ++n)
#pragma unroll
                        for (int j = 0; j < 4; ++j) atomicAdd(rowp + bj * HALF + n * 16 + j, acc[ai][bj][m][n][j]); }
    }
};
struct EpiResid {
    static constexpr bool PERM = false;
    const float* base; float* out; const float* gate0; float* rowss;
    __device__ __forceinline__ void operator()(const AccT& acc, const Unit& u, int wr, int wc, int fr, int fq) const {
        const int row0 = u.pm * BM + wr * 64 + fr, col0 = u.pn * BM + wc * 32 + 4 * fq;
        const float* gate = gate0 + (u.pm >> 4) * D6;
        f32x4 gv[2][2];
#pragma unroll
        for (int bj = 0; bj < 2; ++bj)
#pragma unroll
            for (int n = 0; n < 2; ++n) gv[bj][n] = *(const f32x4*)(gate + col0 + bj * HALF + n * 16);
#pragma unroll
        for (int ai = 0; ai < 2; ++ai)
#pragma unroll
            for (int m = 0; m < 4; ++m) { const size_t off = (size_t)(row0 + ai * HALF + m * 16) * D + col0; float ss = 0.f;
#pragma unroll
                for (int bj = 0; bj < 2; ++bj)
#pragma unroll
                    for (int n = 0; n < 2; ++n) { const f32x4 bs = *(const f32x4*)(base + off + bj * HALF + n * 16); const f32x4 xo = bs + gv[bj][n] * acc[ai][bj][m][n]; *(f32x4*)(out + off + bj * HALF + n * 16) = xo;
                        ss += (xo.x * xo.x + xo.y * xo.y) + (xo.z * xo.z + xo.w * xo.w); }
                if (rowss) { const int ln = fr + 16 * fq; ss += shfl_xor_l(ss, 16, ln); ss += shfl_xor_l(ss, 32, ln); if (fq == 0) atomicAdd(rowss + row0 + ai * HALF + m * 16, ss); }
                asm volatile("" ::: "memory"); }
    }
};
struct EpiResidNorm {
    static constexpr bool PERM = true;
    const float* base; float* out; const float* gate0; const float* gp0; bf16_t* XG; float* rowss;
    __device__ __forceinline__ void operator()(const AccT& acc, const Unit& u, int wr, int wc, int fr, int fq) const {
        const int row0 = u.pm * BM + wr * 64 + fr, col0 = u.pn * BM + wc * 32 + 8 * fq, bb = u.pm >> 4, ln = fr + 16 * fq;
        const float* gate = gate0 + bb * D6; const float* gp = gp0 + bb * D;
        f32x4 gv[2][2], pv[2][2];
#pragma unroll
        for (int bj = 0; bj < 2; ++bj)
#pragma unroll
            for (int n = 0; n < 2; ++n) { gv[bj][n] = *(const f32x4*)(gate + col0 + bj * HALF + 4 * n); pv[bj][n] = *(const f32x4*)(gp + col0 + bj * HALF + 4 * n); }
#pragma unroll
        for (int ai = 0; ai < 2; ++ai)
#pragma unroll
            for (int m = 0; m < 4; ++m) { const int row = row0 + ai * HALF + m * 16; const size_t off = (size_t)row * D + col0; float ss = 0.f;
#pragma unroll
                for (int bj = 0; bj < 2; ++bj) {
                    const f32x4 b0 = *(const f32x4*)(base + off + bj * HALF), b1 = *(const f32x4*)(base + off + bj * HALF + 4);
                    const f32x4 x0 = b0 + gv[bj][0] * acc[ai][bj][m][0], x1 = b1 + gv[bj][1] * acc[ai][bj][m][1];
                    *(f32x4*)(out + off + bj * HALF) = x0; *(f32x4*)(out + off + bj * HALF + 4) = x1;
                    ss += (x0.x * x0.x + x0.y * x0.y) + (x0.z * x0.z + x0.w * x0.w) + (x1.x * x1.x + x1.y * x1.y) + (x1.z * x1.z + x1.w * x1.w);
                    const f32x4 y0 = x0 * pv[bj][0], y1 = x1 * pv[bj][1];
                    u32x4 w; w.x = pk2(y0.x, y0.y); w.y = pk2(y0.z, y0.w); w.z = pk2(y1.x, y1.y); w.w = pk2(y1.z, y1.w);
                    *(u32x4*)(XG + off + bj * HALF) = w; }
                ss += shfl_xor_l(ss, 16, ln); ss += shfl_xor_l(ss, 32, ln);
                if (fq == 0) atomicAdd(rowss + row, ss);
                asm volatile("" ::: "memory"); }
    }
};
template <int ACT> struct EpiBf16 {
    static constexpr bool PERM = true;
    bf16_t* O; int ldc; float* stats; int stat_pn0; const float* rowss; const float* bias0;
    __device__ __forceinline__ void operator()(const AccT& acc, const Unit& u, int wr, int wc, int fr, int fq) const {
        const int row0 = u.pm * BM + wr * 64 + fr, col0 = u.pn * BM + wc * 32 + 8 * fq;
        const bool do_stats = (ACT == 1) && (u.pn >= stat_pn0);
        const float* bias = bias0 + (u.pm >> 4) * F2;
        f32x4 bv[2][2];
#pragma unroll
        for (int bj = 0; bj < 2; ++bj)
#pragma unroll
            for (int n = 0; n < 2; ++n) bv[bj][n] = *(const f32x4*)(bias + col0 + bj * HALF + 4 * n);
#pragma unroll
        for (int ai = 0; ai < 2; ++ai)
#pragma unroll
            for (int m = 0; m < 4; ++m) { const int row = row0 + ai * HALF + m * 16; bf16_t* rowp = O + (size_t)row * ldc + col0; float s = 0.f, q = 0.f;
                const float rstd = __builtin_amdgcn_rsqf(rowss[row] * (1.f / D) + 1e-6f);
#pragma unroll
                for (int bj = 0; bj < 2; ++bj) { f32x4 v0 = acc[ai][bj][m][0] * rstd + bv[bj][0], v1 = acc[ai][bj][m][1] * rstd + bv[bj][1];
                    if (ACT == 1) {
#pragma unroll
                        for (int j = 0; j < 4; ++j) { v0[j] = gelu_tanh_f(v0[j]); v1[j] = gelu_tanh_f(v1[j]); s += v0[j] + v1[j]; q += v0[j] * v0[j] + v1[j] * v1[j]; } }
                    u32x4 w; w.x = pk2(v0[0], v0[1]); w.y = pk2(v0[2], v0[3]); w.z = pk2(v1[0], v1[1]); w.w = pk2(v1[2], v1[3]);
                    *(u32x4*)(rowp + bj * HALF) = w; }
                if (ACT == 1) { if (do_stats) { const int ln = fr + 16 * fq; s += shfl_xor_l(s, 16, ln); s += shfl_xor_l(s, 32, ln); q += shfl_xor_l(q, 16, ln); q += shfl_xor_l(q, 32, ln);
                    if (fq == 0) { atomicAdd(stats + 2 * row, s); atomicAdd(stats + 2 * row + 1, q); } } } }
    }
};
struct EpiGlu {
    static constexpr bool PERM = true;
    const bf16_t* Gm; bf16_t* O; const float* bias;
    __device__ __forceinline__ void operator()(const AccT& acc, const Unit& u, int wr, int wc, int fr, int fq) const {
        const int row0 = u.pm * BM + wr * 64 + fr, col0 = u.pn * BM + wc * 32 + 8 * fq;
        f32x4 bv[2][2];
#pragma unroll
        for (int bj = 0; bj < 2; ++bj)
#pragma unroll
            for (int n = 0; n < 2; ++n) bv[bj][n] = *(const f32x4*)(bias + col0 + bj * HALF + 4 * n);
#pragma unroll
        for (int ai = 0; ai < 2; ++ai)
#pragma unroll
            for (int m = 0; m < 4; ++m) { const size_t off = (size_t)(row0 + ai * HALF + m * 16) * D + col0;
#pragma unroll
                for (int bj = 0; bj < 2; ++bj) { const f32x4 v0 = acc[ai][bj][m][0] + bv[bj][0], v1 = acc[ai][bj][m][1] + bv[bj][1];
                    const u32x4 gw = *(const u32x4*)(Gm + off + bj * HALF);
                    u32x4 w;
                    w.x = pk2(bf_lo(gw.x) * sigmoid_f(v0[0]), bf_hi(gw.x) * sigmoid_f(v0[1]));
                    w.y = pk2(bf_lo(gw.y) * sigmoid_f(v0[2]), bf_hi(gw.y) * sigmoid_f(v0[3]));
                    w.z = pk2(bf_lo(gw.z) * sigmoid_f(v1[0]), bf_hi(gw.z) * sigmoid_f(v1[1]));
                    w.w = pk2(bf_lo(gw.w) * sigmoid_f(v1[2]), bf_hi(gw.w) * sigmoid_f(v1[3]));
                    *(u32x4*)(O + off + bj * HALF) = w; } }
    }
};
}

__device__ __forceinline__ void p0_gemv_task(CArgsP a, LAS unsigned char* lds, int tk) {
    const int t = tid_opaque();
    LAS float* sv = (LAS float*)lds;
    LAS float* red = (LAS float*)(lds + 24576);
    const int l = tk / 384, n0 = (tk % 384) * 32;
    const float* c = a->in[1]; const float* cc = a->in[3];
    for (int i = t; i < 3 * D; i += NTHREADS) { const float x = i < 2 * D ? c[i] : cc[i - 2 * D]; sv[i] = silu_f(x); }
    __syncthreads();
    const int cq = t & 7, ks = t >> 3;
    const float* W = a->in[6] + (size_t)l * D * D6 + n0 + 4 * cq;
    f32x4 acc0 = {0.f, 0.f, 0.f, 0.f}, acc1 = acc0, acc2 = acc0;
#pragma unroll 8
    for (int kk = 0; kk < 32; ++kk) { const int k = ks * 32 + kk; const f32x4 w = __builtin_nontemporal_load((const f32x4*)(W + (size_t)k * D6));
        const float s0 = sv[k], s1 = sv[D + k], s2 = sv[2 * D + k]; acc0 += w * s0; acc1 += w * s1; acc2 += w * s2; }
    LAS float* rp = red + ks * 96 + cq * 12;
#pragma unroll
    for (int j = 0; j < 4; ++j) { rp[j] = acc0[j]; rp[4 + j] = acc1[j]; rp[8 + j] = acc2[j]; }
    __syncthreads();
    if (t < 96) { float s = 0.f;
#pragma unroll 8
        for (int j = 0; j < 64; ++j) s += red[j * 96 + t];
        const int q = t / 12, i = t % 12, v = i >> 2, comp = i & 3, n = n0 + 4 * q + comp;
        float* modbuf = (float*)(a->ws + WS_MOD);
        modbuf[(l * 3 + v) * D6 + n] = s + a->in[7][l * D6 + n]; }
    __syncthreads();
}

struct TMat { const float* W; bf16_t* Wt; int K, N; float* bias; const float* shift; };
__device__ __forceinline__ bool tr_decode(CArgsP a, int task, int t_end, TMat& m, int& k0, int& n0) {
    constexpr int C0 = 256, C1 = 512, C2 = 768, C3 = C2 + 1408, C4 = C3 + 1408, C5 = C4 + 704, C6 = C5 + 704, C7 = C6 + 1024, C8 = C7 + 512;
    if (task >= t_end) return false;
    int base;
    float* BI = (float*)(a->ws + WS_BIAS); const float* MD = (const float*)(a->ws + WS_MOD);
    if (task < C0) { m = {a->in[12], (bf16_t*)(a->ws + WS_WIN), D, D, nullptr, nullptr}; base = 0; }
    else if (task < C1) { m = {a->in[21], (bf16_t*)(a->ws + WS_WGLU), D, D, nullptr, nullptr}; base = C0; }
    else if (task < C2) { m = {a->in[23], (bf16_t*)(a->ws + WS_WOUT), D, D, nullptr, nullptr}; base = C1; }
    else if (task < C3) { m = {a->in[8], (bf16_t*)(a->ws + WS_UP0), D, F2, BI, MD + 3 * D}; base = C2; }
    else if (task < C4) { m = {a->in[8] + (size_t)D * F2, (bf16_t*)(a->ws + WS_UP1), D, F2, BI + 4 * F2, MD + 3 * D6 + 3 * D}; base = C3; }
    else if (task < C5) { m = {a->in[11], (bf16_t*)(a->ws + WS_DN0), FF, D, nullptr, nullptr}; base = C4; }
    else if (task < C6) { m = {a->in[11] + (size_t)FF * D, (bf16_t*)(a->ws + WS_DN1), FF, D, nullptr, nullptr}; base = C5; }
    else if (task < C7) { m = {a->in[24], (bf16_t*)(a->ws + WS_SIN_W), D, SD2, BI + 2 * F2, MD + 3 * D6}; base = C6; }
    else { m = {a->in[29], (bf16_t*)(a->ws + WS_SOUT_W), SD, D, nullptr, nullptr}; base = C7; }
    const int idx = task - base, ntn = m.N >> 7;
    k0 = (idx / ntn) * 128; n0 = (idx % ntn) * 128;
    return true;
}
__device__ __forceinline__ void tr_load(const TMat& m, int k0, int n0, int t, f32x4 (&r)[8]) {
    const int c4 = t & 31, rr = t >> 5;
#pragma unroll
    for (int i = 0; i < 8; ++i) r[i] = __builtin_nontemporal_load((const f32x4*)(m.W + (size_t)(k0 + rr + 16 * i) * m.N + n0 + 4 * c4));
}
constexpr int TR_PITCH = 132;
constexpr int TRC_UP1_B = 768 + 1408, TRC_UP1_E = TRC_UP1_B + 1408, TRC_DN1_B = TRC_UP1_E + 704, TRC_DN1_E = TRC_DN1_B + 704, TRC_END = TRC_DN1_E + 1024 + 512;
__device__ __forceinline__ int tr_remap(int v) {
    if (v >= TRC_UP1_B) v += 1408; if (v >= TRC_DN1_B) v += 704; return v; }
__device__ __forceinline__ void tr_step(LAS float* tile, LAS float* shl, int t, f32x4 (&r)[8], const TMat& m, int k0, int n0, bool nok, const TMat& nm, int nk0, int nn0) {
    { const int c4 = t & 31, rr = t >> 5;
#pragma unroll
      for (int i = 0; i < 8; ++i) *(LAS f32x4*)(tile + (rr + 16 * i) * TR_PITCH + 4 * c4) = r[i];
      if (m.bias && t < 256) shl[t] = m.shift[(t >> 7) * D6 + k0 + (t & 127)]; }
    __syncthreads();
    if (nok) tr_load(nm, nk0, nn0, t, r);
    { const int n = t & 127, kq = t >> 7; const LAS float* s = tile + (32 * kq) * TR_PITCH + n;
      bf16_t* dst = m.Wt + (size_t)(n0 + n) * m.K + k0 + 32 * kq;
#pragma unroll
      for (int h = 0; h < 4; ++h) { u32x4 o0;
        o0.x = pk2(s[(8 * h + 0) * TR_PITCH], s[(8 * h + 1) * TR_PITCH]); o0.y = pk2(s[(8 * h + 2) * TR_PITCH], s[(8 * h + 3) * TR_PITCH]);
        o0.z = pk2(s[(8 * h + 4) * TR_PITCH], s[(8 * h + 5) * TR_PITCH]); o0.w = pk2(s[(8 * h + 6) * TR_PITCH], s[(8 * h + 7) * TR_PITCH]);
        *(u32x4*)(dst + 8 * h) = o0; }
      if (m.bias) { float p0 = 0.f, p1 = 0.f;
#pragma unroll 8
        for (int i = 0; i < 32; ++i) { const float w = s[i * TR_PITCH]; p0 += w * shl[32 * kq + i]; p1 += w * shl[128 + 32 * kq + i]; }
        atomicAdd(m.bias + n0 + n, p0); atomicAdd(m.bias + F2 + n0 + n, p1); } }
    __syncthreads();
}
template <int MODE>
__device__ __forceinline__ void p0_transpose_all(CArgsP a, LAS unsigned char* lds, int first, int stride, int t_end) {
    const int t = tid_opaque();
    LAS float* tile = (LAS float*)lds;
    LAS float* shl = (LAS float*)(lds + 128 * TR_PITCH * 4);
    TMat ma, mb; int ka, na, kb, nb; f32x4 ra[8], rb[8];
    int task = first;
    bool oka = tr_decode(a, MODE == 1 ? tr_remap(task) : task, t_end, ma, ka, na); if (oka) tr_load(ma, ka, na, t, ra);
    task += stride;
    bool okb = tr_decode(a, MODE == 1 ? tr_remap(task) : task, t_end, mb, kb, nb); if (okb) tr_load(mb, kb, nb, t, rb);
    while (oka) {
        { TMat nm; int nk, nn; task += stride; const bool nok = tr_decode(a, MODE == 1 ? tr_remap(task) : task, t_end, nm, nk, nn);
          tr_step(tile, shl, t, ra, ma, ka, na, nok, nm, nk, nn); oka = nok; ma = nm; ka = nk; na = nn; }
        if (!okb) break;
        { TMat nm; int nk, nn; task += stride; const bool nok = tr_decode(a, MODE == 1 ? tr_remap(task) : task, t_end, nm, nk, nn);
          tr_step(tile, shl, t, rb, mb, kb, nb, nok, nm, nk, nn); okb = nok; mb = nm; kb = nk; nb = nn; }
    }
}

__device__ __forceinline__ void sincos_d(double x, double& s, double& c) {
    const double k = __builtin_rint(x * 0.63661977236758134308);
    double r = __builtin_fma(-k, 1.57079632679489655800e+00, x);
    r = __builtin_fma(-k, 6.12323399573676603587e-17, r);
    const double r2 = r * r;
    double sp = -7.6471637318198164759e-13; sp = sp * r2 + 1.6059043836821614599e-10; sp = sp * r2 - 2.5052108385441718775e-08; sp = sp * r2 + 2.7557319223985890653e-06;
    sp = sp * r2 - 1.9841269841269841270e-04; sp = sp * r2 + 8.3333333333333333333e-03; sp = sp * r2 - 1.6666666666666666667e-01; sp = r + r * r2 * sp;
    double cp = 4.7794773323873852974e-14; cp = cp * r2 - 1.1470745597729724714e-11; cp = cp * r2 + 2.0876756987868098979e-09; cp = cp * r2 - 2.7557319223985890653e-07;
    cp = cp * r2 + 2.4801587301587301587e-05; cp = cp * r2 - 1.3888888888888888889e-03; cp = cp * r2 + 4.1666666666666666667e-02; cp = cp * r2 - 0.5; cp = 1.0 + r2 * cp;
    const int q = ((int)(long long)k) & 3;
    s = (q == 0) ? sp : (q == 1) ? cp : (q == 2) ? -sp : -cp;
    c = (q == 0) ? cp : (q == 1) ? -sp : (q == 2) ? -cp : sp;
}
__device__ __forceinline__ double exp_d(double x) {
    const double k = __builtin_rint(x * 1.44269504088896340736);
    double r = __builtin_fma(-k, 6.93147180369123816490e-01, x);
    r = __builtin_fma(-k, 1.90821492927058770002e-10, r);
    double p = 1.0 / 479001600.0;
    p = p * r + 1.0 / 39916800.0; p = p * r + 1.0 / 3628800.0; p = p * r + 1.0 / 362880.0; p = p * r + 1.0 / 40320.0; p = p * r + 1.0 / 5040.0;
    p = p * r + 1.0 / 720.0; p = p * r + 1.0 / 120.0; p = p * r + 1.0 / 24.0; p = p * r + 1.0 / 6.0; p = p * r + 0.5; p = p * r + 1.0; p = p * r + 1.0;
    const long long e = (long long)k + 1023;
    return p * __builtin_bit_cast(double, (unsigned long long)e << 52);
}
__device__ __forceinline__ void p0_s5_tables(CArgsP a, int idx) {
    const int d = idx >> 13, g = (idx >> 6) & 127, p = idx & 63, gd = g * 2 + d;
    const double are = a->in[13][idx], aim = a->in[14][idx];
    const double dt = exp_d((double)a->in[19][d * NG + g]);
    const double mag = exp_d(are * dt); double sn, cs; sincos_d(aim * dt, sn, cs);
    const double lr = mag * cs, li = mag * sn, den = are * are + aim * aim;
    const double kr = ((lr - 1.0) * are + li * aim) / den, ki = (li * are - (lr - 1.0) * aim) / den;
    const double magT = exp_d(are * dt * (double)TC); double snT, csT; sincos_d(aim * dt * (double)TC, snT, csT);
    f32x2* lam = (f32x2*)(a->ws + WS_LAM); f32x2* lamT = (f32x2*)(a->ws + WS_LAMT);
    lam[gd * 64 + p] = (f32x2){(float)lr, (float)li};
    lamT[gd * 64 + p] = (f32x2){(float)(magT * csT), (float)(magT * snT)};
    bf16_t* Bcat = (bf16_t*)(a->ws + WS_BCAT) + (size_t)(gd * 128 + 2 * p) * 16;
    const float* bre = a->in[15] + (size_t)idx * 16; const float* bim = a->in[16] + (size_t)idx * 16;
#pragma unroll
    for (int h = 0; h < 16; h += 2) {
        const double br0 = bre[h], bi0 = bim[h], br1 = bre[h + 1], bi1 = bim[h + 1];
        *(unsigned*)(Bcat + h) = pk2((float)(kr * br0 - ki * bi0), (float)(kr * br1 - ki * bi1));
        *(unsigned*)(Bcat + 16 + h) = pk2((float)(kr * bi0 + ki * br0), (float)(kr * bi1 + ki * br1));
    }
    bf16_t* Cc = (bf16_t*)(a->ws + WS_CCAT);
    const float* cre = a->in[17] + (size_t)(d * NG + g) * 16 * 64 + p; const float* cim = a->in[18] + (size_t)(d * NG + g) * 16 * 64 + p;
#pragma unroll
    for (int part = 0; part < 2; ++part) {
        const int R = 2 * p + part, tau = R >> 5, rho = R & 31, s = rho >> 4, hh = (rho >> 2) & 1, j = ((rho >> 3) & 1) * 4 + (rho & 3);
        bf16_t* dst = Cc + ((size_t)(((gd * 4 + tau) * 2 + s) * 2 + hh) * 16) * 8 + j;
        for (int h = 0; h < 16; ++h) dst[h * 8] = f2bf(part == 0 ? cre[h * 64] : -cim[h * 64]);
    }
}

__device__ __forceinline__ void p0_s5_kend(CArgsP a, int idx, int seg) {
    const int d = idx >> 13, g = (idx >> 6) & 127, p = idx & 63, gd = g * 2 + d;
    const double are = a->in[13][idx], aim = a->in[14][idx];
    const double dt = exp_d((double)a->in[19][d * NG + g]);
    const double mag = exp_d(are * dt); double sn, cs; sincos_d(aim * dt, sn, cs);
    const double lr = mag * cs, li = mag * sn, den = are * are + aim * aim;
    const double kr = ((lr - 1.0) * are + li * aim) / den, ki = (li * are - (lr - 1.0) * aim) / den;
    const int t_lo = seg == 0 ? 0 : seg == 1 ? 9 : seg == 2 ? 18 : 26, t_hi = seg == 0 ? 9 : seg == 1 ? 18 : seg == 2 ? 26 : 34;
    const double pw = (double)(TC - t_hi);
    const double magP = exp_d(are * dt * pw); double snP, csP; sincos_d(aim * dt * pw, snP, csP);
    double pr = magP * csP, pi = magP * snP;
    float bbr[16], bbi[16];
    const float* bre = a->in[15] + (size_t)idx * 16; const float* bim = a->in[16] + (size_t)idx * 16;
#pragma unroll
    for (int h = 0; h < 16; ++h) { const double br = bre[h], bi = bim[h]; bbr[h] = (float)(kr * br - ki * bi); bbi[h] = (float)(kr * bi + ki * br); }
    for (int tt = t_hi - 1; tt >= t_lo; --tt) {
        const float fr = (float)pr, fi = (float)pi;
        bf16_t* dst = (bf16_t*)(a->ws + WS_KEND) + (((size_t)gd * TC + tt) * 128 + 2 * p) * 16;
        u32x4 w0, w1, w2, w3;
        w0.x = pk2(fr * bbr[0] - fi * bbi[0], fr * bbr[1] - fi * bbi[1]); w0.y = pk2(fr * bbr[2] - fi * bbi[2], fr * bbr[3] - fi * bbi[3]);
        w0.z = pk2(fr * bbr[4] - fi * bbi[4], fr * bbr[5] - fi * bbi[5]); w0.w = pk2(fr * bbr[6] - fi * bbi[6], fr * bbr[7] - fi * bbi[7]);
        w1.x = pk2(fr * bbr[8] - fi * bbi[8], fr * bbr[9] - fi * bbi[9]); w1.y = pk2(fr * bbr[10] - fi * bbi[10], fr * bbr[11] - fi * bbi[11]);
        w1.z = pk2(fr * bbr[12] - fi * bbi[12], fr * bbr[13] - fi * bbi[13]); w1.w = pk2(fr * bbr[14] - fi * bbi[14], fr * bbr[15] - fi * bbi[15]);
        w2.x = pk2(fr * bbi[0] + fi * bbr[0], fr * bbi[1] + fi * bbr[1]); w2.y = pk2(fr * bbi[2] + fi * bbr[2], fr * bbi[3] + fi * bbr[3]);
        w2.z = pk2(fr * bbi[4] + fi * bbr[4], fr * bbi[5] + fi * bbr[5]); w2.w = pk2(fr * bbi[6] + fi * bbr[6], fr * bbi[7] + fi * bbr[7]);
        w3.x = pk2(fr * bbi[8] + fi * bbr[8], fr * bbi[9] + fi * bbr[9]); w3.y = pk2(fr * bbi[10] + fi * bbr[10], fr * bbi[11] + fi * bbr[11]);
        w3.z = pk2(fr * bbi[12] + fi * bbr[12], fr * bbi[13] + fi * bbr[13]); w3.w = pk2(fr * bbi[14] + fi * bbr[14], fr * bbi[15] + fi * bbr[15]);
        *(u32x4*)dst = w0; *(u32x4*)(dst + 8) = w1; *(u32x4*)(dst + 16) = w2; *(u32x4*)(dst + 24) = w3;
        const double nr = pr * lr - pi * li, ni = pr * li + pi * lr; pr = nr; pi = ni;
    }
}

template <bool OUT_F32, int NR>
__device__ __forceinline__ void norm_rows(const float* (&src)[NR], const float* g, const float* (&shift)[NR], void* (&dst)[NR], const bool (&valid)[NR], int lane) {
    f32x4 v[NR][8];
#pragma unroll
    for (int r = 0; r < NR; ++r)
#pragma unroll
        for (int j = 0; j < 8; ++j) v[r][j] = __builtin_nontemporal_load((const f32x4*)src[r] + lane + 64 * j);
#pragma unroll
    for (int r = 0; r < NR; ++r) {
        float ss = 0.f;
#pragma unroll
        for (int j = 0; j < 8; ++j) ss += (v[r][j].x * v[r][j].x + v[r][j].y * v[r][j].y) + (v[r][j].z * v[r][j].z + v[r][j].w * v[r][j].w);
        ss = wave_sum(ss, lane);
        const float rstd = __builtin_amdgcn_rsqf(ss * (1.f / D) + 1e-6f);
        if (valid[r]) {
#pragma unroll
            for (int j = 0; j < 8; ++j) {
                const f32x4 gv = ((const f32x4*)g)[lane + 64 * j]; f32x4 y = v[r][j] * rstd * gv;
                if (OUT_F32) ((f32x4*)dst[r])[lane + 64 * j] = y;
                else { const f32x4 sh = ((const f32x4*)shift[r])[lane + 64 * j], sc = ((const f32x4*)(shift[r] + D))[lane + 64 * j]; y = y * (sc + 1.f) + sh;
                    u32x2 w; w.x = pk2(y.x, y.y); w.y = pk2(y.z, y.w); ((u32x2*)dst[r])[lane + 64 * j] = w; }
            }
        }
    }
}

#define MFMA32(a, b, c) __builtin_amdgcn_mfma_f32_32x32x16_bf16((a), (b), (c), 0, 0, 0)
__device__ __forceinline__ bf16x8 pack8(const f32x4& a, const f32x4& b) { u32x4 p; p.x = pk2(a.x, a.y); p.y = pk2(a.z, a.w); p.z = pk2(b.x, b.y); p.w = pk2(b.z, b.w); return __builtin_bit_cast(bf16x8, p); }
template <bool PASSB>
__device__ __forceinline__ void s5_pass(CArgsP a, LAS unsigned char* lds, int gw, int nw, int lane) {
    LAS unsigned char* cfl = lds + tid_opaque() * 16;
    LAS unsigned char* lamL = lds + 65536 + (tid_opaque() >> 6) * 512;
    const bf16_t* U = (const bf16_t*)(a->ws + WS_UB);
    const f32x2* lam = (const f32x2*)(a->ws + WS_LAM);
    const bf16_t* Bcat = (const bf16_t*)(a->ws + WS_BCAT);
    const bf16_t* Cc = (const bf16_t*)(a->ws + WS_CCAT);
    for (int item = gw; item < 2048; item += nw) {
        const int g = item & 127, tile = (item >> 7) & 7, d = item >> 10, gd = g * 2 + d;
        const int r = lane & 31, hh = lane >> 5, col = tile * 32 + r, b = col >> 7, c = col & 127;
        bf16x8 Bf[4];
#pragma unroll
        for (int tau = 0; tau < 4; ++tau) Bf[tau] = *(const bf16x8*)(Bcat + (size_t)(gd * 128 + 32 * tau + r) * 16 + 8 * hh);
        { const int p = lane, tau = p >> 4, pl = p & 15, q = ((pl >> 2) << 1) | (pl & 1), h2 = (pl >> 1) & 1;
          *(LAS f32x2*)(lamL + ((tau * 2 + h2) * 8 + q) * 8) = lam[gd * 64 + p]; }
        f32x16 S[4];
        float* Ebuf = (float*)(a->ws + (PASSB ? WS_SI : WS_E)) + ((size_t)gd * NCOL + col) * 128 + 4 * hh;
        if (PASSB) {
#pragma unroll
            for (int tau = 0; tau < 4; ++tau)
#pragma unroll
                for (int i4 = 0; i4 < 4; ++i4) { const f32x4 v = __builtin_nontemporal_load((const f32x4*)(Ebuf + 32 * tau + 8 * i4)); S[tau][4 * i4] = v.x; S[tau][4 * i4 + 1] = v.y; S[tau][4 * i4 + 2] = v.z; S[tau][4 * i4 + 3] = v.w; }
        } else {
#pragma unroll
            for (int tau = 0; tau < 4; ++tau)
#pragma unroll
                for (int i = 0; i < 16; ++i) S[tau][i] = 0.f;
        }
        if (PASSB) {
#pragma unroll
            for (int tau = 0; tau < 4; ++tau)
#pragma unroll
                for (int s = 0; s < 2; ++s) {
                    u32x4 z = {0u, 0u, 0u, 0u};
                    if (r < 16) z = *(const u32x4*)(Cc + ((size_t)((((gd * 4 + tau) * 2 + s) * 2 + hh) * 16 + r)) * 8);
                    *(LAS u32x4*)(cfl + (tau * 2 + s) * 8192) = z;
                }
        }
        bf16_t* Yd = (bf16_t*)(a->ws + (d == 0 ? WS_YF : WS_YR));
        const int pos0 = TC * c;
        auto memidx = [&](int pos) -> int { return d == 0 ? pos : (pos < CTXL ? (CTXL - 1 - pos) : (LT + CTXL - 1 - pos)); };
        const bf16_t* ub = U + (size_t)b * LT * D + g * 16 + 8 * hh;
        auto ldu = [&](int mem) -> bf16x8 { return *(const bf16x8*)(ub + (size_t)mem * D); };
        bf16x8 un[8];
#pragma unroll
        for (int j = 0; j < 8; ++j) un[j] = ldu(memidx(pos0 + j));
#pragma unroll 1
        for (int tb = 0; tb < TC; tb += 8) {
#pragma unroll
          for (int j = 0; j < 8; j += 2) {
            const int t = tb + j;
            if (t < TC) {
            asm volatile("" ::: "memory");
            const bf16x8 ufa = un[j], ufb = un[j + 1];
            const int posa = pos0 + t, mema = memidx(posa), memb = memidx(posa + 1);
            if (t + 8 < TC) { un[j] = ldu(memidx(posa + 8)); un[j + 1] = ldu(memidx(posa + 9)); }
            f32x16 Ya, Yb;
#pragma unroll
            for (int i = 0; i < 16; ++i) { Ya[i] = 0.f; Yb[i] = 0.f; }
#pragma unroll
            for (int tau = 0; tau < 4; ++tau) {
                const LAS f32x4* lp = (const LAS f32x4*)(lamL + (tau * 2 + hh) * 64);
                const f32x4 l0 = lp[0], l1 = lp[1], l2 = lp[2], l3 = lp[3];
                const float lrr[8] = {l0.x, l0.z, l1.x, l1.z, l2.x, l2.z, l3.x, l3.z}, lii[8] = {l0.y, l0.w, l1.y, l1.w, l2.y, l2.w, l3.y, l3.w};
                bf16x8 cf0, cf1;
                if (PASSB) { cf0 = *(const LAS bf16x8*)(cfl + (tau * 2 + 0) * 8192); cf1 = *(const LAS bf16x8*)(cfl + (tau * 2 + 1) * 8192); }
#pragma unroll
                for (int half = 0; half < 2; ++half) {
                    f32x16 C;
#pragma unroll
                    for (int q = 0; q < 8; ++q) { const float sr = S[tau][2 * q], si = S[tau][2 * q + 1];
                        C[2 * q] = lrr[q] * sr - lii[q] * si; C[2 * q + 1] = lrr[q] * si + lii[q] * sr; }
                    S[tau] = MFMA32(Bf[tau], half == 0 ? ufa : ufb, C);
                    if (PASSB) {
                        u32x4 p0, p1;
                        p0.x = pk2(S[tau][0], S[tau][1]); p0.y = pk2(S[tau][2], S[tau][3]); p0.z = pk2(S[tau][4], S[tau][5]); p0.w = pk2(S[tau][6], S[tau][7]);
                        p1.x = pk2(S[tau][8], S[tau][9]); p1.y = pk2(S[tau][10], S[tau][11]); p1.z = pk2(S[tau][12], S[tau][13]); p1.w = pk2(S[tau][14], S[tau][15]);
                        if (half == 0) { Ya = MFMA32(cf0, __builtin_bit_cast(bf16x8, p0), Ya); Ya = MFMA32(cf1, __builtin_bit_cast(bf16x8, p1), Ya); }
                        else { Yb = MFMA32(cf0, __builtin_bit_cast(bf16x8, p0), Yb); Yb = MFMA32(cf1, __builtin_bit_cast(bf16x8, p1), Yb); }
                    }
                }
            }
            if (PASSB) {
                if (posa >= CTXL) {
                    bf16_t* yp = Yd + ((size_t)b * SEQ + (mema - CTXL)) * D + g * 16 + 4 * hh;
                    u32x2 w0, w1; w0.x = pk2(Ya[0], Ya[1]); w0.y = pk2(Ya[2], Ya[3]); w1.x = pk2(Ya[4], Ya[5]); w1.y = pk2(Ya[6], Ya[7]);
                    *(u32x2*)yp = w0; *(u32x2*)(yp + 8) = w1;
                }
                if (posa + 1 >= CTXL) {
                    bf16_t* yp = Yd + ((size_t)b * SEQ + (memb - CTXL)) * D + g * 16 + 4 * hh;
                    u32x2 w0, w1; w0.x = pk2(Yb[0], Yb[1]); w0.y = pk2(Yb[2], Yb[3]); w1.x = pk2(Yb[4], Yb[5]); w1.y = pk2(Yb[6], Yb[7]);
                    *(u32x2*)yp = w0; *(u32x2*)(yp + 8) = w1;
                }
            }
            }
          }
        }
        if (!PASSB) {
#pragma unroll
            for (int tau = 0; tau < 4; ++tau)
#pragma unroll
                for (int i4 = 0; i4 < 4; ++i4) *(f32x4*)(Ebuf + 32 * tau + 8 * i4) = (f32x4){S[tau][4 * i4], S[tau][4 * i4 + 1], S[tau][4 * i4 + 2], S[tau][4 * i4 + 3]};
        }
    }
}

__device__ __forceinline__ void s5_passA(CArgsP a, int gw, int nw, int lane) {
    const bf16_t* U = (const bf16_t*)(a->ws + WS_UB);
    const bf16_t* KE = (const bf16_t*)(a->ws + WS_KEND);
    for (int item = gw; item < 2048; item += nw) {
        const int g = item & 127, tile = (item >> 7) & 7, d = item >> 10, gd = g * 2 + d;
        const int r = lane & 31, hh = lane >> 5, col = tile * 32 + r, b = col >> 7, c = col & 127;
        f32x16 S[4];
#pragma unroll
        for (int tau = 0; tau < 4; ++tau)
#pragma unroll
            for (int i = 0; i < 16; ++i) S[tau][i] = 0.f;
        float* Ebuf = (float*)(a->ws + WS_E) + ((size_t)gd * NCOL + col) * 128 + 4 * hh;
        const int pos0 = TC * c;
        auto memidx = [&](int pos) -> int { return d == 0 ? pos : (pos < CTXL ? (CTXL - 1 - pos) : (LT + CTXL - 1 - pos)); };
        const bf16_t* ub = U + (size_t)b * LT * D + g * 16 + 8 * hh;
        const bf16_t* kb = KE + ((size_t)gd * TC * 128 + r) * 16 + 8 * hh;
        bf16x8 un[8], af[4][4];
#pragma unroll
        for (int j = 0; j < 8; ++j) un[j] = *(const bf16x8*)(ub + (size_t)memidx(pos0 + j) * D);
#pragma unroll
        for (int j = 0; j < 4; ++j)
#pragma unroll
            for (int tau = 0; tau < 4; ++tau) af[j][tau] = __builtin_nontemporal_load((const bf16x8*)(kb + ((size_t)j * 128 + 32 * tau) * 16));
#pragma unroll 1
        for (int tb = 0; tb < TC; tb += 8) {
#pragma unroll
            for (int j = 0; j < 8; ++j) {
                const int t = tb + j;
                if (t < TC) {
                    const bf16x8 uf = un[j];
                    const bf16x8 a0 = af[j & 3][0], a1 = af[j & 3][1], a2 = af[j & 3][2], a3 = af[j & 3][3];
                    if (t + 8 < TC) un[j] = *(const bf16x8*)(ub + (size_t)memidx(pos0 + t + 8) * D);
                    if (t + 4 < TC) {
#pragma unroll
                        for (int tau = 0; tau < 4; ++tau) af[j & 3][tau] = __builtin_nontemporal_load((const bf16x8*)(kb + ((size_t)(t + 4) * 128 + 32 * tau) * 16)); }
                    S[0] = MFMA32(a0, uf, S[0]); S[1] = MFMA32(a1, uf, S[1]); S[2] = MFMA32(a2, uf, S[2]); S[3] = MFMA32(a3, uf, S[3]);
                }
            }
        }
#pragma unroll
        for (int tau = 0; tau < 4; ++tau)
#pragma unroll
            for (int i4 = 0; i4 < 4; ++i4) *(f32x4*)(Ebuf + 32 * tau + 8 * i4) = (f32x4){S[tau][4 * i4], S[tau][4 * i4 + 1], S[tau][4 * i4 + 2], S[tau][4 * i4 + 3]};
    }
}

__device__ __forceinline__ float dot2bf(unsigned z, unsigned w, float acc) { return __builtin_amdgcn_fdot2_f32_bf16(__builtin_bit_cast(bf16x2v, z), __builtin_bit_cast(bf16x2v, w), acc, false); }
__device__ __forceinline__ void conv_phase(CArgsP a, LAS unsigned char* lds, int layer, int first, int stride) {
    const int t0 = tid_opaque();
    const bf16_t* Z = (const bf16_t*)(a->ws + WS_Z); bf16_t* A3 = (bf16_t*)(a->ws + WS_A3);
    const float* cw = a->in[9] + (size_t)layer * 9 * F2; const float* cb = a->in[10] + (size_t)layer * F2;
    LAS unsigned* wl = (LAS unsigned*)lds;
    for (int task = first; task < 704; task += stride) {
        const int t = launder_i(t0), o = t & 15, c = (t >> 4) + 32 * ((task / 44) & 1);
        const int cbk = task % 44, rb = (task / 88) & 3, b = task / 352;
        __syncthreads();
#pragma unroll
        for (int it = 0; it < 5; ++it) { const int i = t + it * NTHREADS; { const int tap = i >> 8, half = (i >> 7) & 1, ch = i & 127; const int gch = half * FF + cbk * 128 + ch;
            const float wv = tap < 9 ? cw[(size_t)tap * F2 + gch] : cb[gch];
            wl[i] = tap < 9 ? ((ch & 1) ? (pk2(0.f, wv)) : (pk2(wv, 0.f))) : __builtin_bit_cast(unsigned, wv); } }
        __syncthreads();
        const u32x4 zero4 = {0u, 0u, 0u, 0u};
        u32x4 win[6][3][2];
        const size_t chg = (size_t)cbk * 128 + 8 * o;
        auto ldrow = [&](int rrow, u32x4 (&w)[3][2]) {
#pragma unroll
            for (int dj = 0; dj < 3; ++dj) { const int cc2 = c + dj - 1; const bool ok = (rrow >= 0) && (rrow < 64) && (cc2 >= 0) && (cc2 < 64);
                if (ok) { const bf16_t* zp = Z + ((size_t)b * SEQ + rrow * 64 + cc2) * F2 + chg; w[dj][0] = *(const u32x4*)zp; w[dj][1] = *(const u32x4*)(zp + FF); }
                else { w[dj][0] = zero4; w[dj][1] = zero4; } }
        };
        const int r0 = rb * 16;
        ldrow(r0 - 1, win[0]); ldrow(r0, win[1]); ldrow(r0 + 1, win[2]); ldrow(r0 + 2, win[3]);
#pragma unroll
        for (int q = 0; q < 8; ++q) {
                asm volatile("" ::: "memory");
                const int row = r0 + 2 * q;
                if (q <= 6) { ldrow(row + 3, win[(2 * q + 4) % 6]); ldrow(row + 4, win[(2 * q + 5) % 6]); }
                float ag[2][8], av[2][8];
                { const LAS f32x4* bp = (const LAS f32x4*)(wl + 9 * 256 + 8 * o); const f32x4 b0 = bp[0], b1 = bp[1], b2 = bp[32], b3 = bp[33];
#pragma unroll
                  for (int rr = 0; rr < 2; ++rr)
#pragma unroll
                  for (int j = 0; j < 4; ++j) { ag[rr][j] = b0[j]; ag[rr][4 + j] = b1[j]; av[rr][j] = b2[j]; av[rr][4 + j] = b3[j]; } }
#pragma unroll
                for (int di = 0; di < 3; ++di)
#pragma unroll
                    for (int dj = 0; dj < 3; ++dj) {
                        asm volatile("" ::: "memory");
                        const LAS u32x4* wp = (const LAS u32x4*)(wl + (di * 3 + dj) * 256 + 8 * o);
                        const u32x4 wg0 = wp[0], wg1 = wp[1], wv0 = wp[32], wv1 = wp[33];
#pragma unroll
                        for (int rr = 0; rr < 2; ++rr) {
                            const u32x4 zg = win[(2 * q + rr + di) % 6][dj][0], zv = win[(2 * q + rr + di) % 6][dj][1];
                            ag[rr][0] = dot2bf(zg.x, wg0.x, ag[rr][0]); ag[rr][1] = dot2bf(zg.x, wg0.y, ag[rr][1]); ag[rr][2] = dot2bf(zg.y, wg0.z, ag[rr][2]); ag[rr][3] = dot2bf(zg.y, wg0.w, ag[rr][3]);
                            ag[rr][4] = dot2bf(zg.z, wg1.x, ag[rr][4]); ag[rr][5] = dot2bf(zg.z, wg1.y, ag[rr][5]); ag[rr][6] = dot2bf(zg.w, wg1.z, ag[rr][6]); ag[rr][7] = dot2bf(zg.w, wg1.w, ag[rr][7]);
                            av[rr][0] = dot2bf(zv.x, wv0.x, av[rr][0]); av[rr][1] = dot2bf(zv.x, wv0.y, av[rr][1]); av[rr][2] = dot2bf(zv.y, wv0.z, av[rr][2]); av[rr][3] = dot2bf(zv.y, wv0.w, av[rr][3]);
                            av[rr][4] = dot2bf(zv.z, wv1.x, av[rr][4]); av[rr][5] = dot2bf(zv.z, wv1.y, av[rr][5]); av[rr][6] = dot2bf(zv.w, wv1.z, av[rr][6]); av[rr][7] = dot2bf(zv.w, wv1.w, av[rr][7]);
                        }
                    }
#pragma unroll
                for (int rr = 0; rr < 2; ++rr) {
                    u32x4 w;
                    w.x = pk2(silu_f(ag[rr][0]) * av[rr][0], silu_f(ag[rr][1]) * av[rr][1]); w.y = pk2(silu_f(ag[rr][2]) * av[rr][2], silu_f(ag[rr][3]) * av[rr][3]);
                    w.z = pk2(silu_f(ag[rr][4]) * av[rr][4], silu_f(ag[rr][5]) * av[rr][5]); w.w = pk2(silu_f(ag[rr][6]) * av[rr][6], silu_f(ag[rr][7]) * av[rr][7]);
                    *(u32x4*)(A3 + ((size_t)b * SEQ + (row + rr) * 64 + c) * FF + chg) = w; }
        }
    }
}

constexpr int SP_PITCH = 136;
constexpr int SP_WS_OFF = 0, SP_VT_OFF = 128 * SP_PITCH * 2  , SP_O_OFF = SP_VT_OFF  , SP_OPITCH = 264;
__device__ __forceinline__ void spatial_phase(CArgsP a, LAS unsigned char* lds, int first, int stride) {
    const int t = tid_opaque(), lane = t & 63, wid = t >> 6;
    const bf16_t* ZS = (const bf16_t*)(a->ws + WS_ZS); bf16_t* GT = (bf16_t*)(a->ws + WS_GT);
    const float* st = (const float*)(a->ws + WS_LNST);
    const float* lng = a->in[25]; const float* lnb = a->in[26]; const float* wsp = a->in[27]; const float* bsp = a->in[28];
    LAS bf16_t* Ws = (LAS bf16_t*)(lds + SP_WS_OFF); LAS bf16_t* Vt = (LAS bf16_t*)(lds + SP_VT_OFF); LAS bf16_t* Ot = (LAS bf16_t*)(lds + SP_O_OFF);
    int g_loaded = -1;
    u32x4 va[4], vb[4]; f32x4 st4[4];
    auto load_v = [&](int item) {
        const int g = item & 15, cn = item >> 4; const size_t tok0 = (size_t)cn * 128;
#pragma unroll
        for (int it = 0; it < 4; ++it) { const int i = t + it * NTHREADS; const int oc = i & 3, kp = (i >> 2) & 63, og = i >> 8, c0 = (og * 4 + oc) * 8;
            const size_t ra = tok0 + 2 * kp;
            va[it] = __builtin_nontemporal_load((const u32x4*)(ZS + ra * SD2 + SD + g * 256 + c0)); vb[it] = __builtin_nontemporal_load((const u32x4*)(ZS + (ra + 1) * SD2 + SD + g * 256 + c0));
            st4[it] = *(const f32x4*)(st + 2 * ra); }
    };
    if (first < 1024) load_v(first);
    for (int item = first; item < 1024; item += stride) {
        const int g = item & 15, cn = item >> 4;
        const size_t tok0 = (size_t)cn * 128;
        __syncthreads();
        if (g != g_loaded) { g_loaded = g;
        for (int i = t; i < 128 * 32; i += NTHREADS) { const int q = i >> 5, k4 = i & 31; const f32x4 w = *(const f32x4*)(wsp + ((size_t)g * 128 + q) * 128 + 4 * k4);
            u32x2 pw; pw.x = pk2(w.x, w.y); pw.y = pk2(w.z, w.w); *(LAS u32x2*)(Ws + q * SP_PITCH + 4 * k4) = pw; } }
#pragma unroll
        for (int it = 0; it < 4; ++it) {
            const int i = t + it * NTHREADS; const int oc = i & 3, kp = (i >> 2) & 63, og = i >> 8, c0 = (og * 4 + oc) * 8;
            const float mua = st4[it].x * (1.f / SD), mub = st4[it].z * (1.f / SD);
            const float rsa = __builtin_amdgcn_rsqf(st4[it].y * (1.f / SD) - mua * mua + 1e-5f), rsb = __builtin_amdgcn_rsqf(st4[it].w * (1.f / SD) - mub * mub + 1e-5f);
            const f32x4 g0 = *(const f32x4*)(lng + g * 256 + c0), g1 = *(const f32x4*)(lng + g * 256 + c0 + 4), b0 = *(const f32x4*)(lnb + g * 256 + c0), b1 = *(const f32x4*)(lnb + g * 256 + c0 + 4);
            const unsigned wa[4] = {va[it].x, va[it].y, va[it].z, va[it].w}, wb[4] = {vb[it].x, vb[it].y, vb[it].z, vb[it].w};
#pragma unroll
            for (int j = 0; j < 4; ++j) {
                const float gl = j < 2 ? g0[2 * j] : g1[2 * j - 4], gh = j < 2 ? g0[2 * j + 1] : g1[2 * j - 3];
                const float bl = j < 2 ? b0[2 * j] : b1[2 * j - 4], bh = j < 2 ? b0[2 * j + 1] : b1[2 * j - 3];
                const float al = (bf_lo(wa[j]) - mua) * rsa * gl + bl, ah = (bf_hi(wa[j]) - mua) * rsa * gh + bh;
                const float bl2 = (bf_lo(wb[j]) - mub) * rsb * gl + bl, bh2 = (bf_hi(wb[j]) - mub) * rsb * gh + bh;
                *(LAS unsigned*)(Vt + (c0 + 2 * j) * SP_PITCH + 2 * kp) = pk2(al, bl2);
                *(LAS unsigned*)(Vt + (c0 + 2 * j + 1) * SP_PITCH + 2 * kp) = pk2(ah, bh2);
            }
        }
        __syncthreads();
        if (item + stride < 1024) load_v(item + stride);
        u32x4 uvr[8];
#pragma unroll
        for (int it = 0; it < 8; ++it) { const int i = t + it * NTHREADS; const int q = i >> 5, oct = i & 31; uvr[it] = __builtin_nontemporal_load((const u32x4*)(ZS + (tok0 + q) * SD2 + g * 256 + 8 * oct)); }
        const int r = lane & 31, hh = lane >> 5;
        f32x16 acc[4];
#pragma unroll
        for (int mt = 0; mt < 4; ++mt)
#pragma unroll
            for (int i = 0; i < 16; ++i) acc[mt][i] = 0.f;
#pragma unroll
        for (int ks = 0; ks < 8; ++ks) {
            const bf16x8 bfr = *(const LAS bf16x8*)(Vt + (32 * wid + r) * SP_PITCH + 16 * ks + 8 * hh);
#pragma unroll
            for (int mt = 0; mt < 4; ++mt) { const bf16x8 afr = *(const LAS bf16x8*)(Ws + (32 * mt + r) * SP_PITCH + 16 * ks + 8 * hh); acc[mt] = MFMA32(afr, bfr, acc[mt]); }
        }
        __syncthreads();
#pragma unroll
        for (int mt = 0; mt < 4; ++mt)
#pragma unroll
            for (int i = 0; i < 16; ++i) { const int q = 32 * mt + (i & 3) + 8 * (i >> 2) + 4 * hh; Ot[q * SP_OPITCH + 32 * wid + r] = f2bf(acc[mt][i] + bsp[g * 128 + q]); }
        __syncthreads();
#pragma unroll
        for (int it = 0; it < 8; ++it) { const int i = t + it * NTHREADS; const int q = i >> 5, oct = i & 31;
            const u32x4 uv = uvr[it];
            const u32x4 sv = *(const LAS u32x4*)(Ot + q * SP_OPITCH + 8 * oct);
            u32x4 w;
            w.x = pk2(bf_lo(uv.x) * bf_lo(sv.x), bf_hi(uv.x) * bf_hi(sv.x)); w.y = pk2(bf_lo(uv.y) * bf_lo(sv.y), bf_hi(uv.y) * bf_hi(sv.y));
            w.z = pk2(bf_lo(uv.z) * bf_lo(sv.z), bf_hi(uv.z) * bf_hi(sv.z)); w.w = pk2(bf_lo(uv.w) * bf_lo(sv.w), bf_hi(uv.w) * bf_hi(sv.w));
            *(u32x4*)(GT + (tok0 + q) * SD + g * 256 + 8 * oct) = w; }
    }
}

#define XB_TMO      128
#define XB_XCNT(j)  (256  + 64 * (j))
#define XB_XSUB(j)  (1280 + 64 * (j))
#define XB_XGEN(j)  (2304 + 64 * (j))
#define XB_TOP      3328
#define XB_TOPGEN   3392
#define XCD_BAR_WORDS 3456
#define XB_SPIN_CAP (1u << 22)
__device__ __forceinline__ unsigned xb_ld(unsigned* p)              { return __hip_atomic_load(p, __ATOMIC_RELAXED, __HIP_MEMORY_SCOPE_AGENT); }
__device__ __forceinline__ unsigned xb_add(unsigned* p, unsigned v) { return __hip_atomic_fetch_add(p, v, __ATOMIC_RELAXED, __HIP_MEMORY_SCOPE_AGENT); }
__device__ __forceinline__ unsigned xb_xcc_id() { return (unsigned)__builtin_amdgcn_s_getreg((3 << 11) | 20) & 0xFu; }
#define XB_SPIN(cond, bar) do { unsigned _sp = 0; while (cond) { __builtin_amdgcn_s_sleep(1); \
    if ((++_sp & 255u) == 0u) { if (xb_ld(&(bar)[XB_TMO])) break; if (_sp > XB_SPIN_CAP) { atomicAdd(&(bar)[XB_TMO], 1u); break; } } } } while (0)
struct XcdBarrier { unsigned* bar; unsigned x; volatile LAS unsigned* st; };
__device__ __forceinline__ XcdBarrier xcd_barrier_post(unsigned* bar, volatile LAS unsigned* st) {
    XcdBarrier b; b.bar = bar; b.x = xb_xcc_id(); b.st = st;
    if (threadIdx.x == 0) (void)xb_add(&bar[XB_XCNT(b.x)], 1u);
    return b;
}
__device__ __forceinline__ void xcd_barrier_complete(unsigned* bar, unsigned x, unsigned& nloc, unsigned& nx) {
    const unsigned G = gridDim.x * gridDim.y * gridDim.z;
    unsigned sum, cnt, mine, sp = 0u;
    for (;;) {
        sum = 0u; cnt = 0u; mine = 0u;
#pragma unroll
        for (unsigned j = 0; j < 16; ++j) { const unsigned c = xb_ld(&bar[XB_XCNT(j)]); sum += c; cnt += (c > 0u) ? 1u : 0u; mine = (j == x) ? c : mine; }
        if (sum == G) break;
        __builtin_amdgcn_s_sleep(1);
        if ((++sp & 255u) == 0u) { if (xb_ld(&bar[XB_TMO])) break; if (sp > XB_SPIN_CAP) { atomicAdd(&bar[XB_TMO], 1u); break; } }
    }
    nloc = mine > 0u ? mine : 1u; nx = cnt > 0u ? cnt : 1u;
}
__device__ __forceinline__ void xcd_barrier(const XcdBarrier& b) {
    asm volatile("s_waitcnt vmcnt(0)" ::: "memory");
    __syncthreads();
    if (threadIdx.x == 0) {
        unsigned* bar = b.bar;
        __builtin_amdgcn_s_waitcnt(0);
        unsigned nloc = b.st[0], nx = b.st[1];
        if (nloc == 0u) { xcd_barrier_complete(bar, b.x, nloc, nx); b.st[0] = nloc; b.st[1] = nx; }
        const unsigned old = xb_add(&bar[XB_XSUB(b.x)], 1u);
        const unsigned gen = old / nloc;
        if (old + 1u == (gen + 1u) * nloc) {
            __builtin_amdgcn_fence(__ATOMIC_RELEASE, "agent");
            asm volatile("s_waitcnt vmcnt(0)" ::: "memory");
            const unsigned og = xb_add(&bar[XB_TOP], 1u);
            const unsigned tg = og / nx;
            if (og + 1u == (tg + 1u) * nx) xb_add(&bar[XB_TOPGEN], 1u);
            else XB_SPIN(xb_ld(&bar[XB_TOPGEN]) == tg, bar);
            __builtin_amdgcn_fence(__ATOMIC_ACQUIRE, "agent");
            xb_add(&bar[XB_XGEN(b.x)], 1u);
            asm volatile("s_waitcnt vmcnt(0)" ::: "memory");
        } else {
            XB_SPIN(xb_ld(&bar[XB_XGEN(b.x)]) == gen, bar);
            __builtin_amdgcn_fence(__ATOMIC_ACQUIRE, "agent");
            asm volatile("s_waitcnt vmcnt(0)" ::: "memory");
        }
    }
    __syncthreads();
}

__global__ void __launch_bounds__(NTHREADS, 2) fwd_kernel(Args a_unused) {
    extern __shared__ __attribute__((aligned(16))) unsigned char lds_raw[];
    LAS unsigned char* lds = (LAS unsigned char*)lds_raw;
    cg::grid_group grid = cg::this_grid();
        int lo, hi; { CArgsP a0 = get_args(); lo = a0->ph_lo; hi = a0->ph_hi; }
    int ph = 0;
    const unsigned long long t_entry = PROBE_MASK ? __builtin_amdgcn_s_memrealtime() : 0ull;
    if (PROBE_MASK && blockIdx.x == 0 && threadIdx.x == 0) { CArgsP a0 = get_args(); *(volatile unsigned long long*)(a0->ws + WS_PROBE) = 0ull; }
    if (threadIdx.x < 2) ((volatile LAS unsigned*)(lds + LDS_BARST))[threadIdx.x] = 0u;
    __syncthreads();
    XcdBarrier xbar; xbar.bar = nullptr; xbar.x = 0; xbar.st = (volatile LAS unsigned*)(lds + LDS_BARST);
    bool xb_ready = false;
#define GRID_SYNC() do { if (!xb_ready) { grid.sync(); CArgsP _a = get_args(); xbar = xcd_barrier_post((unsigned*)(_a->ws + WS_BAR), (volatile LAS unsigned*)(lds + LDS_BARST)); xb_ready = true; } else { xcd_barrier(xbar); } } while (0)
#ifndef ONLY_KIND
#define ONLY_KIND -1
#endif
#define PHASE_BEGIN(kind) if ((ONLY_KIND < 0 || ONLY_KIND == (kind)) && ph >= lo && ph < hi) { CArgsP a = get_args(); unsigned char* ws = a->ws; float* modbuf = (float*)(ws + WS_MOD); (void)modbuf; const int t = tid_opaque(), lane = t & 63, wave = __builtin_amdgcn_readfirstlane(t >> 6); const int G = gridDim.x, bx = blockIdx.x; const int gw = bx * NWAVES + wave, NGW = G * NWAVES; (void)lane; (void)gw; (void)NGW; \
    unsigned long long _pt0 = 0; const bool _pon = PROBE_MASK && ((PROBE_MASK >> (kind)) & 1u) && bx == 0 && t == 0; if (_pon) _pt0 = __builtin_amdgcn_s_memrealtime();
#define PHASE_END   if (ph + 1 < hi) { GRID_SYNC(); } if (_pon) { *(volatile unsigned long long*)(ws + WS_PROBE) += __builtin_amdgcn_s_memrealtime() - _pt0; } } ++ph;

    PHASE_BEGIN(0)
        for (int i = bx * NTHREADS + t; i < M * 2; i += G * NTHREADS) ((float*)(ws + WS_LNST))[i] = 0.f;
        for (int i = bx * NTHREADS + t; i < 6 * F2; i += G * NTHREADS) ((float*)(ws + WS_BIAS))[i] = 0.f;
        for (int i = bx * NTHREADS + t; i < 4 * M; i += G * NTHREADS) ((float*)(ws + WS_ROWSS))[i] = 0.f;
        if (bx == 0) for (int i = t; i < XCD_BAR_WORDS; i += NTHREADS) ((unsigned*)(ws + WS_BAR))[i] = 0u;
        for (int tk = bx; tk < 768; tk += G) p0_gemv_task(a, lds, tk);
    PHASE_END
    PHASE_BEGIN(1)
        for (int i = bx * NTHREADS + t; i < 3 * NB * D; i += G * NTHREADS) { const int site = i / (NB * D), b = (i / D) % NB, k = i % D;
            const float gg = site == 0 ? a->in[5][k] : site == 1 ? a->in[4][D + k] : a->in[5][D + k];
            const float sc = site == 0 ? modbuf[b * D6 + 4 * D + k] : site == 1 ? modbuf[(3 + b) * D6 + D + k] : modbuf[(3 + b) * D6 + 4 * D + k];
            ((float*)(ws + WS_GP))[i] = gg * (1.f + sc); }
        for (int m0 = gw; m0 < MU; m0 += 4 * NGW) {
            const float* src[4]; const float* sh[4]; void* dst[4]; bool valid[4];
#pragma unroll
            for (int k = 0; k < 4; ++k) { const int mm = m0 + k * NGW; valid[k] = mm < MU; const int m = valid[k] ? mm : MU - 1; const int b = m / LT, j = m % LT;
                src[k] = j < CTXL ? a->in[2] + ((size_t)b * CTXL + j) * D : a->in[0] + ((size_t)b * SEQ + (j - CTXL)) * D;
                sh[k] = modbuf + (j < CTXL ? 2 : b) * D6; dst[k] = (bf16_t*)(ws + WS_A0) + (size_t)m * D; }
            norm_rows<false, 4>(src, a->in[4], sh, dst, valid, lane); }
        __syncthreads();
        p0_transpose_all<1>(a, lds, bx, G, TRC_END - 512);
    PHASE_END
    PHASE_BEGIN(2)
        pg8::Gemm g{(const bf16_t*)(ws + WS_A0), (const bf16_t*)(ws + WS_WIN), MU, D, D, D}; pg8::StaticOrder S; S.init(MU, D, G, bx);
        pg8::EpiF32 E{nullptr, D, (bf16_t*)(ws + WS_UB)};
        pg8::gemm_phase<pg8::EpiF32, true, true>(lds, g, S, E);
        if (bx >= 16) { __syncthreads(); p0_transpose_all<0>(a, lds, TRC_UP1_B + (bx - 16), G - 16, TRC_UP1_E);
            for (int idx = (bx - 16) * NTHREADS + t; idx < 2 * NG * NP; idx += (G - 16) * NTHREADS) p0_s5_tables(a, idx);
            for (int w = (bx - 16) * NTHREADS + t; w < 2 * NG * NP * 4; w += (G - 16) * NTHREADS) p0_s5_kend(a, w >> 2, w & 3); }
    PHASE_END
    PHASE_BEGIN(3)
        s5_passA(a, gw, NGW, lane);
    PHASE_END
    PHASE_BEGIN(4)
        if (t < 128) {
            const f32x2* lamT = (const f32x2*)(ws + WS_LAMT);
            for (int idx = bx * 128 + t; idx < 2 * NG * 2 * NP; idx += G * 128) {
                const int p = idx & 63, b = (idx >> 6) & 1, gd = idx >> 7;
                const f32x2 lt = lamT[gd * 64 + p]; float sr = 0.f, si = 0.f;
                const f32x2* e = (const f32x2*)((const float*)(ws + WS_E) + ((size_t)gd * NCOL + b * 128) * 128) + p;
                f32x2* so = (f32x2*)((float*)(ws + WS_SI) + ((size_t)gd * NCOL + b * 128) * 128) + p;
#pragma unroll 8
                for (int c = 0; c < 128; ++c) { so[c * 64] = (f32x2){sr, si}; const f32x2 ev = __builtin_nontemporal_load(e + c * 64);
                    const float nr = lt.x * sr - lt.y * si + ev.x, ni = lt.x * si + lt.y * sr + ev.y; sr = nr; si = ni; }
            }
        }
    PHASE_END
    PHASE_BEGIN(5)
        s5_pass<true>(a, lds, gw, NGW, lane);
    PHASE_END
    PHASE_BEGIN(6)
        const bf16_t* UBp = (const bf16_t*)(ws + WS_UB); const u32x4* YF = (const u32x4*)(ws + WS_YF); const u32x4* YR = (const u32x4*)(ws + WS_YR);
        const float* dsk = a->in[20]; u32x4* Gm = (u32x4*)(ws + WS_G);
        for (int i = bx * NTHREADS + t; i < M * (D / 8); i += G * NTHREADS) {
            const int m = i >> 8, c8 = i & 255, b = m >> 12, tt = m & 4095;
            const u32x4 u = __builtin_nontemporal_load((const u32x4*)(UBp + ((size_t)b * LT + CTXL + tt) * D + 8 * c8));
            const u32x4 yf = __builtin_nontemporal_load(YF + i), yr = __builtin_nontemporal_load(YR + i); const f32x4 d0 = ((const f32x4*)dsk)[2 * c8], d1 = ((const f32x4*)dsk)[2 * c8 + 1];
            u32x4 w;
            w.x = pk2(gelu_tanh_f(d0.x * bf_lo(u.x) + bf_lo(yf.x) + bf_lo(yr.x)), gelu_tanh_f(d0.y * bf_hi(u.x) + bf_hi(yf.x) + bf_hi(yr.x)));
            w.y = pk2(gelu_tanh_f(d0.z * bf_lo(u.y) + bf_lo(yf.y) + bf_lo(yr.y)), gelu_tanh_f(d0.w * bf_hi(u.y) + bf_hi(yf.y) + bf_hi(yr.y)));
            w.z = pk2(gelu_tanh_f(d1.x * bf_lo(u.z) + bf_lo(yf.z) + bf_lo(yr.z)), gelu_tanh_f(d1.y * bf_hi(u.z) + bf_hi(yf.z) + bf_hi(yr.z)));
            w.w = pk2(gelu_tanh_f(d1.z * bf_lo(u.w) + bf_lo(yf.w) + bf_lo(yr.w)), gelu_tanh_f(d1.w * bf_hi(u.w) + bf_hi(yf.w) + bf_hi(yr.w)));
            Gm[i] = w; }
    PHASE_END
    PHASE_BEGIN(7)
        pg8::Gemm g{(const bf16_t*)(ws + WS_G), (const bf16_t*)(ws + WS_WGLU), M, D, D, D}; pg8::StaticOrder S; S.init(M, D, G, bx);
        pg8::EpiGlu E{(const bf16_t*)(ws + WS_G), (bf16_t*)(ws + WS_A2), a->in[22]};
        pg8::gemm_phase<pg8::EpiGlu, true, true>(lds, g, S, E);
    PHASE_END
    PHASE_BEGIN(8)
        pg8::Gemm g{(const bf16_t*)(ws + WS_A2), (const bf16_t*)(ws + WS_WOUT), M, D, D, D}; pg8::StaticOrder S; S.init(M, D, G, bx);
        pg8::EpiResidNorm E{a->in[0], (float*)(ws + WS_X), modbuf + 2 * D, (const float*)(ws + WS_GP), (bf16_t*)(ws + WS_A0), (float*)(ws + WS_ROWSS)};
        pg8::gemm_phase<pg8::EpiResidNorm, true, true>(lds, g, S, E);
    PHASE_END
#pragma unroll
    for (int layer = 0; layer < 2; ++layer) {
        if (layer == 1) {
            PHASE_BEGIN(10)
                pg8::Gemm g{(const bf16_t*)(ws + WS_A0), (const bf16_t*)(ws + WS_SIN_W), M, SD2, D, D}; pg8::StaticOrder S; S.init(M, SD2, G, bx);
                pg8::EpiBf16<1> E{(bf16_t*)(ws + WS_ZS), SD2, (float*)(ws + WS_LNST), 16, (const float*)(ws + WS_ROWSS) + M, (const float*)(ws + WS_BIAS) + 2 * F2};
                pg8::gemm_phase<pg8::EpiBf16<1>, true, true>(lds, g, S, E);
            PHASE_END
            PHASE_BEGIN(11)
                spatial_phase(a, lds, bx, G);
            PHASE_END
            PHASE_BEGIN(12)
                pg8::Gemm g{(const bf16_t*)(ws + WS_GT), (const bf16_t*)(ws + WS_SOUT_W), M, D, SD, SD}; pg8::StaticOrder S; S.init(M, D, G, bx);
                pg8::EpiResidNorm E{(const float*)(ws + WS_X), (float*)(ws + WS_X), modbuf + 3 * D6 + 2 * D, (const float*)(ws + WS_GP) + 2 * NB * D, (bf16_t*)(ws + WS_A0), (float*)(ws + WS_ROWSS) + 2 * M};
                pg8::gemm_phase<pg8::EpiResidNorm, true, true>(lds, g, S, E);
            PHASE_END
        }
        PHASE_BEGIN(14)
            pg8::Gemm g{(const bf16_t*)(ws + WS_A0), (const bf16_t*)(ws + (layer ? WS_UP1 : WS_UP0)), M, F2, D, D}; pg8::StaticOrder S; S.init(M, F2, G, bx);
            pg8::EpiBf16<0> E{(bf16_t*)(ws + WS_Z), F2, nullptr, 1 << 30, (const float*)(ws + WS_ROWSS) + (layer ? 2 * M : 0), (const float*)(ws + WS_BIAS) + (layer ? 4 * F2 : 0)};
            pg8::gemm_phase<pg8::EpiBf16<0>, true, true>(lds, g, S, E);
            if (bx >= 128) { __syncthreads();
                if (layer == 0) p0_transpose_all<0>(a, lds, TRC_END - 512 + (bx - 128), G - 128, TRC_END); else p0_transpose_all<0>(a, lds, TRC_DN1_B + (bx - 128), G - 128, TRC_DN1_E); }
        PHASE_END
        PHASE_BEGIN(15)
            conv_phase(a, lds, layer, bx, G);
        PHASE_END
        PHASE_BEGIN(16)
            pg8::Gemm g{(const bf16_t*)(ws + WS_A3), (const bf16_t*)(ws + (layer ? WS_DN1 : WS_DN0)), M, D, FF, FF}; pg8::StaticOrder S; S.init(M, D, G, bx);
            if (layer == 0) { pg8::EpiResidNorm E{(const float*)(ws + WS_X), (float*)(ws + WS_X), modbuf + 5 * D, (const float*)(ws + WS_GP) + NB * D, (bf16_t*)(ws + WS_A0), (float*)(ws + WS_ROWSS) + M};
                pg8::gemm_phase<pg8::EpiResidNorm, true, true>(lds, g, S, E); }
            else { pg8::EpiResid E{(const float*)(ws + WS_X), (float*)(ws + WS_X), modbuf + 3 * D6 + 5 * D, (float*)(ws + WS_ROWSS) + 3 * M};
                pg8::gemm_phase<pg8::EpiResid, true, true>(lds, g, S, E); }
        PHASE_END
    }
    PHASE_BEGIN(17)
        { const f32x4* xp = (const f32x4*)(ws + WS_X); const float* rs = (const float*)(ws + WS_ROWSS) + 3 * M; const f32x4* gp = (const f32x4*)a->in[30]; f32x4* op = (f32x4*)a->out;
#pragma unroll 8
          for (int i = bx * NTHREADS + t; i < M * (D / 4); i += G * NTHREADS) { const float rstd = __builtin_amdgcn_rsqf(rs[i >> 9] * (1.f / D) + 1e-6f); op[i] = __builtin_nontemporal_load(xp + i) * rstd * gp[i & 511]; } }
        if (PROBE_MASK) { GRID_SYNC(); }
    PHASE_END
    if (PROBE_MASK) {
        CArgsP a = get_args(); unsigned char* ws = a->ws; const int t = tid_opaque(), bx = blockIdx.x, G = gridDim.x;
        if ((PROBE_MASK >> 20) & 1u) {
            unsigned long long t0 = 0; if (bx == 0 && t == 0) t0 = __builtin_amdgcn_s_memrealtime();
            f32x4 acc4 = {0.f, 0.f, 0.f, 0.f}; const f32x4* xp = (const f32x4*)(ws + WS_X);
#pragma unroll 8
            for (int i = bx * NTHREADS + t; i < M * (D / 4); i += G * NTHREADS) acc4 += xp[i];
            ((float*)(ws + WS_PROBE + 65536))[bx * NTHREADS + t] = acc4.x + acc4.y + acc4.z + acc4.w;
            GRID_SYNC();
            if (bx == 0 && t == 0) *(volatile unsigned long long*)(ws + WS_PROBE) += __builtin_amdgcn_s_memrealtime() - t0;
        }
        if ((PROBE_MASK >> 21) & 1u) {
            unsigned long long t0 = 0; if (bx == 0 && t == 0) t0 = __builtin_amdgcn_s_memrealtime();
            f32x4* zp = (f32x4*)(ws + WS_ZS); const f32x4 v = {1.f, 2.f, 3.f, (float)t};
#pragma unroll 8
            for (int i = bx * NTHREADS + t; i < M * (D / 4); i += G * NTHREADS) zp[i] = v;
            GRID_SYNC();
            if (bx == 0 && t == 0) *(volatile unsigned long long*)(ws + WS_PROBE) += __builtin_amdgcn_s_memrealtime() - t0;
        }
        if ((PROBE_MASK >> 22) & 1u) {
            unsigned long long t0 = 0; if (bx == 0 && t == 0) t0 = __builtin_amdgcn_s_memrealtime();
            f32x4* zp = (f32x4*)(ws + WS_ZS); const f32x4* xp = (const f32x4*)(ws + WS_X);
#pragma unroll 8
            for (int i = bx * NTHREADS + t; i < M * (D / 4); i += G * NTHREADS) zp[i] = xp[i];
            GRID_SYNC();
            if (bx == 0 && t == 0) *(volatile unsigned long long*)(ws + WS_PROBE) += __builtin_amdgcn_s_memrealtime() - t0;
        }
        if ((PROBE_MASK >> 19) & 1u) {
            unsigned long long t0 = 0; if (bx == 0 && t == 0) t0 = __builtin_amdgcn_s_memrealtime();
            for (int i = 0; i < 10; ++i) { GRID_SYNC(); }
            if (bx == 0 && t == 0) *(volatile unsigned long long*)(ws + WS_PROBE) += __builtin_amdgcn_s_memrealtime() - t0;
        }
        if ((PROBE_MASK >> 18) & 1u) { if (bx == 0 && t == 0) *(volatile unsigned long long*)(ws + WS_PROBE) += __builtin_amdgcn_s_memrealtime() - t_entry; }
        grid.sync();
        const unsigned long long tk = *(volatile unsigned long long*)(ws + WS_PROBE); const float pd = sqrtf((float)tk * 1e-10f);
        for (int i = bx * NTHREADS + t; i < M * (D / 4); i += G * NTHREADS) { f32x4 y = ((f32x4*)a->out)[i]; y.x += pd; y.y -= pd; y.z += pd; y.w -= pd; ((f32x4*)a->out)[i] = y; }
    }
}
constexpr int N_PHASES = 19;

extern "C" void kernel_launch(void* const* d_in, const int* in_sizes, int n_in, void* d_out, int out_size, void* d_ws, size_t ws_size, hipStream_t stream) {
    static int grid = 0;
    if (grid == 0) {
        if (n_in != 31 || out_size != M * D || ws_size < WS_END) { fprintf(stderr, "kernel_launch: unexpected shapes (n_in %d out %d ws %zu need %zu)\n", n_in, out_size, ws_size, (size_t)WS_END); grid = -1; return; }
        int dev = 0, cus = 0, per_cu = 0;
        hipGetDevice(&dev); hipDeviceGetAttribute(&cus, hipDeviceAttributeMultiprocessorCount, dev);
        if (hipFuncSetAttribute((const void*)fwd_kernel, hipFuncAttributeMaxDynamicSharedMemorySize, LDS_BYTES) != hipSuccess) { fprintf(stderr, "kernel_launch: hipFuncSetAttribute failed\n"); grid = -1; return; }
        if (hipOccupancyMaxActiveBlocksPerMultiprocessor(&per_cu, (const void*)fwd_kernel, NTHREADS, LDS_BYTES) != hipSuccess || per_cu < 1) { fprintf(stderr, "kernel_launch: occupancy query gave %d\n", per_cu); per_cu = 1; }
        (void)hipGetLastError();
        grid = cus * 1;
    }
    if (grid < 0) return;
    Args a{};
    for (int i = 0; i < 31; ++i) a.in[i] = (const float*)d_in[i];
    a.out = (float*)d_out; a.ws = (unsigned char*)d_ws; a.ph_lo = 0; a.ph_hi = N_PHASES;
    void* args[] = {&a};
    hipError_t e = hipLaunchCooperativeKernel((const void*)fwd_kernel, dim3(grid), dim3(NTHREADS), args, LDS_BYTES, stream);
    if (e != hipSuccess) fprintf(stderr, "kernel_launch: cooperative launch failed: %s (grid %d)\n", hipGetErrorString(e), grid);
}
```

```cpp
#include <hip/hip_runtime.h>
#include <hip/hip_cooperative_groups.h>
#include <cstdio>
#include <cstdint>
namespace cg = cooperative_groups;

#ifndef PROBE_MASK
#define PROBE_MASK 0u
#endif
#define LAS __attribute__((address_space(3)))
typedef unsigned short bf16_t;
typedef short bf16x8 __attribute__((ext_vector_type(8)));
typedef float f32x2 __attribute__((ext_vector_type(2)));
typedef float f32x4 __attribute__((ext_vector_type(4)));
typedef float f32x16 __attribute__((ext_vector_type(16)));
typedef unsigned u32x2 __attribute__((ext_vector_type(2)));
typedef unsigned u32x4 __attribute__((ext_vector_type(4)));
typedef __bf16 bf16x2v __attribute__((ext_vector_type(2)));

constexpr int D = 2048, NB = 2, SEQ = 4096, CTXL = 256, M = NB * SEQ, LT = SEQ + CTXL, MU = NB * LT;
constexpr int NG = 128, NP = 64, NH = 16, TC = 34, NCOL = 256;
constexpr int F2 = 11264, FF = 5632, SD = 4096, SD2 = 8192, D6 = 12288;
constexpr int NTHREADS = 512, NWAVES = 8;
constexpr int LDS_BYTES = 147456;

constexpr size_t MiB = 1u << 20;
constexpr size_t WS_MOD = 0;
constexpr size_t WS_LAM = 512 * 1024;
constexpr size_t WS_LAMT = 768 * 1024;
constexpr size_t WS_BCAT = 1 * MiB;
constexpr size_t WS_CCAT = 2 * MiB;
constexpr size_t WS_LNST = 3 * MiB;
constexpr size_t WS_PROBE = 4 * MiB;
constexpr size_t WS_BIAS = 6 * MiB;
constexpr size_t WS_ROWSS = 7 * MiB;
constexpr size_t WS_GP = 7 * MiB + 512 * 1024;
constexpr size_t WS_BAR = 5 * MiB;
constexpr int LDS_BARST = LDS_BYTES - 64;
constexpr size_t WS_W = 16 * MiB;
constexpr size_t WS_WIN = WS_W, WS_WGLU = WS_WIN + 8 * MiB, WS_WOUT = WS_WGLU + 8 * MiB;
constexpr size_t WS_UP0 = WS_WOUT + 8 * MiB, WS_UP1 = WS_UP0 + 44 * MiB;
constexpr size_t WS_DN0 = WS_UP1 + 44 * MiB, WS_DN1 = WS_DN0 + 22 * MiB;
constexpr size_t WS_SIN_W = WS_DN1 + 22 * MiB, WS_SOUT_W = WS_SIN_W + 32 * MiB;
constexpr size_t WS_X = WS_SOUT_W + 16 * MiB;
constexpr size_t WS_A0 = WS_X + 64 * MiB;
constexpr size_t WS_G = WS_A0 + 34 * MiB;
constexpr size_t WS_A2 = WS_G + 32 * MiB;
constexpr size_t WS_BIG1 = WS_A2 + 32 * MiB;
constexpr size_t WS_U = WS_BIG1;
constexpr size_t WS_YF = WS_BIG1 + 68 * MiB;
constexpr size_t WS_Z = WS_BIG1;
constexpr size_t WS_ZS = WS_BIG1;
constexpr size_t WS_BIG2 = WS_BIG1 + 176 * MiB;
constexpr size_t WS_YR = WS_BIG2;
constexpr size_t WS_E = WS_BIG2 + 64 * MiB;
constexpr size_t WS_SI = WS_BIG2 + 96 * MiB;
constexpr size_t WS_A3 = WS_BIG2;
constexpr size_t WS_GT = WS_BIG2;
constexpr size_t WS_UB = WS_BIG2 + 128 * MiB;
constexpr size_t WS_KEND = WS_UB + 34 * MiB;
constexpr size_t WS_END = WS_KEND + 36 * MiB;

struct Args { const float* in[31]; float* out; unsigned char* ws; int ph_lo, ph_hi; };
typedef const Args __attribute__((address_space(4)))* CArgsP;
__device__ __forceinline__ CArgsP get_args() { CArgsP p = (CArgsP)__builtin_amdgcn_kernarg_segment_ptr(); asm volatile("" : "+s"(p)); return p; }

__device__ __forceinline__ void store16_wt(void* p, f32x4 v) { asm volatile("global_store_dwordx4 %0, %1, off sc1" :: "v"(p), "v"(v) : "memory"); }
__device__ __forceinline__ int launder_i(int v) { asm volatile("" : "+v"(v)); return v; }
__device__ __forceinline__ int tid_opaque() { int t = threadIdx.x; asm volatile("" : "+v"(t)); return t; }
__device__ __forceinline__ unsigned pk2(float lo, float hi) { f32x2 v = {lo, hi}; bf16x2v r = __builtin_convertvector(v, bf16x2v); return __builtin_bit_cast(unsigned, r); }
__device__ __forceinline__ bf16_t f2bf(float f) { return (bf16_t)(pk2(f, 0.f) & 0xffffu); }
__device__ __forceinline__ float bf_lo(unsigned w) { return __builtin_bit_cast(float, w << 16); }
__device__ __forceinline__ float bf_hi(unsigned w) { return __builtin_bit_cast(float, w & 0xffff0000u); }
__device__ __forceinline__ float shfl_xor_l(float v, int m, int lane) { return __builtin_bit_cast(float, __builtin_amdgcn_ds_bpermute((lane ^ m) << 2, __builtin_bit_cast(int, v))); }
__device__ __forceinline__ float wave_sum(float v, int lane) {
#pragma unroll
    for (int o = 1; o < 64; o <<= 1) v += shfl_xor_l(v, o, lane);
    return v;
}
__device__ __forceinline__ float sigmoid_f(float x) { return __builtin_amdgcn_rcpf(1.f + __expf(-x)); }
__device__ __forceinline__ float silu_f(float x) { return x * sigmoid_f(x); }
__device__ __forceinline__ float gelu_tanh_f(float x) { const float t = 1.5957691216f * (x + 0.044715f * x * x * x); return x * sigmoid_f(t); }

namespace pg8 {
constexpr int BM = 256, BK = 64, HALF = 128, HTB = HALF * BK * 2, STAGE_BYTES = 8 * HTB, NXCD = 8, WGM = 8;
__device__ __forceinline__ int lds_byte(int r, int c) { const int st = (r >> 4) * 2 + (c >> 5), rr = r & 15, cc = c & 31, ob = rr * 64 + cc * 2; return st * 1024 + (ob ^ (((ob >> 9) & 1) << 5)); }
__device__ __forceinline__ void stage_rc(int b, int& R, int& C) { const int st = b / 1024, sb = b % 1024, swz = sb ^ (((sb >> 9) & 1) << 5); R = (st >> 1) * 16 + swz / 64; C = (st & 1) * 32 + (swz % 64) / 2; }
__device__ __forceinline__ int perm32(int rho) { const int n = rho >> 4, i = rho & 15; return 8 * (i >> 2) + 4 * n + (i & 3); }
struct Unit { int pm, pn; };
struct Gemm { const bf16_t* A; const bf16_t* Bt; int M, N, K, ld; };
struct StaticOrder {
    int nM, nN, nwg, G, c;
    __device__ void init(int M_, int N_, int G_, int c_) { nM = M_ / BM; nN = N_ / BM; nwg = nM * nN; G = G_; c = c_; }
    __device__ bool next(int i, Unit& u) const {
        const long L = (long)i * G + c; if (L >= nwg) return false;
        int wgid = (int)L; { const int q = nwg / NXCD, r = nwg % NXCD, xcd = wgid % NXCD, off = wgid / NXCD; wgid = (xcd < r ? xcd * (q + 1) : r * (q + 1) + (xcd - r) * q) + off; }
        const int nig = WGM * nN, gid = wgid / nig, fm = gid * WGM, gsz = (nM - fm) < WGM ? (nM - fm) : WGM;
        u.pm = fm + ((wgid % nig) % gsz); u.pn = (wgid % nig) / gsz; return true;
    }
};

template <class Epi, bool ALIGN_EPI, bool SP2>
__device__ __forceinline__ void gemm_phase(LAS unsigned char* lds, const Gemm g, const StaticOrder& S, const Epi& E) {
    const int tid = tid_opaque(), wid = __builtin_amdgcn_readfirstlane(tid >> 6), lane = tid & 63, wr = wid >> 2, wc = wid & 3, fr = lane & 15, fq = lane >> 4;
    const int K = g.ld, nt = g.K / BK;
    unsigned voffA[2], voffB[2];
#pragma unroll
    for (int i = 0; i < 2; ++i) { int R, C; stage_rc(tid * 16 + i * 8192, R, C); const int Rb = Epi::PERM ? ((R & ~31) + perm32(R & 31)) : R;
        voffA[i] = (unsigned)(R * K + C) * 2u; voffB[i] = (unsigned)(Rb * K + C) * 2u; }
    const size_t kstep = (size_t)(BK * 2);
    const size_t hstep = (size_t)HALF * K * 2;
    const size_t tstep = 2 * hstep;
    const unsigned ldsw = (unsigned)wid * 1024u;
    const int aoff = lds_byte(wr * 64 + fr, fq * 8), boff = lds_byte(wc * 32 + fr, fq * 8);
#define PG8_SA(b, h) (((b) * 2 + (h)) * HTB)
#define PG8_SB(b, h) ((4 + (b) * 2 + (h)) * HTB)
#define PG8_STAGE(bufoff, gbase, voff) do { _Pragma("unroll") for (int _i = 0; _i < 2; ++_i) \
        __builtin_amdgcn_global_load_lds((const unsigned*)((const char*)(gbase) + (voff)[_i]), (LAS unsigned*)(lds + (bufoff) + ldsw + _i * 8192), 16, 0, 0); } while (0)
#define PG8_LDA(dst, b, h) do { _Pragma("unroll") for (int m = 0; m < 4; ++m) _Pragma("unroll") for (int k = 0; k < 2; ++k) dst[m][k] = *(const LAS bf16x8*)(lds + PG8_SA(b, h) + aoff + m * 2048 + k * 1024); } while (0)
#define PG8_LDB(dst, b, h) do { _Pragma("unroll") for (int n = 0; n < 2; ++n) _Pragma("unroll") for (int k = 0; k < 2; ++k) dst[n][k] = *(const LAS bf16x8*)(lds + PG8_SB(b, h) + boff + n * 2048 + k * 1024); } while (0)
#define PG8_MMA(ai, bj, At, Bt) do { __builtin_amdgcn_s_setprio(1); _Pragma("unroll") for (int m = 0; m < 4; ++m) _Pragma("unroll") for (int n = 0; n < 2; ++n) _Pragma("unroll") for (int k = 0; k < 2; ++k) \
        acc[ai][bj][m][n] = __builtin_amdgcn_mfma_f32_16x16x32_bf16(Bt[n][k], At[m][k], acc[ai][bj][m][n], 0, 0, 0); __builtin_amdgcn_s_setprio(0); } while (0)
#define PG8_WAIT_V(n) asm volatile("s_waitcnt vmcnt(" #n ")" ::: "memory")
#define PG8_WAIT_L(n) asm volatile("s_waitcnt lgkmcnt(" #n ")" ::: "memory")
#define PG8_BAR __builtin_amdgcn_s_barrier()
#define PG8_SCHED __builtin_amdgcn_sched_barrier(0)
    Unit cur, nxt; int ui = 0;
    if (!S.next(0, cur)) return;
    f32x4 acc[2][2][4][2];
#pragma unroll
    for (int a = 0; a < 2; ++a)
#pragma unroll
        for (int b = 0; b < 2; ++b)
#pragma unroll
            for (int m = 0; m < 4; ++m)
#pragma unroll
                for (int n = 0; n < 2; ++n) acc[a][b][m][n] = (f32x4){0.f, 0.f, 0.f, 0.f};
    bf16x8 At[4][2], B0[2][2], B1[2][2];
    const char* cA = (const char*)g.A + (size_t)cur.pm * tstep; const char* cB = (const char*)g.Bt + (size_t)cur.pn * tstep;
    if constexpr (SP2) {
        PG8_STAGE(PG8_SB(0, 0), cB, voffB); PG8_STAGE(PG8_SB(0, 1), cB + hstep, voffB); PG8_STAGE(PG8_SA(0, 0), cA, voffA); PG8_STAGE(PG8_SA(0, 1), cA + hstep, voffA);
        if (wr == 1) PG8_BAR;
        PG8_WAIT_V(2); PG8_BAR;
        PG8_STAGE(PG8_SB(1, 0), cB + kstep, voffB); PG8_STAGE(PG8_SA(1, 0), cA + kstep, voffA); PG8_STAGE(PG8_SB(1, 1), cB + hstep + kstep, voffB);
        PG8_WAIT_V(6); PG8_BAR;
    } else {
        PG8_STAGE(PG8_SB(0, 0), cB, voffB); PG8_STAGE(PG8_SA(0, 0), cA, voffA); PG8_STAGE(PG8_SB(0, 1), cB + hstep, voffB); PG8_STAGE(PG8_SA(0, 1), cA + hstep, voffA);
        if (wr == 1) PG8_BAR;
        PG8_WAIT_V(4); PG8_BAR;
        PG8_STAGE(PG8_SB(1, 0), cB + kstep, voffB); PG8_STAGE(PG8_SA(1, 0), cA + kstep, voffA); PG8_STAGE(PG8_SB(1, 1), cB + hstep + kstep, voffB);
        PG8_WAIT_V(6); PG8_BAR;
    }
    for (;;) {
        const bool has_next = S.next(ui + 1, nxt);
        const char* nA = has_next ? (const char*)g.A + (size_t)nxt.pm * tstep : cA; const char* nB = has_next ? (const char*)g.Bt + (size_t)nxt.pn * tstep : cB;
        for (int t = 0; t < nt; t += 2) {
            const bool last = (t == nt - 2);
            const char* a1 = cA + (size_t)(t + 1) * kstep;
            const char* a2 = last ? nA : cA + (size_t)(t + 2) * kstep; const char* b2 = last ? nB : cB + (size_t)(t + 2) * kstep;
            const char* a3 = a2 + kstep; const char* b3 = b2 + kstep;
            if constexpr (SP2) {
            PG8_LDB(B0, 0, 0); PG8_LDB(B1, 0, 1); PG8_SCHED; PG8_LDA(At, 0, 0); PG8_STAGE(PG8_SA(1, 1), a1 + hstep, voffA);
            PG8_WAIT_V(8); PG8_WAIT_L(0); PG8_BAR; PG8_MMA(0, 0, At, B0); PG8_MMA(0, 1, At, B1); PG8_BAR; PG8_SCHED;
            PG8_LDA(At, 0, 1); PG8_STAGE(PG8_SB(0, 0), b2, voffB); PG8_STAGE(PG8_SB(0, 1), b2 + hstep, voffB); PG8_STAGE(PG8_SA(0, 0), a2, voffA);
            PG8_WAIT_V(8); PG8_WAIT_L(0); PG8_BAR; PG8_MMA(1, 0, At, B0); PG8_MMA(1, 1, At, B1); PG8_BAR; PG8_SCHED;
            PG8_LDB(B0, 1, 0); PG8_LDB(B1, 1, 1); PG8_SCHED; PG8_LDA(At, 1, 0); PG8_STAGE(PG8_SA(0, 1), a2 + hstep, voffA);
            PG8_WAIT_V(8); PG8_WAIT_L(0); PG8_BAR; PG8_MMA(0, 0, At, B0); PG8_MMA(0, 1, At, B1); PG8_BAR; PG8_SCHED;
            PG8_LDA(At, 1, 1); PG8_STAGE(PG8_SB(1, 0), b3, voffB); PG8_STAGE(PG8_SB(1, 1), b3 + hstep, voffB); PG8_STAGE(PG8_SA(1, 0), a3, voffA);
            PG8_WAIT_V(8); PG8_WAIT_L(0); PG8_BAR; PG8_MMA(1, 0, At, B0); PG8_MMA(1, 1, At, B1); PG8_BAR; PG8_SCHED;
            } else {
            PG8_LDB(B0, 0, 0); PG8_SCHED; PG8_LDA(At, 0, 0); PG8_STAGE(PG8_SA(1, 1), a1 + hstep, voffA);
            PG8_WAIT_L(8); PG8_BAR; PG8_WAIT_L(0); PG8_MMA(0, 0, At, B0); PG8_BAR; PG8_SCHED;
            PG8_LDB(B1, 0, 1); PG8_STAGE(PG8_SB(0, 0), b2, voffB);
            PG8_BAR; PG8_WAIT_L(0); PG8_MMA(0, 1, At, B1); PG8_BAR;
            PG8_LDA(At, 0, 1); PG8_STAGE(PG8_SA(0, 0), a2, voffA);
            PG8_BAR; PG8_WAIT_L(0); PG8_MMA(1, 0, At, B0); PG8_BAR; PG8_SCHED;
            PG8_STAGE(PG8_SB(0, 1), b2 + hstep, voffB);
            PG8_WAIT_V(6); PG8_BAR; PG8_MMA(1, 1, At, B1); PG8_BAR;
            PG8_LDB(B0, 1, 0); PG8_SCHED; PG8_LDA(At, 1, 0); PG8_STAGE(PG8_SA(0, 1), a2 + hstep, voffA);
            PG8_WAIT_L(8); PG8_BAR; PG8_WAIT_L(0); PG8_MMA(0, 0, At, B0); PG8_BAR; PG8_SCHED;
            PG8_LDB(B1, 1, 1); PG8_STAGE(PG8_SB(1, 0), b3, voffB);
            PG8_BAR; PG8_WAIT_L(0); PG8_MMA(0, 1, At, B1); PG8_BAR;
            PG8_LDA(At, 1, 1); PG8_STAGE(PG8_SA(1, 0), a3, voffA);
            PG8_BAR; PG8_WAIT_L(0); PG8_MMA(1, 0, At, B0); PG8_BAR; PG8_SCHED;
            PG8_STAGE(PG8_SB(1, 1), b3 + hstep, voffB);
            PG8_WAIT_V(6); PG8_BAR; PG8_MMA(1, 1, At, B1); PG8_BAR;
            }
        }
        if constexpr (ALIGN_EPI) { if (wr == 0) PG8_BAR; }
        E(acc, cur, wr, wc, fr, fq);
        if (!has_next) break;
#pragma unroll
        for (int a = 0; a < 2; ++a)
#pragma unroll
            for (int b = 0; b < 2; ++b)
#pragma unroll
                for (int m = 0; m < 4; ++m)
#pragma unroll
                    for (int n = 0; n < 2; ++n) acc[a][b][m][n] = (f32x4){0.f, 0.f, 0.f, 0.f};
        cur = nxt; cA = nA; cB = nB; ++ui;
        if constexpr (ALIGN_EPI) { if (wr == 1) PG8_BAR; }
    }
    PG8_WAIT_V(0);
    if constexpr (!ALIGN_EPI) { if (wr == 0) PG8_BAR; }
    PG8_BAR;
#undef PG8_SA
#undef PG8_SB
#undef PG8_STAGE
#undef PG8_LDA
#undef PG8_LDB
#undef PG8_MMA
#undef PG8_WAIT_V
#undef PG8_WAIT_L
#undef PG8_BAR
#undef PG8_SCHED
}

typedef f32x4 AccT[2][2][4][2];
struct EpiF32 {
    static constexpr bool PERM = false;
    float* C; int ldc; bf16_t* Cb;
    __device__ __forceinline__ void operator()(const AccT& acc, const Unit& u, int wr, int wc, int fr, int fq) const {
        const int row0 = u.pm * BM + wr * 64 + fr, col0 = u.pn * BM + wc * 32 + 4 * fq;
#pragma unroll
        for (int ai = 0; ai < 2; ++ai)
#pragma unroll
            for (int m = 0; m < 4; ++m) { float* rowp = C + (size_t)(row0 + ai * HALF + m * 16) * ldc + col0;
#pragma unroll
                for (int bj = 0; bj < 2; ++bj)
#pragma unroll
                    for (int n = 0; n < 2; ++n) { const f32x4 v = acc[ai][bj][m][n]; if (C) *(f32x4*)(rowp + bj * HALF + n * 16) = v;
                        u32x2 w; w.x = pk2(v.x, v.y); w.y = pk2(v.z, v.w); *(u32x2*)(Cb + (size_t)(row0 + ai * HALF + m * 16) * ldc + col0 + bj * HALF + n * 16) = w; } }
    }
};
struct EpiF32Atomic {
    static constexpr bool PERM = false;
    float* C; int ldc;
    __device__ __forceinline__ void operator()(const AccT& acc, const Unit& u, int wr, int wc, int fr, int fq) const {
        const int row0 = u.pm * BM + wr * 64 + fr, col0 = u.pn * BM + wc * 32 + 4 * fq;
#pragma unroll
        for (int ai = 0; ai < 2; ++ai)
#pragma unroll
            for (int m = 0; m < 4; ++m) { float* rowp = C + (size_t)(row0 + ai * HALF + m * 16) * ldc + col0;
#pragma unroll
                for (int bj = 0; bj < 2; ++bj)
#pragma unroll
                    for (int n = 0; n < 2; ++n)
#pragma unroll
                        for (int j = 0; j < 4; ++j) atomicAdd(rowp + bj * HALF + n * 16 + j, acc[ai][bj][m][n][j]); }
    }
};
struct EpiResid {
    static constexpr bool PERM = false;
    const float* base; float* out; const float* gate0; float* rowss;
    __device__ __forceinline__ void operator()(const AccT& acc, const Unit& u, int wr, int wc, int fr, int fq) const {
        const int row0 = u.pm * BM + wr * 64 + fr, col0 = u.pn * BM + wc * 32 + 4 * fq;
        const float* gate = gate0 + (u.pm >> 4) * D6;
        f32x4 gv[2][2];
#pragma unroll
        for (int bj = 0; bj < 2; ++bj)
#pragma unroll
            for (int n = 0; n < 2; ++n) gv[bj][n] = *(const f32x4*)(gate + col0 + bj * HALF + n * 16);
#pragma unroll
        for (int ai = 0; ai < 2; ++ai)
#pragma unroll
            for (int m = 0; m < 4; ++m) { const size_t off = (size_t)(row0 + ai * HALF + m * 16) * D + col0; float ss = 0.f;
#pragma unroll
                for (int bj = 0; bj < 2; ++bj)
#pragma unroll
                    for (int n = 0; n < 2; ++n) { const f32x4 bs = *(const f32x4*)(base + off + bj * HALF + n * 16); const f32x4 xo = bs + gv[bj][n] * acc[ai][bj][m][n]; *(f32x4*)(out + off + bj * HALF + n * 16) = xo;
                        ss += (xo.x * xo.x + xo.y * xo.y) + (xo.z * xo.z + xo.w * xo.w); }
                if (rowss) { const int ln = fr + 16 * fq; ss += shfl_xor_l(ss, 16, ln); ss += shfl_xor_l(ss, 32, ln); if (fq == 0) atomicAdd(rowss + row0 + ai * HALF + m * 16, ss); }
                asm volatile("" ::: "memory"); }
    }
};
struct EpiResidNorm {
    static constexpr bool PERM = true;
    const float* base; float* out; const float* gate0; const float* gp0; bf16_t* XG; float* rowss;
    __device__ __forceinline__ void operator()(const AccT& acc, const Unit& u, int wr, int wc, int fr, int fq) const {
        const int row0 = u.pm * BM + wr * 64 + fr, col0 = u.pn * BM + wc * 32 + 8 * fq, bb = u.pm >> 4, ln = fr + 16 * fq;
        const float* gate = gate0 + bb * D6; const float* gp = gp0 + bb * D;
        f32x4 gv[2][2], pv[2][2];
#pragma unroll
        for (int bj = 0; bj < 2; ++bj)
#pragma unroll
            for (int n = 0; n < 2; ++n) { gv[bj][n] = *(const f32x4*)(gate + col0 + bj * HALF + 4 * n); pv[bj][n] = *(const f32x4*)(gp + col0 + bj * HALF + 4 * n); }
#pragma unroll
        for (int ai = 0; ai < 2; ++ai)
#pragma unroll
            for (int m = 0; m < 4; ++m) { const int row = row0 + ai * HALF + m * 16; const size_t off = (size_t)row * D + col0; float ss = 0.f;
#pragma unroll
                for (int bj = 0; bj < 2; ++bj) {
                    const f32x4 b0 = *(const f32x4*)(base + off + bj * HALF), b1 = *(const f32x4*)(base + off + bj * HALF + 4);
                    const f32x4 x0 = b0 + gv[bj][0] * acc[ai][bj][m][0], x1 = b1 + gv[bj][1] * acc[ai][bj][m][1];
                    *(f32x4*)(out + off + bj * HALF) = x0; *(f32x4*)(out + off + bj * HALF + 4) = x1;
                    ss += (x0.x * x0.x + x0.y * x0.y) + (x0.z * x0.z + x0.w * x0.w) + (x1.x * x1.x + x1.y * x1.y) + (x1.z * x1.z + x1.w * x1.w);
                    const f32x4 y0 = x0 * pv[bj][0], y1 = x1 * pv[bj][1];
                    u32x4 w; w.x = pk2(y0.x, y0.y); w.y = pk2(y0.z, y0.w); w.z = pk2(y1.x, y1.y); w.w = pk2(y1.z, y1.w);
                    *(u32x4*)(XG + off + bj * HALF) = w; }
                ss += shfl_xor_l(ss, 16, ln); ss += shfl_xor_l(ss, 32, ln);
                if (fq == 0) atomicAdd(rowss + row, ss);
                asm volatile("" ::: "memory"); }
    }
};
template <int ACT> struct EpiBf16 {
    static constexpr bool PERM = true;
    bf16_t* O; int ldc; float* stats; int stat_pn0; const float* rowss; const float* bias0;
    __device__ __forceinline__ void operator()(const AccT& acc, const Unit& u, int wr, int wc, int fr, int fq) const {
        const int row0 = u.pm * BM + wr * 64 + fr, col0 = u.pn * BM + wc * 32 + 8 * fq;
        const bool do_stats = (ACT == 1) && (u.pn >= stat_pn0);
        const float* bias = bias0 + (u.pm >> 4) * F2;
        f32x4 bv[2][2];
#pragma unroll
        for (int bj = 0; bj < 2; ++bj)
#pragma unroll
            for (int n = 0; n < 2; ++n) bv[bj][n] = *(const f32x4*)(bias + col0 + bj * HALF + 4 * n);
#pragma unroll
        for (int ai = 0; ai < 2; ++ai)
#pragma unroll
            for (int m = 0; m < 4; ++m) { const int row = row0 + ai * HALF + m * 16; bf16_t* rowp = O + (size_t)row * ldc + col0; float s = 0.f, q = 0.f;
                const float rstd = __builtin_amdgcn_rsqf(rowss[row] * (1.f / D) + 1e-6f);
#pragma unroll
                for (int bj = 0; bj < 2; ++bj) { f32x4 v0 = acc[ai][bj][m][0] * rstd + bv[bj][0], v1 = acc[ai][bj][m][1] * rstd + bv[bj][1];
                    if (ACT == 1) {
#pragma unroll
                        for (int j = 0; j < 4; ++j) { v0[j] = gelu_tanh_f(v0[j]); v1[j] = gelu_tanh_f(v1[j]); s += v0[j] + v1[j]; q += v0[j] * v0[j] + v1[j] * v1[j]; } }
                    u32x4 w; w.x = pk2(v0[0], v0[1]); w.y = pk2(v0[2], v0[3]); w.z = pk2(v1[0], v1[1]); w.w = pk2(v1[2], v1[3]);
                    *(u32x4*)(rowp + bj * HALF) = w; }
                if (ACT == 1) { if (do_stats) { const int ln = fr + 16 * fq; s += shfl_xor_l(s, 16, ln); s += shfl_xor_l(s, 32, ln); q += shfl_xor_l(q, 16, ln); q += shfl_xor_l(q, 32, ln);
                    if (fq == 0) { atomicAdd(stats + 2 * row, s); atomicAdd(stats + 2 * row + 1, q); } } } }
    }
};
struct EpiGlu {
    static constexpr bool PERM = true;
    const bf16_t* Gm; bf16_t* O; const float* bias;
    __device__ __forceinline__ void operator()(const AccT& acc, const Unit& u, int wr, int wc, int fr, int fq) const {
        const int row0 = u.pm * BM + wr * 64 + fr, col0 = u.pn * BM + wc * 32 + 8 * fq;
        f32x4 bv[2][2];
#pragma unroll
        for (int bj = 0; bj < 2; ++bj)
#pragma unroll
            for (int n = 0; n < 2; ++n) bv[bj][n] = *(const f32x4*)(bias + col0 + bj * HALF + 4 * n);
#pragma unroll
        for (int ai = 0; ai < 2; ++ai)
#pragma unroll
            for (int m = 0; m < 4; ++m) { const size_t off = (size_t)(row0 + ai * HALF + m * 16) * D + col0;
#pragma unroll
                for (int bj = 0; bj < 2; ++bj) { const f32x4 v0 = acc[ai][bj][m][0] + bv[bj][0], v1 = acc[ai][bj][m][1] + bv[bj][1];
                    const u32x4 gw = *(const u32x4*)(Gm + off + bj * HALF);
                    u32x4 w;
                    w.x = pk2(bf_lo(gw.x) * sigmoid_f(v0[0]), bf_hi(gw.x) * sigmoid_f(v0[1]));
                    w.y = pk2(bf_lo(gw.y) * sigmoid_f(v0[2]), bf_hi(gw.y) * sigmoid_f(v0[3]));
                    w.z = pk2(bf_lo(gw.z) * sigmoid_f(v1[0]), bf_hi(gw.z) * sigmoid_f(v1[1]));
                    w.w = pk2(bf_lo(gw.w) * sigmoid_f(v1[2]), bf_hi(gw.w) * sigmoid_f(v1[3]));
                    *(u32x4*)(O + off + bj * HALF) = w; } }
    }
};
}

__device__ __forceinline__ void p0_gemv_task(CArgsP a, LAS unsigned char* lds, int tk) {
    const int t = tid_opaque();
    LAS float* sv = (LAS float*)lds;
    LAS float* red = (LAS float*)(lds + 24576);
    const int l = tk / 384, n0 = (tk % 384) * 32;
    const float* c = a->in[1]; const float* cc = a->in[3];
    for (int i = t; i < 3 * D; i += NTHREADS) { const float x = i < 2 * D ? c[i] : cc[i - 2 * D]; sv[i] = silu_f(x); }
    __syncthreads();
    const int cq = t & 7, ks = t >> 3;
    const float* W = a->in[6] + (size_t)l * D * D6 + n0 + 4 * cq;
    f32x4 acc0 = {0.f, 0.f, 0.f, 0.f}, acc1 = acc0, acc2 = acc0;
#pragma unroll 8
    for (int kk = 0; kk < 32; ++kk) { const int k = ks * 32 + kk; const f32x4 w = __builtin_nontemporal_load((const f32x4*)(W + (size_t)k * D6));
        const float s0 = sv[k], s1 = sv[D + k], s2 = sv[2 * D + k]; acc0 += w * s0; acc1 += w * s1; acc2 += w * s2; }
    LAS float* rp = red + ks * 96 + cq * 12;
#pragma unroll
    for (int j = 0; j < 4; ++j) { rp[j] = acc0[j]; rp[4 + j] = acc1[j]; rp[8 + j] = acc2[j]; }
    __syncthreads();
    if (t < 96) { float s = 0.f;
#pragma unroll 8
        for (int j = 0; j < 64; ++j) s += red[j * 96 + t];
        const int q = t / 12, i = t % 12, v = i >> 2, comp = i & 3, n = n0 + 4 * q + comp;
        float* modbuf = (float*)(a->ws + WS_MOD);
        modbuf[(l * 3 + v) * D6 + n] = s + a->in[7][l * D6 + n]; }
    __syncthreads();
}

struct TMat { const float* W; bf16_t* Wt; int K, N; float* bias; const float* shift; };
__device__ __forceinline__ bool tr_decode(CArgsP a, int task, int t_end, TMat& m, int& k0, int& n0) {
    constexpr int C0 = 256, C1 = 512, C2 = 768, C3 = C2 + 1408, C4 = C3 + 1408, C5 = C4 + 704, C6 = C5 + 704, C7 = C6 + 1024, C8 = C7 + 512;
    if (task >= t_end) return false;
    int base;
    float* BI = (float*)(a->ws + WS_BIAS); const float* MD = (const float*)(a->ws + WS_MOD);
    if (task < C0) { m = {a->in[12], (bf16_t*)(a->ws + WS_WIN), D, D, nullptr, nullptr}; base = 0; }
    else if (task < C1) { m = {a->in[21], (bf16_t*)(a->ws + WS_WGLU), D, D, nullptr, nullptr}; base = C0; }
    else if (task < C2) { m = {a->in[23], (bf16_t*)(a->ws + WS_WOUT), D, D, nullptr, nullptr}; base = C1; }
    else if (task < C3) { m = {a->in[8], (bf16_t*)(a->ws + WS_UP0), D, F2, BI, MD + 3 * D}; base = C2; }
    else if (task < C4) { m = {a->in[8] + (size_t)D * F2, (bf16_t*)(a->ws + WS_UP1), D, F2, BI + 4 * F2, MD + 3 * D6 + 3 * D}; base = C3; }
    else if (task < C5) { m = {a->in[11], (bf16_t*)(a->ws + WS_DN0), FF, D, nullptr, nullptr}; base = C4; }
    else if (task < C6) { m = {a->in[11] + (size_t)FF * D, (bf16_t*)(a->ws + WS_DN1), FF, D, nullptr, nullptr}; base = C5; }
    else if (task < C7) { m = {a->in[24], (bf16_t*)(a->ws + WS_SIN_W), D, SD2, BI + 2 * F2, MD + 3 * D6}; base = C6; }
    else { m = {a->in[29], (bf16_t*)(a->ws + WS_SOUT_W), SD, D, nullptr, nullptr}; base = C7; }
    const int idx = task - base, ntn = m.N >> 7;
    k0 = (idx / ntn) * 128; n0 = (idx % ntn) * 128;
    return true;
}
__device__ __forceinline__ void tr_load(const TMat& m, int k0, int n0, int t, f32x4 (&r)[8]) {
    const int c4 = t & 31, rr = t >> 5;
#pragma unroll
    for (int i = 0; i < 8; ++i) r[i] = __builtin_nontemporal_load((const f32x4*)(m.W + (size_t)(k0 + rr + 16 * i) * m.N + n0 + 4 * c4));
}
constexpr int TR_PITCH = 132;
constexpr int TRC_UP1_B = 768 + 1408, TRC_UP1_E = TRC_UP1_B + 1408, TRC_DN1_B = TRC_UP1_E + 704, TRC_DN1_E = TRC_DN1_B + 704, TRC_END = TRC_DN1_E + 1024 + 512;
__device__ __forceinline__ int tr_remap(int v) {
    if (v >= TRC_UP1_B) v += 1408; if (v >= TRC_DN1_B) v += 704; return v; }
__device__ __forceinline__ void tr_step(LAS float* tile, LAS float* shl, int t, f32x4 (&r)[8], const TMat& m, int k0, int n0, bool nok, const TMat& nm, int nk0, int nn0) {
    { const int c4 = t & 31, rr = t >> 5;
#pragma unroll
      for (int i = 0; i < 8; ++i) *(LAS f32x4*)(tile + (rr + 16 * i) * TR_PITCH + 4 * c4) = r[i];
      if (m.bias && t < 256) shl[t] = m.shift[(t >> 7) * D6 + k0 + (t & 127)]; }
    __syncthreads();
    if (nok) tr_load(nm, nk0, nn0, t, r);
    { const int n = t & 127, kq = t >> 7; const LAS float* s = tile + (32 * kq) * TR_PITCH + n;
      bf16_t* dst = m.Wt + (size_t)(n0 + n) * m.K + k0 + 32 * kq;
#pragma unroll
      for (int h = 0; h < 4; ++h) { u32x4 o0;
        o0.x = pk2(s[(8 * h + 0) * TR_PITCH], s[(8 * h + 1) * TR_PITCH]); o0.y = pk2(s[(8 * h + 2) * TR_PITCH], s[(8 * h + 3) * TR_PITCH]);
        o0.z = pk2(s[(8 * h + 4) * TR_PITCH], s[(8 * h + 5) * TR_PITCH]); o0.w = pk2(s[(8 * h + 6) * TR_PITCH], s[(8 * h + 7) * TR_PITCH]);
        *(u32x4*)(dst + 8 * h) = o0; }
      if (m.bias) { float p0 = 0.f, p1 = 0.f;
#pragma unroll 8
        for (int i = 0; i < 32; ++i) { const float w = s[i * TR_PITCH]; p0 += w * shl[32 * kq + i]; p1 += w * shl[128 + 32 * kq + i]; }
        atomicAdd(m.bias + n0 + n, p0); atomicAdd(m.bias + F2 + n0 + n, p1); } }
    __syncthreads();
}
template <int MODE>
__device__ __forceinline__ void p0_transpose_all(CArgsP a, LAS unsigned char* lds, int first, int stride, int t_end) {
    const int t = tid_opaque();
    LAS float* tile = (LAS float*)lds;
    LAS float* shl = (LAS float*)(lds + 128 * TR_PITCH * 4);
    TMat ma, mb; int ka, na, kb, nb; f32x4 ra[8], rb[8];
    int task = first;
    bool oka = tr_decode(a, MODE == 1 ? tr_remap(task) : task, t_end, ma, ka, na); if (oka) tr_load(ma, ka, na, t, ra);
    task += stride;
    bool okb = tr_decode(a, MODE == 1 ? tr_remap(task) : task, t_end, mb, kb, nb); if (okb) tr_load(mb, kb, nb, t, rb);
    while (oka) {
        { TMat nm; int nk, nn; task += stride; const bool nok = tr_decode(a, MODE == 1 ? tr_remap(task) : task, t_end, nm, nk, nn);
          tr_step(tile, shl, t, ra, ma, ka, na, nok, nm, nk, nn); oka = nok; ma = nm; ka = nk; na = nn; }
        if (!okb) break;
        { TMat nm; int nk, nn; task += stride; const bool nok = tr_decode(a, MODE == 1 ? tr_remap(task) : task, t_end, nm, nk, nn);
          tr_step(tile, shl, t, rb, mb, kb, nb, nok, nm, nk, nn); okb = nok; mb = nm; kb = nk; nb = nn; }
    }
}

__device__ __forceinline__ void sincos_d(double x, double& s, double& c) {
    const double k = __builtin_rint(x * 0.63661977236758134308);
    double r = __builtin_fma(-k, 1.57079632679489655800e+00, x);
    r = __builtin_fma(-k, 6.12323399573676603587e-17, r);
    const double r2 = r * r;
    double sp = -7.6471637318198164759e-13; sp = sp * r2 + 1.6059043836821614599e-10; sp = sp * r2 - 2.5052108385441718775e-08; sp = sp * r2 + 2.7557319223985890653e-06;
    sp = sp * r2 - 1.9841269841269841270e-04; sp = sp * r2 + 8.3333333333333333333e-03; sp = sp * r2 - 1.6666666666666666667e-01; sp = r + r * r2 * sp;
    double cp = 4.7794773323873852974e-14; cp = cp * r2 - 1.1470745597729724714e-11; cp = cp * r2 + 2.0876756987868098979e-09; cp = cp * r2 - 2.7557319223985890653e-07;
    cp = cp * r2 + 2.4801587301587301587e-05; cp = cp * r2 - 1.3888888888888888889e-03; cp = cp * r2 + 4.1666666666666666667e-02; cp = cp * r2 - 0.5; cp = 1.0 + r2 * cp;
    const int q = ((int)(long long)k) & 3;
    s = (q == 0) ? sp : (q == 1) ? cp : (q == 2) ? -sp : -cp;
    c = (q == 0) ? cp : (q == 1) ? -sp : (q == 2) ? -cp : sp;
}
__device__ __forceinline__ double exp_d(double x) {
    const double k = __builtin_rint(x * 1.44269504088896340736);
    double r = __builtin_fma(-k, 6.93147180369123816490e-01, x);
    r = __builtin_fma(-k, 1.90821492927058770002e-10, r);
    double p = 1.0 / 479001600.0;
    p = p * r + 1.0 / 39916800.0; p = p * r + 1.0 / 3628800.0; p = p * r + 1.0 / 362880.0; p = p * r + 1.0 / 40320.0; p = p * r + 1.0 / 5040.0;
    p = p * r + 1.0 / 720.0; p = p * r + 1.0 / 120.0; p = p * r + 1.0 / 24.0; p = p * r + 1.0 / 6.0; p = p * r + 0.5; p = p * r + 1.0; p = p * r + 1.0;
    const long long e = (long long)k + 1023;
    return p * __builtin_bit_cast(double, (unsigned long long)e << 52);
}
__device__ __forceinline__ void p0_s5_tables(CArgsP a, int idx) {
    const int d = idx >> 13, g = (idx >> 6) & 127, p = idx & 63, gd = g * 2 + d;
    const double are = a->in[13][idx], aim = a->in[14][idx];
    const double dt = exp_d((double)a->in[19][d * NG + g]);
    const double mag = exp_d(are * dt); double sn, cs; sincos_d(aim * dt, sn, cs);
    const double lr = mag * cs, li = mag * sn, den = are * are + aim * aim;
    const double kr = ((lr - 1.0) * are + li * aim) / den, ki = (li * are - (lr - 1.0) * aim) / den;
    const double magT = exp_d(are * dt * (double)TC); double snT, csT; sincos_d(aim * dt * (double)TC, snT, csT);
    f32x2* lam = (f32x2*)(a->ws + WS_LAM); f32x2* lamT = (f32x2*)(a->ws + WS_LAMT);
    lam[gd * 64 + p] = (f32x2){(float)lr, (float)li};
    lamT[gd * 64 + p] = (f32x2){(float)(magT * csT), (float)(magT * snT)};
    bf16_t* Bcat = (bf16_t*)(a->ws + WS_BCAT) + (size_t)(gd * 128 + 2 * p) * 16;
    const float* bre = a->in[15] + (size_t)idx * 16; const float* bim = a->in[16] + (size_t)idx * 16;
#pragma unroll
    for (int h = 0; h < 16; h += 2) {
        const double br0 = bre[h], bi0 = bim[h], br1 = bre[h + 1], bi1 = bim[h + 1];
        *(unsigned*)(Bcat + h) = pk2((float)(kr * br0 - ki * bi0), (float)(kr * br1 - ki * bi1));
        *(unsigned*)(Bcat + 16 + h) = pk2((float)(kr * bi0 + ki * br0), (float)(kr * bi1 + ki * br1));
    }
    bf16_t* Cc = (bf16_t*)(a->ws + WS_CCAT);
    const float* cre = a->in[17] + (size_t)(d * NG + g) * 16 * 64 + p; const float* cim = a->in[18] + (size_t)(d * NG + g) * 16 * 64 + p;
#pragma unroll
    for (int part = 0; part < 2; ++part) {
        const int R = 2 * p + part, tau = R >> 5, rho = R & 31, s = rho >> 4, hh = (rho >> 2) & 1, j = ((rho >> 3) & 1) * 4 + (rho & 3);
        bf16_t* dst = Cc + ((size_t)(((gd * 4 + tau) * 2 + s) * 2 + hh) * 16) * 8 + j;
        for (int h = 0; h < 16; ++h) dst[h * 8] = f2bf(part == 0 ? cre[h * 64] : -cim[h * 64]);
    }
}

__device__ __forceinline__ void p0_s5_kend(CArgsP a, int idx, int seg) {
    const int d = idx >> 13, g = (idx >> 6) & 127, p = idx & 63, gd = g * 2 + d;
    const double are = a->in[13][idx], aim = a->in[14][idx];
    const double dt = exp_d((double)a->in[19][d * NG + g]);
    const double mag = exp_d(are * dt); double sn, cs; sincos_d(aim * dt, sn, cs);
    const double lr = mag * cs, li = mag * sn, den = are * are + aim * aim;
    const double kr = ((lr - 1.0) * are + li * aim) / den, ki = (li * are - (lr - 1.0) * aim) / den;
    const int t_lo = seg == 0 ? 0 : seg == 1 ? 9 : seg == 2 ? 18 : 26, t_hi = seg == 0 ? 9 : seg == 1 ? 18 : seg == 2 ? 26 : 34;
    const double pw = (double)(TC - t_hi);
    const double magP = exp_d(are * dt * pw); double snP, csP; sincos_d(aim * dt * pw, snP, csP);
    double pr = magP * csP, pi = magP * snP;
    float bbr[16], bbi[16];
    const float* bre = a->in[15] + (size_t)idx * 16; const float* bim = a->in[16] + (size_t)idx * 16;
#pragma unroll
    for (int h = 0; h < 16; ++h) { const double br = bre[h], bi = bim[h]; bbr[h] = (float)(kr * br - ki * bi); bbi[h] = (float)(kr * bi + ki * br); }
    for (int tt = t_hi - 1; tt >= t_lo; --tt) {
        const float fr = (float)pr, fi = (float)pi;
        bf16_t* dst = (bf16_t*)(a->ws + WS_KEND) + (((size_t)gd * TC + tt) * 128 + 2 * p) * 16;
        u32x4 w0, w1, w2, w3;
        w0.x = pk2(fr * bbr[0] - fi * bbi[0], fr * bbr[1] - fi * bbi[1]); w0.y = pk2(fr * bbr[2] - fi * bbi[2], fr * bbr[3] - fi * bbi[3]);
        w0.z = pk2(fr * bbr[4] - fi * bbi[4], fr * bbr[5] - fi * bbi[5]); w0.w = pk2(fr * bbr[6] - fi * bbi[6], fr * bbr[7] - fi * bbi[7]);
        w1.x = pk2(fr * bbr[8] - fi * bbi[8], fr * bbr[9] - fi * bbi[9]); w1.y = pk2(fr * bbr[10] - fi * bbi[10], fr * bbr[11] - fi * bbi[11]);
        w1.z = pk2(fr * bbr[12] - fi * bbi[12], fr * bbr[13] - fi * bbi[13]); w1.w = pk2(fr * bbr[14] - fi * bbi[14], fr * bbr[15] - fi * bbi[15]);
        w2.x = pk2(fr * bbi[0] + fi * bbr[0], fr * bbi[1] + fi * bbr[1]); w2.y = pk2(fr * bbi[2] + fi * bbr[2], fr * bbi[3] + fi * bbr[3]);
        w2.z = pk2(fr * bbi[4] + fi * bbr[4], fr * bbi[5] + fi * bbr[5]); w2.w = pk2(fr * bbi[6] + fi * bbr[6], fr * bbi[7] + fi * bbr[7]);
        w3.x = pk2(fr * bbi[8] + fi * bbr[8], fr * bbi[9] + fi * bbr[9]); w3.y = pk2(fr * bbi[10] + fi * bbr[10], fr * bbi[11] + fi * bbr[11]);
        w3.z = pk2(fr * bbi[12] + fi * bbr[12], fr * bbi[13] + fi * bbr[13]); w3.w = pk2(fr * bbi[14] + fi * bbr[14], fr * bbi[15] + fi * bbr[15]);
        *(u32x4*)dst = w0; *(u32x4*)(dst + 8) = w1; *(u32x4*)(dst + 16) = w2; *(u32x4*)(dst + 24) = w3;
        const double nr = pr * lr - pi * li, ni = pr * li + pi * lr; pr = nr; pi = ni;
    }
}

template <bool OUT_F32, int NR>
__device__ __forceinline__ void norm_rows(const float* (&src)[NR], const float* g, const float* (&shift)[NR], void* (&dst)[NR], const bool (&valid)[NR], int lane) {
    f32x4 v[NR][8];
#pragma unroll
    for (int r = 0; r < NR; ++r)
#pragma unroll
        for (int j = 0; j < 8; ++j) v[r][j] = __builtin_nontemporal_load((const f32x4*)src[r] + lane + 64 * j);
#pragma unroll
    for (int r = 0; r < NR; ++r) {
        float ss = 0.f;
#pragma unroll
        for (int j = 0; j < 8; ++j) ss += (v[r][j].x * v[r][j].x + v[r][j].y * v[r][j].y) + (v[r][j].z * v[r][j].z + v[r][j].w * v[r][j].w);
        ss = wave_sum(ss, lane);
        const float rstd = __builtin_amdgcn_rsqf(ss * (1.f / D) + 1e-6f);
        if (valid[r]) {
#pragma unroll
            for (int j = 0; j < 8; ++j) {
                const f32x4 gv = ((const f32x4*)g)[lane + 64 * j]; f32x4 y = v[r][j] * rstd * gv;
                if (OUT_F32) ((f32x4*)dst[r])[lane + 64 * j] = y;
                else { const f32x4 sh = ((const f32x4*)shift[r])[lane + 64 * j], sc = ((const f32x4*)(shift[r] + D))[lane + 64 * j]; y = y * (sc + 1.f) + sh;
                    u32x2 w; w.x = pk2(y.x, y.y); w.y = pk2(y.z, y.w); ((u32x2*)dst[r])[lane + 64 * j] = w; }
            }
        }
    }
}

#define MFMA32(a, b, c) __builtin_amdgcn_mfma_f32_32x32x16_bf16((a), (b), (c), 0, 0, 0)
__device__ __forceinline__ bf16x8 pack8(const f32x4& a, const f32x4& b) { u32x4 p; p.x = pk2(a.x, a.y); p.y = pk2(a.z, a.w); p.z = pk2(b.x, b.y); p.w = pk2(b.z, b.w); return __builtin_bit_cast(bf16x8, p); }
template <bool PASSB>
__device__ __forceinline__ void s5_pass(CArgsP a, LAS unsigned char* lds, int gw, int nw, int lane) {
    LAS unsigned char* cfl = lds + tid_opaque() * 16;
    LAS unsigned char* lamL = lds + 65536 + (tid_opaque() >> 6) * 512;
    const bf16_t* U = (const bf16_t*)(a->ws + WS_UB);
    const f32x2* lam = (const f32x2*)(a->ws + WS_LAM);
    const bf16_t* Bcat = (const bf16_t*)(a->ws + WS_BCAT);
    const bf16_t* Cc = (const bf16_t*)(a->ws + WS_CCAT);
    for (int item = gw; item < 2048; item += nw) {
        const int g = item & 127, tile = (item >> 7) & 7, d = item >> 10, gd = g * 2 + d;
        const int r = lane & 31, hh = lane >> 5, col = tile * 32 + r, b = col >> 7, c = col & 127;
        bf16x8 Bf[4];
#pragma unroll
        for (int tau = 0; tau < 4; ++tau) Bf[tau] = *(const bf16x8*)(Bcat + (size_t)(gd * 128 + 32 * tau + r) * 16 + 8 * hh);
        { const int p = lane, tau = p >> 4, pl = p & 15, q = ((pl >> 2) << 1) | (pl & 1), h2 = (pl >> 1) & 1;
          *(LAS f32x2*)(lamL + ((tau * 2 + h2) * 8 + q) * 8) = lam[gd * 64 + p]; }
        f32x16 S[4];
        float* Ebuf = (float*)(a->ws + (PASSB ? WS_SI : WS_E)) + ((size_t)gd * NCOL + col) * 128 + 4 * hh;
        if (PASSB) {
#pragma unroll
            for (int tau = 0; tau < 4; ++tau)
#pragma unroll
                for (int i4 = 0; i4 < 4; ++i4) { const f32x4 v = *(const f32x4*)(Ebuf + 32 * tau + 8 * i4); S[tau][4 * i4] = v.x; S[tau][4 * i4 + 1] = v.y; S[tau][4 * i4 + 2] = v.z; S[tau][4 * i4 + 3] = v.w; }
        } else {
#pragma unroll
            for (int tau = 0; tau < 4; ++tau)
#pragma unroll
                for (int i = 0; i < 16; ++i) S[tau][i] = 0.f;
        }
        if (PASSB) {
#pragma unroll
            for (int tau = 0; tau < 4; ++tau)
#pragma unroll
                for (int s = 0; s < 2; ++s) {
                    u32x4 z = {0u, 0u, 0u, 0u};
                    if (r < 16) z = *(const u32x4*)(Cc + ((size_t)((((gd * 4 + tau) * 2 + s) * 2 + hh) * 16 + r)) * 8);
                    *(LAS u32x4*)(cfl + (tau * 2 + s) * 8192) = z;
                }
        }
        bf16_t* Yd = (bf16_t*)(a->ws + (d == 0 ? WS_YF : WS_YR));
        const int pos0 = TC * c;
        auto memidx = [&](int pos) -> int { return d == 0 ? pos : (pos < CTXL ? (CTXL - 1 - pos) : (LT + CTXL - 1 - pos)); };
        const bf16_t* ub = U + (size_t)b * LT * D + g * 16 + 8 * hh;
        auto ldu = [&](int mem) -> bf16x8 { return *(const bf16x8*)(ub + (size_t)mem * D); };
        bf16x8 un[8];
#pragma unroll
        for (int j = 0; j < 8; ++j) un[j] = ldu(memidx(pos0 + j));
#pragma unroll 1
        for (int tb = 0; tb < TC; tb += 8) {
#pragma unroll
          for (int j = 0; j < 8; j += 2) {
            const int t = tb + j;
            if (t < TC) {
            asm volatile("" ::: "memory");
            const bf16x8 ufa = un[j], ufb = un[j + 1];
            const int posa = pos0 + t, mema = memidx(posa), memb = memidx(posa + 1);
            if (t + 8 < TC) { un[j] = ldu(memidx(posa + 8)); un[j + 1] = ldu(memidx(posa + 9)); }
            f32x16 Ya, Yb;
#pragma unroll
            for (int i = 0; i < 16; ++i) { Ya[i] = 0.f; Yb[i] = 0.f; }
#pragma unroll
            for (int tau = 0; tau < 4; ++tau) {
                const LAS f32x4* lp = (const LAS f32x4*)(lamL + (tau * 2 + hh) * 64);
                const f32x4 l0 = lp[0], l1 = lp[1], l2 = lp[2], l3 = lp[3];
                const float lrr[8] = {l0.x, l0.z, l1.x, l1.z, l2.x, l2.z, l3.x, l3.z}, lii[8] = {l0.y, l0.w, l1.y, l1.w, l2.y, l2.w, l3.y, l3.w};
                bf16x8 cf0, cf1;
                if (PASSB) { cf0 = *(const LAS bf16x8*)(cfl + (tau * 2 + 0) * 8192); cf1 = *(const LAS bf16x8*)(cfl + (tau * 2 + 1) * 8192); }
#pragma unroll
                for (int half = 0; half < 2; ++half) {
                    f32x16 C;
#pragma unroll
                    for (int q = 0; q < 8; ++q) { const float sr = S[tau][2 * q], si = S[tau][2 * q + 1];
                        C[2 * q] = lrr[q] * sr - lii[q] * si; C[2 * q + 1] = lrr[q] * si + lii[q] * sr; }
                    S[tau] = MFMA32(Bf[tau], half == 0 ? ufa : ufb, C);
                    if (PASSB) {
                        u32x4 p0, p1;
                        p0.x = pk2(S[tau][0], S[tau][1]); p0.y = pk2(S[tau][2], S[tau][3]); p0.z = pk2(S[tau][4], S[tau][5]); p0.w = pk2(S[tau][6], S[tau][7]);
                        p1.x = pk2(S[tau][8], S[tau][9]); p1.y = pk2(S[tau][10], S[tau][11]); p1.z = pk2(S[tau][12], S[tau][13]); p1.w = pk2(S[tau][14], S[tau][15]);
                        if (half == 0) { Ya = MFMA32(cf0, __builtin_bit_cast(bf16x8, p0), Ya); Ya = MFMA32(cf1, __builtin_bit_cast(bf16x8, p1), Ya); }
                        else { Yb = MFMA32(cf0, __builtin_bit_cast(bf16x8, p0), Yb); Yb = MFMA32(cf1, __builtin_bit_cast(bf16x8, p1), Yb); }
                    }
                }
            }
            if (PASSB) {
                if (posa >= CTXL) {
                    bf16_t* yp = Yd + ((size_t)b * SEQ + (mema - CTXL)) * D + g * 16 + 4 * hh;
                    u32x2 w0, w1; w0.x = pk2(Ya[0], Ya[1]); w0.y = pk2(Ya[2], Ya[3]); w1.x = pk2(Ya[4], Ya[5]); w1.y = pk2(Ya[6], Ya[7]);
                    *(u32x2*)yp = w0; *(u32x2*)(yp + 8) = w1;
                }
                if (posa + 1 >= CTXL) {
                    bf16_t* yp = Yd + ((size_t)b * SEQ + (memb - CTXL)) * D + g * 16 + 4 * hh;
                    u32x2 w0, w1; w0.x = pk2(Yb[0], Yb[1]); w0.y = pk2(Yb[2], Yb[3]); w1.x = pk2(Yb[4], Yb[5]); w1.y = pk2(Yb[6], Yb[7]);
                    *(u32x2*)yp = w0; *(u32x2*)(yp + 8) = w1;
                }
            }
            }
          }
        }
        if (!PASSB) {
#pragma unroll
            for (int tau = 0; tau < 4; ++tau)
#pragma unroll
                for (int i4 = 0; i4 < 4; ++i4) *(f32x4*)(Ebuf + 32 * tau + 8 * i4) = (f32x4){S[tau][4 * i4], S[tau][4 * i4 + 1], S[tau][4 * i4 + 2], S[tau][4 * i4 + 3]};
        }
    }
}

__device__ __forceinline__ void s5_passA(CArgsP a, int gw, int nw, int lane) {
    const bf16_t* U = (const bf16_t*)(a->ws + WS_UB);
    const bf16_t* KE = (const bf16_t*)(a->ws + WS_KEND);
    for (int item = gw; item < 2048; item += nw) {
        const int g = item & 127, tile = (item >> 7) & 7, d = item >> 10, gd = g * 2 + d;
        const int r = lane & 31, hh = lane >> 5, col = tile * 32 + r, b = col >> 7, c = col & 127;
        f32x16 S[4];
#pragma unroll
        for (int tau = 0; tau < 4; ++tau)
#pragma unroll
            for (int i = 0; i < 16; ++i) S[tau][i] = 0.f;
        float* Ebuf = (float*)(a->ws + WS_E) + ((size_t)gd * NCOL + col) * 128 + 4 * hh;
        const int pos0 = TC * c;
        auto memidx = [&](int pos) -> int { return d == 0 ? pos : (pos < CTXL ? (CTXL - 1 - pos) : (LT + CTXL - 1 - pos)); };
        const bf16_t* ub = U + (size_t)b * LT * D + g * 16 + 8 * hh;
        const bf16_t* kb = KE + ((size_t)gd * TC * 128 + r) * 16 + 8 * hh;
        bf16x8 un[8], af[4][4];
#pragma unroll
        for (int j = 0; j < 8; ++j) un[j] = *(const bf16x8*)(ub + (size_t)memidx(pos0 + j) * D);
#pragma unroll
        for (int j = 0; j < 4; ++j)
#pragma unroll
            for (int tau = 0; tau < 4; ++tau) af[j][tau] = *(const bf16x8*)(kb + ((size_t)j * 128 + 32 * tau) * 16);
#pragma unroll 1
        for (int tb = 0; tb < TC; tb += 8) {
#pragma unroll
            for (int j = 0; j < 8; ++j) {
                const int t = tb + j;
                if (t < TC) {
                    const bf16x8 uf = un[j];
                    const bf16x8 a0 = af[j & 3][0], a1 = af[j & 3][1], a2 = af[j & 3][2], a3 = af[j & 3][3];
                    if (t + 8 < TC) un[j] = *(const bf16x8*)(ub + (size_t)memidx(pos0 + t + 8) * D);
                    if (t + 4 < TC) {
#pragma unroll
                        for (int tau = 0; tau < 4; ++tau) af[j & 3][tau] = *(const bf16x8*)(kb + ((size_t)(t + 4) * 128 + 32 * tau) * 16); }
                    S[0] = MFMA32(a0, uf, S[0]); S[1] = MFMA32(a1, uf, S[1]); S[2] = MFMA32(a2, uf, S[2]); S[3] = MFMA32(a3, uf, S[3]);
                }
            }
        }
#pragma unroll
        for (int tau = 0; tau < 4; ++tau)
#pragma unroll
            for (int i4 = 0; i4 < 4; ++i4) *(f32x4*)(Ebuf + 32 * tau + 8 * i4) = (f32x4){S[tau][4 * i4], S[tau][4 * i4 + 1], S[tau][4 * i4 + 2], S[tau][4 * i4 + 3]};
    }
}

__device__ __forceinline__ float dot2bf(unsigned z, unsigned w, float acc) { return __builtin_amdgcn_fdot2_f32_bf16(__builtin_bit_cast(bf16x2v, z), __builtin_bit_cast(bf16x2v, w), acc, false); }
__device__ __forceinline__ void conv_phase(CArgsP a, LAS unsigned char* lds, int layer, int first, int stride) {
    const int t0 = tid_opaque();
    const bf16_t* Z = (const bf16_t*)(a->ws + WS_Z); bf16_t* A3 = (bf16_t*)(a->ws + WS_A3);
    const float* cw = a->in[9] + (size_t)layer * 9 * F2; const float* cb = a->in[10] + (size_t)layer * F2;
    LAS unsigned* wl = (LAS unsigned*)lds;
    for (int task = first; task < 704; task += stride) {
        const int t = launder_i(t0), o = t & 15, c = (t >> 4) + 32 * ((task / 44) & 1);
        const int cbk = task % 44, rb = (task / 88) & 3, b = task / 352;
        __syncthreads();
#pragma unroll
        for (int it = 0; it < 5; ++it) { const int i = t + it * NTHREADS; { const int tap = i >> 8, half = (i >> 7) & 1, ch = i & 127; const int gch = half * FF + cbk * 128 + ch;
            const float wv = tap < 9 ? cw[(size_t)tap * F2 + gch] : cb[gch];
            wl[i] = tap < 9 ? ((ch & 1) ? (pk2(0.f, wv)) : (pk2(wv, 0.f))) : __builtin_bit_cast(unsigned, wv); } }
        __syncthreads();
        const u32x4 zero4 = {0u, 0u, 0u, 0u};
        u32x4 win[6][3][2];
        const size_t chg = (size_t)cbk * 128 + 8 * o;
        auto ldrow = [&](int rrow, u32x4 (&w)[3][2]) {
#pragma unroll
            for (int dj = 0; dj < 3; ++dj) { const int cc2 = c + dj - 1; const bool ok = (rrow >= 0) && (rrow < 64) && (cc2 >= 0) && (cc2 < 64);
                if (ok) { const bf16_t* zp = Z + ((size_t)b * SEQ + rrow * 64 + cc2) * F2 + chg; w[dj][0] = *(const u32x4*)zp; w[dj][1] = *(const u32x4*)(zp + FF); }
                else { w[dj][0] = zero4; w[dj][1] = zero4; } }
        };
        const int r0 = rb * 16;
        ldrow(r0 - 1, win[0]); ldrow(r0, win[1]); ldrow(r0 + 1, win[2]); ldrow(r0 + 2, win[3]);
#pragma unroll
        for (int q = 0; q < 8; ++q) {
                asm volatile("" ::: "memory");
                const int row = r0 + 2 * q;
                if (q <= 6) { ldrow(row + 3, win[(2 * q + 4) % 6]); ldrow(row + 4, win[(2 * q + 5) % 6]); }
                float ag[2][8], av[2][8];
                { const LAS f32x4* bp = (const LAS f32x4*)(wl + 9 * 256 + 8 * o); const f32x4 b0 = bp[0], b1 = bp[1], b2 = bp[32], b3 = bp[33];
#pragma unroll
                  for (int rr = 0; rr < 2; ++rr)
#pragma unroll
                  for (int j = 0; j < 4; ++j) { ag[rr][j] = b0[j]; ag[rr][4 + j] = b1[j]; av[rr][j] = b2[j]; av[rr][4 + j] = b3[j]; } }
#pragma unroll
                for (int di = 0; di < 3; ++di)
#pragma unroll
                    for (int dj = 0; dj < 3; ++dj) {
                        asm volatile("" ::: "memory");
                        const LAS u32x4* wp = (const LAS u32x4*)(wl + (di * 3 + dj) * 256 + 8 * o);
                        const u32x4 wg0 = wp[0], wg1 = wp[1], wv0 = wp[32], wv1 = wp[33];
#pragma unroll
                        for (int rr = 0; rr < 2; ++rr) {
                            const u32x4 zg = win[(2 * q + rr + di) % 6][dj][0], zv = win[(2 * q + rr + di) % 6][dj][1];
                            ag[rr][0] = dot2bf(zg.x, wg0.x, ag[rr][0]); ag[rr][1] = dot2bf(zg.x, wg0.y, ag[rr][1]); ag[rr][2] = dot2bf(zg.y, wg0.z, ag[rr][2]); ag[rr][3] = dot2bf(zg.y, wg0.w, ag[rr][3]);
                            ag[rr][4] = dot2bf(zg.z, wg1.x, ag[rr][4]); ag[rr][5] = dot2bf(zg.z, wg1.y, ag[rr][5]); ag[rr][6] = dot2bf(zg.w, wg1.z, ag[rr][6]); ag[rr][7] = dot2bf(zg.w, wg1.w, ag[rr][7]);
                            av[rr][0] = dot2bf(zv.x, wv0.x, av[rr][0]); av[rr][1] = dot2bf(zv.x, wv0.y, av[rr][1]); av[rr][2] = dot2bf(zv.y, wv0.z, av[rr][2]); av[rr][3] = dot2bf(zv.y, wv0.w, av[rr][3]);
                            av[rr][4] = dot2bf(zv.z, wv1.x, av[rr][4]); av[rr][5] = dot2bf(zv.z, wv1.y, av[rr][5]); av[rr][6] = dot2bf(zv.w, wv1.z, av[rr][6]); av[rr][7] = dot2bf(zv.w, wv1.w, av[rr][7]);
                        }
                    }
#pragma unroll
                for (int rr = 0; rr < 2; ++rr) {
                    u32x4 w;
                    w.x = pk2(silu_f(ag[rr][0]) * av[rr][0], silu_f(ag[rr][1]) * av[rr][1]); w.y = pk2(silu_f(ag[rr][2]) * av[rr][2], silu_f(ag[rr][3]) * av[rr][3]);
                    w.z = pk2(silu_f(ag[rr][4]) * av[rr][4], silu_f(ag[rr][5]) * av[rr][5]); w.w = pk2(silu_f(ag[rr][6]) * av[rr][6], silu_f(ag[rr][7]) * av[rr][7]);
                    *(u32x4*)(A3 + ((size_t)b * SEQ + (row + rr) * 64 + c) * FF + chg) = w; }
        }
    }
}

constexpr int SP_PITCH = 136;
constexpr int SP_WS_OFF = 0, SP_VT_OFF = 128 * SP_PITCH * 2  , SP_O_OFF = SP_VT_OFF  , SP_OPITCH = 264;
__device__ __forceinline__ void spatial_phase(CArgsP a, LAS unsigned char* lds, int first, int stride) {
    const int t = tid_opaque(), lane = t & 63, wid = t >> 6;
    const bf16_t* ZS = (const bf16_t*)(a->ws + WS_ZS); bf16_t* GT = (bf16_t*)(a->ws + WS_GT);
    const float* st = (const float*)(a->ws + WS_LNST);
    const float* lng = a->in[25]; const float* lnb = a->in[26]; const float* wsp = a->in[27]; const float* bsp = a->in[28];
    LAS bf16_t* Ws = (LAS bf16_t*)(lds + SP_WS_OFF); LAS bf16_t* Vt = (LAS bf16_t*)(lds + SP_VT_OFF); LAS bf16_t* Ot = (LAS bf16_t*)(lds + SP_O_OFF);
    int g_loaded = -1;
    u32x4 va[4], vb[4]; f32x4 st4[4];
    auto load_v = [&](int item) {
        const int g = item & 15, cn = item >> 4; const size_t tok0 = (size_t)cn * 128;
#pragma unroll
        for (int it = 0; it < 4; ++it) { const int i = t + it * NTHREADS; const int oc = i & 3, kp = (i >> 2) & 63, og = i >> 8, c0 = (og * 4 + oc) * 8;
            const size_t ra = tok0 + 2 * kp;
            va[it] = __builtin_nontemporal_load((const u32x4*)(ZS + ra * SD2 + SD + g * 256 + c0)); vb[it] = __builtin_nontemporal_load((const u32x4*)(ZS + (ra + 1) * SD2 + SD + g * 256 + c0));
            st4[it] = *(const f32x4*)(st + 2 * ra); }
    };
    if (first < 1024) load_v(first);
    for (int item = first; item < 1024; item += stride) {
        const int g = item & 15, cn = item >> 4;
        const size_t tok0 = (size_t)cn * 128;
        __syncthreads();
        if (g != g_loaded) { g_loaded = g;
        for (int i = t; i < 128 * 32; i += NTHREADS) { const int q = i >> 5, k4 = i & 31; const f32x4 w = *(const f32x4*)(wsp + ((size_t)g * 128 + q) * 128 + 4 * k4);
            u32x2 pw; pw.x = pk2(w.x, w.y); pw.y = pk2(w.z, w.w); *(LAS u32x2*)(Ws + q * SP_PITCH + 4 * k4) = pw; } }
#pragma unroll
        for (int it = 0; it < 4; ++it) {
            const int i = t + it * NTHREADS; const int oc = i & 3, kp = (i >> 2) & 63, og = i >> 8, c0 = (og * 4 + oc) * 8;
            const float mua = st4[it].x * (1.f / SD), mub = st4[it].z * (1.f / SD);
            const float rsa = __builtin_amdgcn_rsqf(st4[it].y * (1.f / SD) - mua * mua + 1e-5f), rsb = __builtin_amdgcn_rsqf(st4[it].w * (1.f / SD) - mub * mub + 1e-5f);
            const f32x4 g0 = *(const f32x4*)(lng + g * 256 + c0), g1 = *(const f32x4*)(lng + g * 256 + c0 + 4), b0 = *(const f32x4*)(lnb + g * 256 + c0), b1 = *(const f32x4*)(lnb + g * 256 + c0 + 4);
            const unsigned wa[4] = {va[it].x, va[it].y, va[it].z, va[it].w}, wb[4] = {vb[it].x, vb[it].y, vb[it].z, vb[it].w};
#pragma unroll
            for (int j = 0; j < 4; ++j) {
                const float gl = j < 2 ? g0[2 * j] : g1[2 * j - 4], gh = j < 2 ? g0[2 * j + 1] : g1[2 * j - 3];
                const float bl = j < 2 ? b0[2 * j] : b1[2 * j - 4], bh = j < 2 ? b0[2 * j + 1] : b1[2 * j - 3];
                const float al = (bf_lo(wa[j]) - mua) * rsa * gl + bl, ah = (bf_hi(wa[j]) - mua) * rsa * gh + bh;
                const float bl2 = (bf_lo(wb[j]) - mub) * rsb * gl + bl, bh2 = (bf_hi(wb[j]) - mub) * rsb * gh + bh;
                const int kphys = (((kp >> 2) ^ oc) << 3) + 2 * (kp & 3);
                *(LAS unsigned*)(Vt + (c0 + 2 * j) * SP_PITCH + kphys) = pk2(al, bl2);
                *(LAS unsigned*)(Vt + (c0 + 2 * j + 1) * SP_PITCH + kphys) = pk2(ah, bh2);
            }
        }
        __syncthreads();
        if (item + stride < 1024) load_v(item + stride);
        u32x4 uvr[8];
#pragma unroll
        for (int it = 0; it < 8; ++it) { const int i = t + it * NTHREADS; const int q = i >> 5, oct = i & 31; uvr[it] = __builtin_nontemporal_load((const u32x4*)(ZS + (tok0 + q) * SD2 + g * 256 + 8 * oct)); }
        const int r = lane & 31, hh = lane >> 5;
        f32x16 acc[4];
#pragma unroll
        for (int mt = 0; mt < 4; ++mt)
#pragma unroll
            for (int i = 0; i < 16; ++i) acc[mt][i] = 0.f;
#pragma unroll
        for (int ks = 0; ks < 8; ++ks) {
            const bf16x8 bfr = *(const LAS bf16x8*)(Vt + (32 * wid + r) * SP_PITCH + 8 * ((2 * ks + hh) ^ ((r >> 3) & 3)));
#pragma unroll
            for (int mt = 0; mt < 4; ++mt) { const bf16x8 afr = *(const LAS bf16x8*)(Ws + (32 * mt + r) * SP_PITCH + 16 * ks + 8 * hh); acc[mt] = MFMA32(afr, bfr, acc[mt]); }
        }
        __syncthreads();
#pragma unroll
        for (int mt = 0; mt < 4; ++mt)
#pragma unroll
            for (int i = 0; i < 16; ++i) { const int q = 32 * mt + (i & 3) + 8 * (i >> 2) + 4 * hh; Ot[q * SP_OPITCH + 32 * wid + r] = f2bf(acc[mt][i] + bsp[g * 128 + q]); }
        __syncthreads();
#pragma unroll
        for (int it = 0; it < 8; ++it) { const int i = t + it * NTHREADS; const int q = i >> 5, oct = i & 31;
            const u32x4 uv = uvr[it];
            const u32x4 sv = *(const LAS u32x4*)(Ot + q * SP_OPITCH + 8 * oct);
            u32x4 w;
            w.x = pk2(bf_lo(uv.x) * bf_lo(sv.x), bf_hi(uv.x) * bf_hi(sv.x)); w.y = pk2(bf_lo(uv.y) * bf_lo(sv.y), bf_hi(uv.y) * bf_hi(sv.y));
            w.z = pk2(bf_lo(uv.z) * bf_lo(sv.z), bf_hi(uv.z) * bf_hi(sv.z)); w.w = pk2(bf_lo(uv.w) * bf_lo(sv.w), bf_hi(uv.w) * bf_hi(sv.w));
            *(u32x4*)(GT + (tok0 + q) * SD + g * 256 + 8 * oct) = w; }
    }
}

#define XB_TMO      128
#define XB_XCNT(j)  (256  + 64 * (j))
#define XB_XSUB(j)  (1280 + 64 * (j))
#define XB_XGEN(j)  (2304 + 64 * (j))
#define XB_TOP      3328
#define XB_TOPGEN   3392
#define XCD_BAR_WORDS 3456
#define XB_SPIN_CAP (1u << 22)
__device__ __forceinline__ unsigned xb_ld(unsigned* p)              { return __hip_atomic_load(p, __ATOMIC_RELAXED, __HIP_MEMORY_SCOPE_AGENT); }
__device__ __forceinline__ unsigned xb_add(unsigned* p, unsigned v) { return __hip_atomic_fetch_add(p, v, __ATOMIC_RELAXED, __HIP_MEMORY_SCOPE_AGENT); }
__device__ __forceinline__ unsigned xb_xcc_id() { return (unsigned)__builtin_amdgcn_s_getreg((3 << 11) | 20) & 0xFu; }
#define XB_SPIN(cond, bar) do { unsigned _sp = 0; while (cond) { __builtin_amdgcn_s_sleep(1); \
    if ((++_sp & 255u) == 0u) { if (xb_ld(&(bar)[XB_TMO])) break; if (_sp > XB_SPIN_CAP) { atomicAdd(&(bar)[XB_TMO], 1u); break; } } } } while (0)
struct XcdBarrier { unsigned* bar; unsigned x; volatile LAS unsigned* st; };
__device__ __forceinline__ XcdBarrier xcd_barrier_post(unsigned* bar, volatile LAS unsigned* st) {
    XcdBarrier b; b.bar = bar; b.x = xb_xcc_id(); b.st = st;
    if (threadIdx.x == 0) (void)xb_add(&bar[XB_XCNT(b.x)], 1u);
    return b;
}
__device__ __forceinline__ void xcd_barrier_complete(unsigned* bar, unsigned x, unsigned& nloc, unsigned& nx) {
    const unsigned G = gridDim.x * gridDim.y * gridDim.z;
    unsigned sum, cnt, mine, sp = 0u;
    for (;;) {
        sum = 0u; cnt = 0u; mine = 0u;
#pragma unroll
        for (unsigned j = 0; j < 16; ++j) { const unsigned c = xb_ld(&bar[XB_XCNT(j)]); sum += c; cnt += (c > 0u) ? 1u : 0u; mine = (j == x) ? c : mine; }
        if (sum == G) break;
        __builtin_amdgcn_s_sleep(1);
        if ((++sp & 255u) == 0u) { if (xb_ld(&bar[XB_TMO])) break; if (sp > XB_SPIN_CAP) { atomicAdd(&bar[XB_TMO], 1u); break; } }
    }
    nloc = mine > 0u ? mine : 1u; nx = cnt > 0u ? cnt : 1u;
}
__device__ __forceinline__ void xcd_barrier(const XcdBarrier& b) {
    asm volatile("s_waitcnt vmcnt(0)" ::: "memory");
    __syncthreads();
    if (threadIdx.x == 0) {
        unsigned* bar = b.bar;
        __builtin_amdgcn_s_waitcnt(0);
        unsigned nloc = b.st[0], nx = b.st[1];
        if (nloc == 0u) { xcd_barrier_complete(bar, b.x, nloc, nx); b.st[0] = nloc; b.st[1] = nx; }
        const unsigned old = xb_add(&bar[XB_XSUB(b.x)], 1u);
        const unsigned gen = old / nloc;
        if (old + 1u == (gen + 1u) * nloc) {
            __builtin_amdgcn_fence(__ATOMIC_RELEASE, "agent");
            asm volatile("s_waitcnt vmcnt(0)" ::: "memory");
            const unsigned og = xb_add(&bar[XB_TOP], 1u);
            const unsigned tg = og / nx;
            if (og + 1u == (tg + 1u) * nx) xb_add(&bar[XB_TOPGEN], 1u);
            else XB_SPIN(xb_ld(&bar[XB_TOPGEN]) == tg, bar);
            __builtin_amdgcn_fence(__ATOMIC_ACQUIRE, "agent");
            xb_add(&bar[XB_XGEN(b.x)], 1u);
            asm volatile("s_waitcnt vmcnt(0)" ::: "memory");
        } else {
            XB_SPIN(xb_ld(&bar[XB_XGEN(b.x)]) == gen, bar);
            __builtin_amdgcn_fence(__ATOMIC_ACQUIRE, "agent");
            asm volatile("s_waitcnt vmcnt(0)" ::: "memory");
        }
    }
    __syncthreads();
}

__global__ void __launch_bounds__(NTHREADS, 2) fwd_kernel(Args a_unused) {
    extern __shared__ __attribute__((aligned(16))) unsigned char lds_raw[];
    LAS unsigned char* lds = (LAS unsigned char*)lds_raw;
    cg::grid_group grid = cg::this_grid();
        int lo, hi; { CArgsP a0 = get_args(); lo = a0->ph_lo; hi = a0->ph_hi; }
    int ph = 0;
    const unsigned long long t_entry = PROBE_MASK ? __builtin_amdgcn_s_memrealtime() : 0ull;
    if (PROBE_MASK && blockIdx.x == 0 && threadIdx.x == 0) { CArgsP a0 = get_args(); *(volatile unsigned long long*)(a0->ws + WS_PROBE) = 0ull; }
    if (threadIdx.x < 2) ((volatile LAS unsigned*)(lds + LDS_BARST))[threadIdx.x] = 0u;
    __syncthreads();
    XcdBarrier xbar; xbar.bar = nullptr; xbar.x = 0; xbar.st = (volatile LAS unsigned*)(lds + LDS_BARST);
    bool xb_ready = false;
#define GRID_SYNC() do { if (!xb_ready) { grid.sync(); CArgsP _a = get_args(); xbar = xcd_barrier_post((unsigned*)(_a->ws + WS_BAR), (volatile LAS unsigned*)(lds + LDS_BARST)); xb_ready = true; } else { xcd_barrier(xbar); } } while (0)
#ifndef ONLY_KIND
#define ONLY_KIND -1
#endif
#define PHASE_BEGIN(kind) if ((ONLY_KIND < 0 || ONLY_KIND == (kind)) && ph >= lo && ph < hi) { CArgsP a = get_args(); unsigned char* ws = a->ws; float* modbuf = (float*)(ws + WS_MOD); (void)modbuf; const int t = tid_opaque(), lane = t & 63, wave = __builtin_amdgcn_readfirstlane(t >> 6); const int G = gridDim.x, bx = blockIdx.x; const int gw = bx * NWAVES + wave, NGW = G * NWAVES; (void)lane; (void)gw; (void)NGW; \
    unsigned long long _pt0 = 0; const bool _pon = PROBE_MASK && ((PROBE_MASK >> (kind)) & 1u) && bx == 0 && t == 0; if (_pon) _pt0 = __builtin_amdgcn_s_memrealtime();
#define PHASE_END   if (ph + 1 < hi) { GRID_SYNC(); } if (_pon) { *(volatile unsigned long long*)(ws + WS_PROBE) += __builtin_amdgcn_s_memrealtime() - _pt0; } } ++ph;

    PHASE_BEGIN(0)
        for (int i = bx * NTHREADS + t; i < M * 2; i += G * NTHREADS) ((float*)(ws + WS_LNST))[i] = 0.f;
        for (int i = bx * NTHREADS + t; i < 6 * F2; i += G * NTHREADS) ((float*)(ws + WS_BIAS))[i] = 0.f;
        for (int i = bx * NTHREADS + t; i < 4 * M; i += G * NTHREADS) ((float*)(ws + WS_ROWSS))[i] = 0.f;
        if (bx == 0) for (int i = t; i < XCD_BAR_WORDS; i += NTHREADS) ((unsigned*)(ws + WS_BAR))[i] = 0u;
        for (int tk = bx; tk < 768; tk += G) p0_gemv_task(a, lds, tk);
    PHASE_END
    PHASE_BEGIN(1)
        for (int i = bx * NTHREADS + t; i < 3 * NB * D; i += G * NTHREADS) { const int site = i / (NB * D), b = (i / D) % NB, k = i % D;
            const float gg = site == 0 ? a->in[5][k] : site == 1 ? a->in[4][D + k] : a->in[5][D + k];
            const float sc = site == 0 ? modbuf[b * D6 + 4 * D + k] : site == 1 ? modbuf[(3 + b) * D6 + D + k] : modbuf[(3 + b) * D6 + 4 * D + k];
            ((float*)(ws + WS_GP))[i] = gg * (1.f + sc); }
        for (int m0 = gw; m0 < MU; m0 += 4 * NGW) {
            const float* src[4]; const float* sh[4]; void* dst[4]; bool valid[4];
#pragma unroll
            for (int k = 0; k < 4; ++k) { const int mm = m0 + k * NGW; valid[k] = mm < MU; const int m = valid[k] ? mm : MU - 1; const int b = m / LT, j = m % LT;
                src[k] = j < CTXL ? a->in[2] + ((size_t)b * CTXL + j) * D : a->in[0] + ((size_t)b * SEQ + (j - CTXL)) * D;
                sh[k] = modbuf + (j < CTXL ? 2 : b) * D6; dst[k] = (bf16_t*)(ws + WS_A0) + (size_t)m * D; }
            norm_rows<false, 4>(src, a->in[4], sh, dst, valid, lane); }
        __syncthreads();
        p0_transpose_all<1>(a, lds, bx, G, TRC_END - 512);
    PHASE_END
    PHASE_BEGIN(2)
        pg8::Gemm g{(const bf16_t*)(ws + WS_A0), (const bf16_t*)(ws + WS_WIN), MU, D, D, D}; pg8::StaticOrder S; S.init(MU, D, G, bx);
        pg8::EpiF32 E{nullptr, D, (bf16_t*)(ws + WS_UB)};
        pg8::gemm_phase<pg8::EpiF32, true, true>(lds, g, S, E);
        if (bx >= 16) { __syncthreads(); p0_transpose_all<0>(a, lds, TRC_UP1_B + (bx - 16), G - 16, TRC_UP1_E);
            for (int idx = (bx - 16) * NTHREADS + t; idx < 2 * NG * NP; idx += (G - 16) * NTHREADS) p0_s5_tables(a, idx);
            for (int w = (bx - 16) * NTHREADS + t; w < 2 * NG * NP * 4; w += (G - 16) * NTHREADS) p0_s5_kend(a, w >> 2, w & 3); }
    PHASE_END
    PHASE_BEGIN(3)
        s5_passA(a, gw, NGW, lane);
    PHASE_END
    PHASE_BEGIN(4)
        if (t < 128) {
            const f32x2* lamT = (const f32x2*)(ws + WS_LAMT);
            for (int idx = bx * 128 + t; idx < 2 * NG * 2 * NP; idx += G * 128) {
                const int p = idx & 63, b = (idx >> 6) & 1, gd = idx >> 7;
                const f32x2 lt = lamT[gd * 64 + p]; float sr = 0.f, si = 0.f;
                const f32x2* e = (const f32x2*)((const float*)(ws + WS_E) + ((size_t)gd * NCOL + b * 128) * 128) + p;
                f32x2* so = (f32x2*)((float*)(ws + WS_SI) + ((size_t)gd * NCOL + b * 128) * 128) + p;
#pragma unroll 8
                for (int c = 0; c < 128; ++c) { so[c * 64] = (f32x2){sr, si}; const f32x2 ev = e[c * 64];
                    const float nr = lt.x * sr - lt.y * si + ev.x, ni = lt.x * si + lt.y * sr + ev.y; sr = nr; si = ni; }
            }
        }
    PHASE_END
    PHASE_BEGIN(5)
        s5_pass<true>(a, lds, gw, NGW, lane);
    PHASE_END
    PHASE_BEGIN(6)
        const bf16_t* UBp = (const bf16_t*)(ws + WS_UB); const u32x4* YF = (const u32x4*)(ws + WS_YF); const u32x4* YR = (const u32x4*)(ws + WS_YR);
        const float* dsk = a->in[20]; u32x4* Gm = (u32x4*)(ws + WS_G);
        for (int i = bx * NTHREADS + t; i < M * (D / 8); i += G * NTHREADS) {
            const int m = i >> 8, c8 = i & 255, b = m >> 12, tt = m & 4095;
            const u32x4 u = __builtin_nontemporal_load((const u32x4*)(UBp + ((size_t)b * LT + CTXL + tt) * D + 8 * c8));
            const u32x4 yf = __builtin_nontemporal_load(YF + i), yr = __builtin_nontemporal_load(YR + i); const f32x4 d0 = ((const f32x4*)dsk)[2 * c8], d1 = ((const f32x4*)dsk)[2 * c8 + 1];
            u32x4 w;
            w.x = pk2(gelu_tanh_f(d0.x * bf_lo(u.x) + bf_lo(yf.x) + bf_lo(yr.x)), gelu_tanh_f(d0.y * bf_hi(u.x) + bf_hi(yf.x) + bf_hi(yr.x)));
            w.y = pk2(gelu_tanh_f(d0.z * bf_lo(u.y) + bf_lo(yf.y) + bf_lo(yr.y)), gelu_tanh_f(d0.w * bf_hi(u.y) + bf_hi(yf.y) + bf_hi(yr.y)));
            w.z = pk2(gelu_tanh_f(d1.x * bf_lo(u.z) + bf_lo(yf.z) + bf_lo(yr.z)), gelu_tanh_f(d1.y * bf_hi(u.z) + bf_hi(yf.z) + bf_hi(yr.z)));
            w.w = pk2(gelu_tanh_f(d1.z * bf_lo(u.w) + bf_lo(yf.w) + bf_lo(yr.w)), gelu_tanh_f(d1.w * bf_hi(u.w) + bf_hi(yf.w) + bf_hi(yr.w)));
            Gm[i] = w; }
    PHASE_END
    PHASE_BEGIN(7)
        pg8::Gemm g{(const bf16_t*)(ws + WS_G), (const bf16_t*)(ws + WS_WGLU), M, D, D, D}; pg8::StaticOrder S; S.init(M, D, G, bx);
        pg8::EpiGlu E{(const bf16_t*)(ws + WS_G), (bf16_t*)(ws + WS_A2), a->in[22]};
        pg8::gemm_phase<pg8::EpiGlu, true, true>(lds, g, S, E);
    PHASE_END
    PHASE_BEGIN(8)
        pg8::Gemm g{(const bf16_t*)(ws + WS_A2), (const bf16_t*)(ws + WS_WOUT), M, D, D, D}; pg8::StaticOrder S; S.init(M, D, G, bx);
        pg8::EpiResidNorm E{a->in[0], (float*)(ws + WS_X), modbuf + 2 * D, (const float*)(ws + WS_GP), (bf16_t*)(ws + WS_A0), (float*)(ws + WS_ROWSS)};
        pg8::gemm_phase<pg8::EpiResidNorm, true, true>(lds, g, S, E);
    PHASE_END
#pragma unroll
    for (int layer = 0; layer < 2; ++layer) {
        if (layer == 1) {
            PHASE_BEGIN(10)
                pg8::Gemm g{(const bf16_t*)(ws + WS_A0), (const bf16_t*)(ws + WS_SIN_W), M, SD2, D, D}; pg8::StaticOrder S; S.init(M, SD2, G, bx);
                pg8::EpiBf16<1> E{(bf16_t*)(ws + WS_ZS), SD2, (float*)(ws + WS_LNST), 16, (const float*)(ws + WS_ROWSS) + M, (const float*)(ws + WS_BIAS) + 2 * F2};
                pg8::gemm_phase<pg8::EpiBf16<1>, true, true>(lds, g, S, E);
            PHASE_END
            PHASE_BEGIN(11)
                spatial_phase(a, lds, bx, G);
            PHASE_END
            PHASE_BEGIN(12)
                pg8::Gemm g{(const bf16_t*)(ws + WS_GT), (const bf16_t*)(ws + WS_SOUT_W), M, D, SD, SD}; pg8::StaticOrder S; S.init(M, D, G, bx);
                pg8::EpiResidNorm E{(const float*)(ws + WS_X), (float*)(ws + WS_X), modbuf + 3 * D6 + 2 * D, (const float*)(ws + WS_GP) + 2 * NB * D, (bf16_t*)(ws + WS_A0), (float*)(ws + WS_ROWSS) + 2 * M};
                pg8::gemm_phase<pg8::EpiResidNorm, true, true>(lds, g, S, E);
            PHASE_END
        }
        PHASE_BEGIN(14)
            pg8::Gemm g{(const bf16_t*)(ws + WS_A0), (const bf16_t*)(ws + (layer ? WS_UP1 : WS_UP0)), M, F2, D, D}; pg8::StaticOrder S; S.init(M, F2, G, bx);
            pg8::EpiBf16<0> E{(bf16_t*)(ws + WS_Z), F2, nullptr, 1 << 30, (const float*)(ws + WS_ROWSS) + (layer ? 2 * M : 0), (const float*)(ws + WS_BIAS) + (layer ? 4 * F2 : 0)};
            pg8::gemm_phase<pg8::EpiBf16<0>, true, true>(lds, g, S, E);
            if (bx >= 128) { __syncthreads();
                if (layer == 0) p0_transpose_all<0>(a, lds, TRC_END - 512 + (bx - 128), G - 128, TRC_END); else p0_transpose_all<0>(a, lds, TRC_DN1_B + (bx - 128), G - 128, TRC_DN1_E); }
        PHASE_END
        PHASE_BEGIN(15)
            conv_phase(a, lds, layer, bx, G);
        PHASE_END
        PHASE_BEGIN(16)
            pg8::Gemm g{(const bf16_t*)(ws + WS_A3), (const bf16_t*)(ws + (layer ? WS_DN1 : WS_DN0)), M, D, FF, FF}; pg8::StaticOrder S; S.init(M, D, G, bx);
            if (layer == 0) { pg8::EpiResidNorm E{(const float*)(ws + WS_X), (float*)(ws + WS_X), modbuf + 5 * D, (const float*)(ws + WS_GP) + NB * D, (bf16_t*)(ws + WS_A0), (float*)(ws + WS_ROWSS) + M};
                pg8::gemm_phase<pg8::EpiResidNorm, true, true>(lds, g, S, E); }
            else { pg8::EpiResid E{(const float*)(ws + WS_X), (float*)(ws + WS_X), modbuf + 3 * D6 + 5 * D, (float*)(ws + WS_ROWSS) + 3 * M};
                pg8::gemm_phase<pg8::EpiResid, true, true>(lds, g, S, E); }
        PHASE_END
    }
    PHASE_BEGIN(17)
        { const f32x4* xp = (const f32x4*)(ws + WS_X); const float* rs = (const float*)(ws + WS_ROWSS) + 3 * M; const f32x4* gp = (const f32x4*)a->in[30]; f32x4* op = (f32x4*)a->out;
#pragma unroll 8
          for (int i = bx * NTHREADS + t; i < M * (D / 4); i += G * NTHREADS) { const float rstd = __builtin_amdgcn_rsqf(rs[i >> 9] * (1.f / D) + 1e-6f); op[i] = __builtin_nontemporal_load(xp + i) * rstd * gp[i & 511]; } }
        if (PROBE_MASK) { GRID_SYNC(); }
    PHASE_END
    if (PROBE_MASK) {
        CArgsP a = get_args(); unsigned char* ws = a->ws; const int t = tid_opaque(), bx = blockIdx.x, G = gridDim.x;
        if ((PROBE_MASK >> 20) & 1u) {
            unsigned long long t0 = 0; if (bx == 0 && t == 0) t0 = __builtin_amdgcn_s_memrealtime();
            f32x4 acc4 = {0.f, 0.f, 0.f, 0.f}; const f32x4* xp = (const f32x4*)(ws + WS_X);
#pragma unroll 8
            for (int i = bx * NTHREADS + t; i < M * (D / 4); i += G * NTHREADS) acc4 += xp[i];
            ((float*)(ws + WS_PROBE + 65536))[bx * NTHREADS + t] = acc4.x + acc4.y + acc4.z + acc4.w;
            GRID_SYNC();
            if (bx == 0 && t == 0) *(volatile unsigned long long*)(ws + WS_PROBE) += __builtin_amdgcn_s_memrealtime() - t0;
        }
        if ((PROBE_MASK >> 21) & 1u) {
            unsigned long long t0 = 0; if (bx == 0 && t == 0) t0 = __builtin_amdgcn_s_memrealtime();
            f32x4* zp = (f32x4*)(ws + WS_ZS); const f32x4 v = {1.f, 2.f, 3.f, (float)t};
#pragma unroll 8
            for (int i = bx * NTHREADS + t; i < M * (D / 4); i += G * NTHREADS) zp[i] = v;
            GRID_SYNC();
            if (bx == 0 && t == 0) *(volatile unsigned long long*)(ws + WS_PROBE) += __builtin_amdgcn_s_memrealtime() - t0;
        }
        if ((PROBE_MASK >> 22) & 1u) {
            unsigned long long t0 = 0; if (bx == 0 && t == 0) t0 = __builtin_amdgcn_s_memrealtime();
            f32x4* zp = (f32x4*)(ws + WS_ZS); const f32x4* xp = (const f32x4*)(ws + WS_X);
#pragma unroll 8
            for (int i = bx * NTHREADS + t; i < M * (D / 4); i += G * NTHREADS) zp[i] = xp[i];
            GRID_SYNC();
            if (bx == 0 && t == 0) *(volatile unsigned long long*)(ws + WS_PROBE) += __builtin_amdgcn_s_memrealtime() - t0;
        }
        if ((PROBE_MASK >> 19) & 1u) {
            unsigned long long t0 = 0; if (bx == 0 && t == 0) t0 = __builtin_amdgcn_s_memrealtime();
            for (int i = 0; i < 10; ++i) { GRID_SYNC(); }
            if (bx == 0 && t == 0) *(volatile unsigned long long*)(ws + WS_PROBE) += __builtin_amdgcn_s_memrealtime() - t0;
        }
        if ((PROBE_MASK >> 18) & 1u) { if (bx == 0 && t == 0) *(volatile unsigned long long*)(ws + WS_PROBE) += __builtin_amdgcn_s_memrealtime() - t_entry; }
        grid.sync();
        const unsigned long long tk = *(volatile unsigned long long*)(ws + WS_PROBE); const float pd = sqrtf((float)tk * 1e-10f);
        for (int i = bx * NTHREADS + t; i < M * (D / 4); i += G * NTHREADS) { f32x4 y = ((f32x4*)a->out)[i]; y.x += pd; y.y -= pd; y.z += pd; y.w -= pd; ((f32x4*)a->out)[i] = y; }
    }
}
constexpr int N_PHASES = 19;

extern "C" void kernel_launch(void* const* d_in, const int* in_sizes, int n_in, void* d_out, int out_size, void* d_ws, size_t ws_size, hipStream_t stream) {
    static int grid = 0;
    if (grid == 0) {
        if (n_in != 31 || out_size != M * D || ws_size < WS_END) { fprintf(stderr, "kernel_launch: unexpected shapes (n_in %d out %d ws %zu need %zu)\n", n_in, out_size, ws_size, (size_t)WS_END); grid = -1; return; }
        int dev = 0, cus = 0, per_cu = 0;
        hipGetDevice(&dev); hipDeviceGetAttribute(&cus, hipDeviceAttributeMultiprocessorCount, dev);
        if (hipFuncSetAttribute((const void*)fwd_kernel, hipFuncAttributeMaxDynamicSharedMemorySize, LDS_BYTES) != hipSuccess) { fprintf(stderr, "kernel_launch: hipFuncSetAttribute failed\n"); grid = -1; return; }
        if (hipOccupancyMaxActiveBlocksPerMultiprocessor(&per_cu, (const void*)fwd_kernel, NTHREADS, LDS_BYTES) != hipSuccess || per_cu < 1) { fprintf(stderr, "kernel_launch: occupancy query gave %d\n", per_cu); per_cu = 1; }
        (void)hipGetLastError();
        grid = cus * 1;
    }
    if (grid < 0) return;
    Args a{};
    for (int i = 0; i < 31; ++i) a.in[i] = (const float*)d_in[i];
    a.out = (float*)d_out; a.ws = (unsigned char*)d_ws; a.ph_lo = 0; a.ph_hi = N_PHASES;
    void* args[] = {&a};
    hipError_t e = hipLaunchCooperativeKernel((const void*)fwd_kernel, dim3(grid), dim3(NTHREADS), args, LDS_BYTES, stream);
    if (e != hipSuccess) fprintf(stderr, "kernel_launch: cooperative launch failed: %s (grid %d)\n", hipGetErrorString(e), grid);
}
```

```cpp
#include <hip/hip_runtime.h>
#include <hip/hip_cooperative_groups.h>
#include <cstdio>
#include <cstdint>
namespace cg = cooperative_groups;

#ifndef PROBE_MASK
#define PROBE_MASK 0u
#endif
#define LAS __attribute__((address_space(3)))
typedef unsigned short bf16_t;
typedef short bf16x8 __attribute__((ext_vector_type(8)));
typedef float f32x2 __attribute__((ext_vector_type(2)));
typedef float f32x4 __attribute__((ext_vector_type(4)));
typedef float f32x16 __attribute__((ext_vector_type(16)));
typedef unsigned u32x2 __attribute__((ext_vector_type(2)));
typedef unsigned u32x4 __attribute__((ext_vector_type(4)));
typedef __bf16 bf16x2v __attribute__((ext_vector_type(2)));

constexpr int D = 2048, NB = 2, SEQ = 4096, CTXL = 256, M = NB * SEQ, LT = SEQ + CTXL, MU = NB * LT;
constexpr int NG = 128, NP = 64, NH = 16, TC = 34, NCOL = 256;
constexpr int F2 = 11264, FF = 5632, SD = 4096, SD2 = 8192, D6 = 12288;
constexpr int NTHREADS = 512, NWAVES = 8;
constexpr int LDS_BYTES = 147456;

constexpr size_t MiB = 1u << 20;
constexpr size_t WS_MOD = 0;
constexpr size_t WS_LAM = 512 * 1024;
constexpr size_t WS_LAMT = 768 * 1024;
constexpr size_t WS_BCAT = 1 * MiB;
constexpr size_t WS_CCAT = 2 * MiB;
constexpr size_t WS_LNST = 3 * MiB;
constexpr size_t WS_PROBE = 4 * MiB;
constexpr size_t WS_BIAS = 6 * MiB;
constexpr size_t WS_ROWSS = 7 * MiB;
constexpr size_t WS_GP = 7 * MiB + 512 * 1024;
constexpr size_t WS_BAR = 5 * MiB;
constexpr int LDS_BARST = LDS_BYTES - 64;
constexpr size_t WS_W = 16 * MiB;
constexpr size_t WS_WIN = WS_W, WS_WGLU = WS_WIN + 8 * MiB, WS_WOUT = WS_WGLU + 8 * MiB;
constexpr size_t WS_UP0 = WS_WOUT + 8 * MiB, WS_UP1 = WS_UP0 + 44 * MiB;
constexpr size_t WS_DN0 = WS_UP1 + 44 * MiB, WS_DN1 = WS_DN0 + 22 * MiB;
constexpr size_t WS_SIN_W = WS_DN1 + 22 * MiB, WS_SOUT_W = WS_SIN_W + 32 * MiB;
constexpr size_t WS_X = WS_SOUT_W + 16 * MiB;
constexpr size_t WS_A0 = WS_X + 64 * MiB;
constexpr size_t WS_G = WS_A0 + 34 * MiB;
constexpr size_t WS_A2 = WS_G + 32 * MiB;
constexpr size_t WS_BIG1 = WS_A2 + 32 * MiB;
constexpr size_t WS_U = WS_BIG1;
constexpr size_t WS_YF = WS_BIG1 + 68 * MiB;
constexpr size_t WS_Z = WS_BIG1;
constexpr size_t WS_ZS = WS_BIG1;
constexpr size_t WS_BIG2 = WS_BIG1 + 176 * MiB;
constexpr size_t WS_YR = WS_BIG2;
constexpr size_t WS_E = WS_BIG2 + 64 * MiB;
constexpr size_t WS_SI = WS_BIG2 + 96 * MiB;
constexpr size_t WS_A3 = WS_BIG2;
constexpr size_t WS_GT = WS_BIG2;
constexpr size_t WS_UB = WS_BIG2 + 128 * MiB;
constexpr size_t WS_KEND = WS_UB + 34 * MiB;
constexpr size_t WS_END = WS_KEND + 36 * MiB;

struct Args { const float* in[31]; float* out; unsigned char* ws; int ph_lo, ph_hi; };
typedef const Args __attribute__((address_space(4)))* CArgsP;
__device__ __forceinline__ CArgsP get_args() { CArgsP p = (CArgsP)__builtin_amdgcn_kernarg_segment_ptr(); asm volatile("" : "+s"(p)); return p; }

__device__ __forceinline__ void store16_wt(void* p, f32x4 v) { asm volatile("global_store_dwordx4 %0, %1, off sc1" :: "v"(p), "v"(v) : "memory"); }
__device__ __forceinline__ int launder_i(int v) { asm volatile("" : "+v"(v)); return v; }
__device__ __forceinline__ int tid_opaque() { int t = threadIdx.x; asm volatile("" : "+v"(t)); return t; }
__device__ __forceinline__ unsigned pk2(float lo, float hi) { f32x2 v = {lo, hi}; bf16x2v r = __builtin_convertvector(v, bf16x2v); return __builtin_bit_cast(unsigned, r); }
__device__ __forceinline__ bf16_t f2bf(float f) { return (bf16_t)(pk2(f, 0.f) & 0xffffu); }
__device__ __forceinline__ float bf_lo(unsigned w) { return __builtin_bit_cast(float, w << 16); }
__device__ __forceinline__ float bf_hi(unsigned w) { return __builtin_bit_cast(float, w & 0xffff0000u); }
__device__ __forceinline__ float shfl_xor_l(float v, int m, int lane) { return __builtin_bit_cast(float, __builtin_amdgcn_ds_bpermute((lane ^ m) << 2, __builtin_bit_cast(int, v))); }
__device__ __forceinline__ float wave_sum(float v, int lane) {
#pragma unroll
    for (int o = 1; o < 64; o <<= 1) v += shfl_xor_l(v, o, lane);
    return v;
}
__device__ __forceinline__ float sigmoid_f(float x) { return __builtin_amdgcn_rcpf(1.f + __expf(-x)); }
__device__ __forceinline__ float silu_f(float x) { return x * sigmoid_f(x); }
__device__ __forceinline__ float gelu_tanh_f(float x) { const float t = 1.5957691216f * (x + 0.044715f * x * x * x); return x * sigmoid_f(t); }

namespace pg8 {
constexpr int BM = 256, BK = 64, HALF = 128, HTB = HALF * BK * 2, STAGE_BYTES = 8 * HTB, NXCD = 8, WGM = 8;
__device__ __forceinline__ int lds_byte(int r, int c) { const int st = (r >> 4) * 2 + (c >> 5), rr = r & 15, cc = c & 31, ob = rr * 64 + cc * 2; return st * 1024 + (ob ^ (((ob >> 9) & 1) << 5)); }
__device__ __forceinline__ void stage_rc(int b, int& R, int& C) { const int st = b / 1024, sb = b % 1024, swz = sb ^ (((sb >> 9) & 1) << 5); R = (st >> 1) * 16 + swz / 64; C = (st & 1) * 32 + (swz % 64) / 2; }
__device__ __forceinline__ int perm32(int rho) { const int n = rho >> 4, i = rho & 15; return 8 * (i >> 2) + 4 * n + (i & 3); }
struct Unit { int pm, pn; };
struct Gemm { const bf16_t* A; const bf16_t* Bt; int M, N, K, ld; };
struct StaticOrder {
    int nM, nN, nwg, G, c;
    __device__ void init(int M_, int N_, int G_, int c_) { nM = M_ / BM; nN = N_ / BM; nwg = nM * nN; G = G_; c = c_; }
    __device__ bool next(int i, Unit& u) const {
        const long L = (long)i * G + c; if (L >= nwg) return false;
        int wgid = (int)L; { const int q = nwg / NXCD, r = nwg % NXCD, xcd = wgid % NXCD, off = wgid / NXCD; wgid = (xcd < r ? xcd * (q + 1) : r * (q + 1) + (xcd - r) * q) + off; }
        const int nig = WGM * nN, gid = wgid / nig, fm = gid * WGM, gsz = (nM - fm) < WGM ? (nM - fm) : WGM;
        u.pm = fm + ((wgid % nig) % gsz); u.pn = (wgid % nig) / gsz; return true;
    }
};

template <class Epi, bool ALIGN_EPI, bool SP2>
__device__ __forceinline__ void gemm_phase(LAS unsigned char* lds, const Gemm g, const StaticOrder& S, const Epi& E) {
    const int tid = tid_opaque(), wid = __builtin_amdgcn_readfirstlane(tid >> 6), lane = tid & 63, wr = wid >> 2, wc = wid & 3, fr = lane & 15, fq = lane >> 4;
    const int K = g.ld, nt = g.K / BK;
    unsigned voffA[2], voffB[2];
#pragma unroll
    for (int i = 0; i < 2; ++i) { int R, C; stage_rc(tid * 16 + i * 8192, R, C); const int Rb = Epi::PERM ? ((R & ~31) + perm32(R & 31)) : R;
        voffA[i] = (unsigned)(R * K + C) * 2u; voffB[i] = (unsigned)(Rb * K + C) * 2u; }
    const size_t kstep = (size_t)(BK * 2);
    const size_t hstep = (size_t)HALF * K * 2;
    const size_t tstep = 2 * hstep;
    const unsigned ldsw = (unsigned)wid * 1024u;
    const int aoff = lds_byte(wr * 64 + fr, fq * 8), boff = lds_byte(wc * 32 + fr, fq * 8);
#define PG8_SA(b, h) (((b) * 2 + (h)) * HTB)
#define PG8_SB(b, h) ((4 + (b) * 2 + (h)) * HTB)
#define PG8_STAGE(bufoff, gbase, voff) do { _Pragma("unroll") for (int _i = 0; _i < 2; ++_i) \
        __builtin_amdgcn_global_load_lds((const unsigned*)((const char*)(gbase) + (voff)[_i]), (LAS unsigned*)(lds + (bufoff) + ldsw + _i * 8192), 16, 0, 0); } while (0)
#define PG8_LDA(dst, b, h) do { _Pragma("unroll") for (int m = 0; m < 4; ++m) _Pragma("unroll") for (int k = 0; k < 2; ++k) dst[m][k] = *(const LAS bf16x8*)(lds + PG8_SA(b, h) + aoff + m * 2048 + k * 1024); } while (0)
#define PG8_LDB(dst, b, h) do { _Pragma("unroll") for (int n = 0; n < 2; ++n) _Pragma("unroll") for (int k = 0; k < 2; ++k) dst[n][k] = *(const LAS bf16x8*)(lds + PG8_SB(b, h) + boff + n * 2048 + k * 1024); } while (0)
#define PG8_MMA(ai, bj, At, Bt) do { __builtin_amdgcn_s_setprio(1); _Pragma("unroll") for (int m = 0; m < 4; ++m) _Pragma("unroll") for (int n = 0; n < 2; ++n) _Pragma("unroll") for (int k = 0; k < 2; ++k) \
        acc[ai][bj][m][n] = __builtin_amdgcn_mfma_f32_16x16x32_bf16(Bt[n][k], At[m][k], acc[ai][bj][m][n], 0, 0, 0); __builtin_amdgcn_s_setprio(0); } while (0)
#define PG8_WAIT_V(n) asm volatile("s_waitcnt vmcnt(" #n ")" ::: "memory")
#define PG8_WAIT_L(n) asm volatile("s_waitcnt lgkmcnt(" #n ")" ::: "memory")
#define PG8_BAR __builtin_amdgcn_s_barrier()
#define PG8_SCHED __builtin_amdgcn_sched_barrier(0)
    Unit cur, nxt; int ui = 0;
    if (!S.next(0, cur)) return;
    f32x4 acc[2][2][4][2];
#pragma unroll
    for (int a = 0; a < 2; ++a)
#pragma unroll
        for (int b = 0; b < 2; ++b)
#pragma unroll
            for (int m = 0; m < 4; ++m)
#pragma unroll
                for (int n = 0; n < 2; ++n) acc[a][b][m][n] = (f32x4){0.f, 0.f, 0.f, 0.f};
    bf16x8 At[4][2], B0[2][2], B1[2][2];
    const char* cA = (const char*)g.A + (size_t)cur.pm * tstep; const char* cB = (const char*)g.Bt + (size_t)cur.pn * tstep;
    if constexpr (SP2) {
        PG8_STAGE(PG8_SB(0, 0), cB, voffB); PG8_STAGE(PG8_SB(0, 1), cB + hstep, voffB); PG8_STAGE(PG8_SA(0, 0), cA, voffA); PG8_STAGE(PG8_SA(0, 1), cA + hstep, voffA);
        if (wr == 1) PG8_BAR;
        PG8_WAIT_V(2); PG8_BAR;
        PG8_STAGE(PG8_SB(1, 0), cB + kstep, voffB); PG8_STAGE(PG8_SA(1, 0), cA + kstep, voffA); PG8_STAGE(PG8_SB(1, 1), cB + hstep + kstep, voffB);
        PG8_WAIT_V(6); PG8_BAR;
    } else {
        PG8_STAGE(PG8_SB(0, 0), cB, voffB); PG8_STAGE(PG8_SA(0, 0), cA, voffA); PG8_STAGE(PG8_SB(0, 1), cB + hstep, voffB); PG8_STAGE(PG8_SA(0, 1), cA + hstep, voffA);
        if (wr == 1) PG8_BAR;
        PG8_WAIT_V(4); PG8_BAR;
        PG8_STAGE(PG8_SB(1, 0), cB + kstep, voffB); PG8_STAGE(PG8_SA(1, 0), cA + kstep, voffA); PG8_STAGE(PG8_SB(1, 1), cB + hstep + kstep, voffB);
        PG8_WAIT_V(6); PG8_BAR;
    }
    for (;;) {
        const bool has_next = S.next(ui + 1, nxt);
        const char* nA = has_next ? (const char*)g.A + (size_t)nxt.pm * tstep : cA; const char* nB = has_next ? (const char*)g.Bt + (size_t)nxt.pn * tstep : cB;
        for (int t = 0; t < nt; t += 2) {
            const bool last = (t == nt - 2);
            const char* a1 = cA + (size_t)(t + 1) * kstep;
            const char* a2 = last ? nA : cA + (size_t)(t + 2) * kstep; const char* b2 = last ? nB : cB + (size_t)(t + 2) * kstep;
            const char* a3 = a2 + kstep; const char* b3 = b2 + kstep;
            if constexpr (SP2) {
            PG8_LDB(B0, 0, 0); PG8_LDB(B1, 0, 1); PG8_SCHED; PG8_LDA(At, 0, 0); PG8_STAGE(PG8_SA(1, 1), a1 + hstep, voffA);
            PG8_WAIT_V(8); PG8_WAIT_L(0); PG8_BAR; PG8_MMA(0, 0, At, B0); PG8_MMA(0, 1, At, B1); PG8_BAR; PG8_SCHED;
            PG8_LDA(At, 0, 1); PG8_STAGE(PG8_SB(0, 0), b2, voffB); PG8_STAGE(PG8_SB(0, 1), b2 + hstep, voffB); PG8_STAGE(PG8_SA(0, 0), a2, voffA);
            PG8_WAIT_V(8); PG8_WAIT_L(0); PG8_BAR; PG8_MMA(1, 0, At, B0); PG8_MMA(1, 1, At, B1); PG8_BAR; PG8_SCHED;
            PG8_LDB(B0, 1, 0); PG8_LDB(B1, 1, 1); PG8_SCHED; PG8_LDA(At, 1, 0); PG8_STAGE(PG8_SA(0, 1), a2 + hstep, voffA);
            PG8_WAIT_V(8); PG8_WAIT_L(0); PG8_BAR; PG8_MMA(0, 0, At, B0); PG8_MMA(0, 1, At, B1); PG8_BAR; PG8_SCHED;
            PG8_LDA(At, 1, 1); PG8_STAGE(PG8_SB(1, 0), b3, voffB); PG8_STAGE(PG8_SB(1, 1), b3 + hstep, voffB); PG8_STAGE(PG8_SA(1, 0), a3, voffA);
            PG8_WAIT_V(8); PG8_WAIT_L(0); PG8_BAR; PG8_MMA(1, 0, At, B0); PG8_MMA(1, 1, At, B1); PG8_BAR; PG8_SCHED;
            } else {
            PG8_LDB(B0, 0, 0); PG8_SCHED; PG8_LDA(At, 0, 0); PG8_STAGE(PG8_SA(1, 1), a1 + hstep, voffA);
            PG8_WAIT_L(8); PG8_BAR; PG8_WAIT_L(0); PG8_MMA(0, 0, At, B0); PG8_BAR; PG8_SCHED;
            PG8_LDB(B1, 0, 1); PG8_STAGE(PG8_SB(0, 0), b2, voffB);
            PG8_BAR; PG8_WAIT_L(0); PG8_MMA(0, 1, At, B1); PG8_BAR;
            PG8_LDA(At, 0, 1); PG8_STAGE(PG8_SA(0, 0), a2, voffA);
            PG8_BAR; PG8_WAIT_L(0); PG8_MMA(1, 0, At, B0); PG8_BAR; PG8_SCHED;
            PG8_STAGE(PG8_SB(0, 1), b2 + hstep, voffB);
            PG8_WAIT_V(6); PG8_BAR; PG8_MMA(1, 1, At, B1); PG8_BAR;
            PG8_LDB(B0, 1, 0); PG8_SCHED; PG8_LDA(At, 1, 0); PG8_STAGE(PG8_SA(0, 1), a2 + hstep, voffA);
            PG8_WAIT_L(8); PG8_BAR; PG8_WAIT_L(0); PG8_MMA(0, 0, At, B0); PG8_BAR; PG8_SCHED;
            PG8_LDB(B1, 1, 1); PG8_STAGE(PG8_SB(1, 0), b3, voffB);
            PG8_BAR; PG8_WAIT_L(0); PG8_MMA(0, 1, At, B1); PG8_BAR;
            PG8_LDA(At, 1, 1); PG8_STAGE(PG8_SA(1, 0), a3, voffA);
            PG8_BAR; PG8_WAIT_L(0); PG8_MMA(1, 0, At, B0); PG8_BAR; PG8_SCHED;
            PG8_STAGE(PG8_SB(1, 1), b3 + hstep, voffB);
            PG8_WAIT_V(6); PG8_BAR; PG8_MMA(1, 1, At, B1); PG8_BAR;
            }
        }
        if constexpr (ALIGN_EPI) { if (wr == 0) PG8_BAR; }
        E(acc, cur, wr, wc, fr, fq);
        if (!has_next) break;
#pragma unroll
        for (int a = 0; a < 2; ++a)
#pragma unroll
            for (int b = 0; b < 2; ++b)
#pragma unroll
                for (int m = 0; m < 4; ++m)
#pragma unroll
                    for (int n = 0; n < 2; ++n) acc[a][b][m][n] = (f32x4){0.f, 0.f, 0.f, 0.f};
        cur = nxt; cA = nA; cB = nB; ++ui;
        if constexpr (ALIGN_EPI) { if (wr == 1) PG8_BAR; }
    }
    PG8_WAIT_V(0);
    if constexpr (!ALIGN_EPI) { if (wr == 0) PG8_BAR; }
    PG8_BAR;
#undef PG8_SA
#undef PG8_SB
#undef PG8_STAGE
#undef PG8_LDA
#undef PG8_LDB
#undef PG8_MMA
#undef PG8_WAIT_V
#undef PG8_WAIT_L
#undef PG8_BAR
#undef PG8_SCHED
}

typedef f32x4 AccT[2][2][4][2];
struct EpiF32 {
    static constexpr bool PERM = false;
    float* C; int ldc; bf16_t* Cb;
    __device__ __forceinline__ void operator()(const AccT& acc, const Unit& u, int wr, int wc, int fr, int fq) const {
        const int row0 = u.pm * BM + wr * 64 + fr, col0 = u.pn * BM + wc * 32 + 4 * fq;
#pragma unroll
        for (int ai = 0; ai < 2; ++ai)
#pragma unroll
            for (int m = 0; m < 4; ++m) { float* rowp = C + (size_t)(row0 + ai * HALF + m * 16) * ldc + col0;
#pragma unroll
                for (int bj = 0; bj < 2; ++bj)
#pragma unroll
                    for (int n = 0; n < 2; ++n) { const f32x4 v = acc[ai][bj][m][n]; if (C) *(f32x4*)(rowp + bj * HALF + n * 16) = v;
                        u32x2 w; w.x = pk2(v.x, v.y); w.y = pk2(v.z, v.w); *(u32x2*)(Cb + (size_t)(row0 + ai * HALF + m * 16) * ldc + col0 + bj * HALF + n * 16) = w; } }
    }
};
struct EpiF32Atomic {
    static constexpr bool PERM = false;
    float* C; int ldc;
    __device__ __forceinline__ void operator()(const AccT& acc, const Unit& u, int wr, int wc, int fr, int fq) const {
        const int row0 = u.pm * BM + wr * 64 + fr, col0 = u.pn * BM + wc * 32 + 4 * fq;
#pragma unroll
        for (int ai = 0; ai < 2; ++ai)
#pragma unroll
            for (int m = 0; m < 4; ++m) { float* rowp = C + (size_t)(row0 + ai * HALF + m * 16) * ldc + col0;
#pragma unroll
                for (int bj = 0; bj < 2; ++bj)
#pragma unroll
                    for (int n = 0; n < 2; ++n)
#pragma unroll
                        for (int j = 0; j < 4; ++j) atomicAdd(rowp + bj * HALF + n * 16 + j, acc[ai][bj][m][n][j]); }
    }
};
struct EpiResid {
    static constexpr bool PERM = false;
    const float* base; float* out; const float* gate0; float* rowss;
    __device__ __forceinline__ void operator()(const AccT& acc, const Unit& u, int wr, int wc, int fr, int fq) const {
        const int row0 = u.pm * BM + wr * 64 + fr, col0 = u.pn * BM + wc * 32 + 4 * fq;
        const float* gate = gate0 + (u.pm >> 4) * D6;
        f32x4 gv[2][2];
#pragma unroll
        for (int bj = 0; bj < 2; ++bj)
#pragma unroll
            for (int n = 0; n < 2; ++n) gv[bj][n] = *(const f32x4*)(gate + col0 + bj * HALF + n * 16);
#pragma unroll
        for (int ai = 0; ai < 2; ++ai)
#pragma unroll
            for (int m = 0; m < 4; ++m) { const size_t off = (size_t)(row0 + ai * HALF + m * 16) * D + col0; float ss = 0.f;
#pragma unroll
                for (int bj = 0; bj < 2; ++bj)
#pragma unroll
                    for (int n = 0; n < 2; ++n) { const f32x4 bs = *(const f32x4*)(base + off + bj * HALF + n * 16); const f32x4 xo = bs + gv[bj][n] * acc[ai][bj][m][n]; *(f32x4*)(out + off + bj * HALF + n * 16) = xo;
                        ss += (xo.x * xo.x + xo.y * xo.y) + (xo.z * xo.z + xo.w * xo.w); }
                if (rowss) { const int ln = fr + 16 * fq; ss += shfl_xor_l(ss, 16, ln); ss += shfl_xor_l(ss, 32, ln); if (fq == 0) atomicAdd(rowss + row0 + ai * HALF + m * 16, ss); }
                asm volatile("" ::: "memory"); }
    }
};
struct EpiResidNorm {
    static constexpr bool PERM = true;
    const float* base; float* out; const float* gate0; const float* gp0; bf16_t* XG; float* rowss;
    __device__ __forceinline__ void operator()(const AccT& acc, const Unit& u, int wr, int wc, int fr, int fq) const {
        const int row0 = u.pm * BM + wr * 64 + fr, col0 = u.pn * BM + wc * 32 + 8 * fq, bb = u.pm >> 4, ln = fr + 16 * fq;
        const float* gate = gate0 + bb * D6; const float* gp = gp0 + bb * D;
        f32x4 gv[2][2], pv[2][2];
#pragma unroll
        for (int bj = 0; bj < 2; ++bj)
#pragma unroll
            for (int n = 0; n < 2; ++n) { gv[bj][n] = *(const f32x4*)(gate + col0 + bj * HALF + 4 * n); pv[bj][n] = *(const f32x4*)(gp + col0 + bj * HALF + 4 * n); }
#pragma unroll
        for (int ai = 0; ai < 2; ++ai)
#pragma unroll
            for (int m = 0; m < 4; ++m) { const int row = row0 + ai * HALF + m * 16; const size_t off = (size_t)row * D + col0; float ss = 0.f;
#pragma unroll
                for (int bj = 0; bj < 2; ++bj) {
                    const f32x4 b0 = *(const f32x4*)(base + off + bj * HALF), b1 = *(const f32x4*)(base + off + bj * HALF + 4);
                    const f32x4 x0 = b0 + gv[bj][0] * acc[ai][bj][m][0], x1 = b1 + gv[bj][1] * acc[ai][bj][m][1];
                    *(f32x4*)(out + off + bj * HALF) = x0; *(f32x4*)(out + off + bj * HALF + 4) = x1;
                    ss += (x0.x * x0.x + x0.y * x0.y) + (x0.z * x0.z + x0.w * x0.w) + (x1.x * x1.x + x1.y * x1.y) + (x1.z * x1.z + x1.w * x1.w);
                    const f32x4 y0 = x0 * pv[bj][0], y1 = x1 * pv[bj][1];
                    u32x4 w; w.x = pk2(y0.x, y0.y); w.y = pk2(y0.z, y0.w); w.z = pk2(y1.x, y1.y); w.w = pk2(y1.z, y1.w);
                    *(u32x4*)(XG + off + bj * HALF) = w; }
                ss += shfl_xor_l(ss, 16, ln); ss += shfl_xor_l(ss, 32, ln);
                if (fq == 0) atomicAdd(rowss + row, ss);
                asm volatile("" ::: "memory"); }
    }
};
template <int ACT> struct EpiBf16 {
    static constexpr bool PERM = true;
    bf16_t* O; int ldc; float* stats; int stat_pn0; const float* rowss; const float* bias0;
    __device__ __forceinline__ void operator()(const AccT& acc, const Unit& u, int wr, int wc, int fr, int fq) const {
        const int row0 = u.pm * BM + wr * 64 + fr, col0 = u.pn * BM + wc * 32 + 8 * fq;
        const bool do_stats = (ACT == 1) && (u.pn >= stat_pn0);
        const float* bias = bias0 + (u.pm >> 4) * F2;
        f32x4 bv[2][2];
#pragma unroll
        for (int bj = 0; bj < 2; ++bj)
#pragma unroll
            for (int n = 0; n < 2; ++n) bv[bj][n] = *(const f32x4*)(bias + col0 + bj * HALF + 4 * n);
#pragma unroll
        for (int ai = 0; ai < 2; ++ai)
#pragma unroll
            for (int m = 0; m < 4; ++m) { const int row = row0 + ai * HALF + m * 16; bf16_t* rowp = O + (size_t)row * ldc + col0; float s = 0.f, q = 0.f;
                const float rstd = __builtin_amdgcn_rsqf(rowss[row] * (1.f / D) + 1e-6f);
#pragma unroll
                for (int bj = 0; bj < 2; ++bj) { f32x4 v0 = acc[ai][bj][m][0] * rstd + bv[bj][0], v1 = acc[ai][bj][m][1] * rstd + bv[bj][1];
                    if (ACT == 1) {
#pragma unroll
                        for (int j = 0; j < 4; ++j) { v0[j] = gelu_tanh_f(v0[j]); v1[j] = gelu_tanh_f(v1[j]); s += v0[j] + v1[j]; q += v0[j] * v0[j] + v1[j] * v1[j]; } }
                    u32x4 w; w.x = pk2(v0[0], v0[1]); w.y = pk2(v0[2], v0[3]); w.z = pk2(v1[0], v1[1]); w.w = pk2(v1[2], v1[3]);
                    *(u32x4*)(rowp + bj * HALF) = w; }
                if (ACT == 1) { if (do_stats) { const int ln = fr + 16 * fq; s += shfl_xor_l(s, 16, ln); s += shfl_xor_l(s, 32, ln); q += shfl_xor_l(q, 16, ln); q += shfl_xor_l(q, 32, ln);
                    if (fq == 0) { atomicAdd(stats + 2 * row, s); atomicAdd(stats + 2 * row + 1, q); } } } }
    }
};
struct EpiGlu {
    static constexpr bool PERM = true;
    const bf16_t* Gm; bf16_t* O; const float* bias;
    __device__ __forceinline__ void operator()(const AccT& acc, const Unit& u, int wr, int wc, int fr, int fq) const {
        const int row0 = u.pm * BM + wr * 64 + fr, col0 = u.pn * BM + wc * 32 + 8 * fq;
        f32x4 bv[2][2];
#pragma unroll
        for (int bj = 0; bj < 2; ++bj)
#pragma unroll
            for (int n = 0; n < 2; ++n) bv[bj][n] = *(const f32x4*)(bias + col0 + bj * HALF + 4 * n);
#pragma unroll
        for (int ai = 0; ai < 2; ++ai)
#pragma unroll
            for (int m = 0; m < 4; ++m) { const size_t off = (size_t)(row0 + ai * HALF + m * 16) * D + col0;
#pragma unroll
                for (int bj = 0; bj < 2; ++bj) { const f32x4 v0 = acc[ai][bj][m][0] + bv[bj][0], v1 = acc[ai][bj][m][1] + bv[bj][1];
                    const u32x4 gw = *(const u32x4*)(Gm + off + bj * HALF);
                    u32x4 w;
                    w.x = pk2(bf_lo(gw.x) * sigmoid_f(v0[0]), bf_hi(gw.x) * sigmoid_f(v0[1]));
                    w.y = pk2(bf_lo(gw.y) * sigmoid_f(v0[2]), bf_hi(gw.y) * sigmoid_f(v0[3]));
                    w.z = pk2(bf_lo(gw.z) * sigmoid_f(v1[0]), bf_hi(gw.z) * sigmoid_f(v1[1]));
                    w.w = pk2(bf_lo(gw.w) * sigmoid_f(v1[2]), bf_hi(gw.w) * sigmoid_f(v1[3]));
                    *(u32x4*)(O + off + bj * HALF) = w; } }
    }
};
}

__device__ __forceinline__ void p0_gemv_task(CArgsP a, LAS unsigned char* lds, int tk) {
    const int t = tid_opaque();
    LAS float* sv = (LAS float*)lds;
    LAS float* red = (LAS float*)(lds + 24576);
    const int l = tk / 384, n0 = (tk % 384) * 32;
    const float* c = a->in[1]; const float* cc = a->in[3];
    for (int i = t; i < 3 * D; i += NTHREADS) { const float x = i < 2 * D ? c[i] : cc[i - 2 * D]; sv[i] = silu_f(x); }
    __syncthreads();
    const int cq = t & 7, ks = t >> 3;
    const float* W = a->in[6] + (size_t)l * D * D6 + n0 + 4 * cq;
    f32x4 acc0 = {0.f, 0.f, 0.f, 0.f}, acc1 = acc0, acc2 = acc0;
#pragma unroll 8
    for (int kk = 0; kk < 32; ++kk) { const int k = ks * 32 + kk; const f32x4 w = __builtin_nontemporal_load((const f32x4*)(W + (size_t)k * D6));
        const float s0 = sv[k], s1 = sv[D + k], s2 = sv[2 * D + k]; acc0 += w * s0; acc1 += w * s1; acc2 += w * s2; }
    LAS float* rp = red + ks * 96 + cq * 12;
#pragma unroll
    for (int j = 0; j < 4; ++j) { rp[j] = acc0[j]; rp[4 + j] = acc1[j]; rp[8 + j] = acc2[j]; }
    __syncthreads();
    if (t < 96) { float s = 0.f;
#pragma unroll 8
        for (int j = 0; j < 64; ++j) s += red[j * 96 + t];
        const int q = t / 12, i = t % 12, v = i >> 2, comp = i & 3, n = n0 + 4 * q + comp;
        float* modbuf = (float*)(a->ws + WS_MOD);
        modbuf[(l * 3 + v) * D6 + n] = s + a->in[7][l * D6 + n]; }
    __syncthreads();
}

struct TMat { const float* W; bf16_t* Wt; int K, N; float* bias; const float* shift; };
__device__ __forceinline__ bool tr_decode(CArgsP a, int task, int t_end, TMat& m, int& k0, int& n0) {
    constexpr int C0 = 256, C1 = 512, C2 = 768, C3 = C2 + 1408, C4 = C3 + 1408, C5 = C4 + 704, C6 = C5 + 704, C7 = C6 + 1024, C8 = C7 + 512;
    if (task >= t_end) return false;
    int base;
    float* BI = (float*)(a->ws + WS_BIAS); const float* MD = (const float*)(a->ws + WS_MOD);
    if (task < C0) { m = {a->in[12], (bf16_t*)(a->ws + WS_WIN), D, D, nullptr, nullptr}; base = 0; }
    else if (task < C1) { m = {a->in[21], (bf16_t*)(a->ws + WS_WGLU), D, D, nullptr, nullptr}; base = C0; }
    else if (task < C2) { m = {a->in[23], (bf16_t*)(a->ws + WS_WOUT), D, D, nullptr, nullptr}; base = C1; }
    else if (task < C3) { m = {a->in[8], (bf16_t*)(a->ws + WS_UP0), D, F2, BI, MD + 3 * D}; base = C2; }
    else if (task < C4) { m = {a->in[8] + (size_t)D * F2, (bf16_t*)(a->ws + WS_UP1), D, F2, BI + 4 * F2, MD + 3 * D6 + 3 * D}; base = C3; }
    else if (task < C5) { m = {a->in[11], (bf16_t*)(a->ws + WS_DN0), FF, D, nullptr, nullptr}; base = C4; }
    else if (task < C6) { m = {a->in[11] + (size_t)FF * D, (bf16_t*)(a->ws + WS_DN1), FF, D, nullptr, nullptr}; base = C5; }
    else if (task < C7) { m = {a->in[24], (bf16_t*)(a->ws + WS_SIN_W), D, SD2, BI + 2 * F2, MD + 3 * D6}; base = C6; }
    else { m = {a->in[29], (bf16_t*)(a->ws + WS_SOUT_W), SD, D, nullptr, nullptr}; base = C7; }
    const int idx = task - base, ntn = m.N >> 7;
    k0 = (idx / ntn) * 128; n0 = (idx % ntn) * 128;
    return true;
}
__device__ __forceinline__ void tr_load(const TMat& m, int k0, int n0, int t, f32x4 (&r)[8]) {
    const int c4 = t & 31, rr = t >> 5;
#pragma unroll
    for (int i = 0; i < 8; ++i) r[i] = __builtin_nontemporal_load((const f32x4*)(m.W + (size_t)(k0 + rr + 16 * i) * m.N + n0 + 4 * c4));
}
constexpr int TR_PITCH = 132;
constexpr int TRC_UP1_B = 768 + 1408, TRC_UP1_E = TRC_UP1_B + 1408, TRC_DN1_B = TRC_UP1_E + 704, TRC_DN1_E = TRC_DN1_B + 704, TRC_END = TRC_DN1_E + 1024 + 512;
__device__ __forceinline__ int tr_remap(int v) {
    if (v >= TRC_UP1_B) v += 1408; if (v >= TRC_DN1_B) v += 704; return v; }
__device__ __forceinline__ void tr_step(LAS float* tile, LAS float* shl, int t, f32x4 (&r)[8], const TMat& m, int k0, int n0, bool nok, const TMat& nm, int nk0, int nn0) {
    { const int c4 = t & 31, rr = t >> 5;
#pragma unroll
      for (int i = 0; i < 8; ++i) *(LAS f32x4*)(tile + (rr + 16 * i) * TR_PITCH + 4 * c4) = r[i];
      if (m.bias && t < 256) shl[t] = m.shift[(t >> 7) * D6 + k0 + (t & 127)]; }
    __syncthreads();
    if (nok) tr_load(nm, nk0, nn0, t, r);
    { const int n = t & 127, kq = t >> 7; const LAS float* s = tile + (32 * kq) * TR_PITCH + n;
      bf16_t* dst = m.Wt + (size_t)(n0 + n) * m.K + k0 + 32 * kq;
#pragma unroll
      for (int h = 0; h < 4; ++h) { u32x4 o0;
        o0.x = pk2(s[(8 * h + 0) * TR_PITCH], s[(8 * h + 1) * TR_PITCH]); o0.y = pk2(s[(8 * h + 2) * TR_PITCH], s[(8 * h + 3) * TR_PITCH]);
        o0.z = pk2(s[(8 * h + 4) * TR_PITCH], s[(8 * h + 5) * TR_PITCH]); o0.w = pk2(s[(8 * h + 6) * TR_PITCH], s[(8 * h + 7) * TR_PITCH]);
        *(u32x4*)(dst + 8 * h) = o0; }
      if (m.bias) { float p0 = 0.f, p1 = 0.f;
#pragma unroll 8
        for (int i = 0; i < 32; ++i) { const float w = s[i * TR_PITCH]; p0 += w * shl[32 * kq + i]; p1 += w * shl[128 + 32 * kq + i]; }
        atomicAdd(m.bias + n0 + n, p0); atomicAdd(m.bias + F2 + n0 + n, p1); } }
    __syncthreads();
}
template <int MODE>
__device__ __forceinline__ void p0_transpose_all(CArgsP a, LAS unsigned char* lds, int first, int stride, int t_end) {
    const int t = tid_opaque();
    LAS float* tile = (LAS float*)lds;
    LAS float* shl = (LAS float*)(lds + 128 * TR_PITCH * 4);
    TMat ma, mb; int ka, na, kb, nb; f32x4 ra[8], rb[8];
    int task = first;
    bool oka = tr_decode(a, MODE == 1 ? tr_remap(task) : task, t_end, ma, ka, na); if (oka) tr_load(ma, ka, na, t, ra);
    task += stride;
    bool okb = tr_decode(a, MODE == 1 ? tr_remap(task) : task, t_end, mb, kb, nb); if (okb) tr_load(mb, kb, nb, t, rb);
    while (oka) {
        { TMat nm; int nk, nn; task += stride; const bool nok = tr_decode(a, MODE == 1 ? tr_remap(task) : task, t_end, nm, nk, nn);
          tr_step(tile, shl, t, ra, ma, ka, na, nok, nm, nk, nn); oka = nok; ma = nm; ka = nk; na = nn; }
        if (!okb) break;
        { TMat nm; int nk, nn; task += stride; const bool nok = tr_decode(a, MODE == 1 ? tr_remap(task) : task, t_end, nm, nk, nn);
          tr_step(tile, shl, t, rb, mb, kb, nb, nok, nm, nk, nn); okb = nok; mb = nm; kb = nk; nb = nn; }
    }
}

__device__ __forceinline__ void sincos_d(double x, double& s, double& c) {
    const double k = __builtin_rint(x * 0.63661977236758134308);
    double r = __builtin_fma(-k, 1.57079632679489655800e+00, x);
    r = __builtin_fma(-k, 6.12323399573676603587e-17, r);
    const double r2 = r * r;
    double sp = -7.6471637318198164759e-13; sp = sp * r2 + 1.6059043836821614599e-10; sp = sp * r2 - 2.5052108385441718775e-08; sp = sp * r2 + 2.7557319223985890653e-06;
    sp = sp * r2 - 1.9841269841269841270e-04; sp = sp * r2 + 8.3333333333333333333e-03; sp = sp * r2 - 1.6666666666666666667e-01; sp = r + r * r2 * sp;
    double cp = 4.7794773323873852974e-14; cp = cp * r2 - 1.1470745597729724714e-11; cp = cp * r2 + 2.0876756987868098979e-09; cp = cp * r2 - 2.7557319223985890653e-07;
    cp = cp * r2 + 2.4801587301587301587e-05; cp = cp * r2 - 1.3888888888888888889e-03; cp = cp * r2 + 4.1666666666666666667e-02; cp = cp * r2 - 0.5; cp = 1.0 + r2 * cp;
    const int q = ((int)(long long)k) & 3;
    s = (q == 0) ? sp : (q == 1) ? cp : (q == 2) ? -sp : -cp;
    c = (q == 0) ? cp : (q == 1) ? -sp : (q == 2) ? -cp : sp;
}
__device__ __forceinline__ double exp_d(double x) {
    const double k = __builtin_rint(x * 1.44269504088896340736);
    double r = __builtin_fma(-k, 6.93147180369123816490e-01, x);
    r = __builtin_fma(-k, 1.90821492927058770002e-10, r);
    double p = 1.0 / 479001600.0;
    p = p * r + 1.0 / 39916800.0; p = p * r + 1.0 / 3628800.0; p = p * r + 1.0 / 362880.0; p = p * r + 1.0 / 40320.0; p = p * r + 1.0 / 5040.0;
    p = p * r + 1.0 / 720.0; p = p * r + 1.0 / 120.0; p = p * r + 1.0 / 24.0; p = p * r + 1.0 / 6.0; p = p * r + 0.5; p = p * r + 1.0; p = p * r + 1.0;
    const long long e = (long long)k + 1023;
    return p * __builtin_bit_cast(double, (unsigned long long)e << 52);
}
__device__ __forceinline__ void p0_s5_tables(CArgsP a, int idx) {
    const int d = idx >> 13, g = (idx >> 6) & 127, p = idx & 63, gd = g * 2 + d;
    const double are = a->in[13][idx], aim = a->in[14][idx];
    const double dt = exp_d((double)a->in[19][d * NG + g]);
    const double mag = exp_d(are * dt); double sn, cs; sincos_d(aim * dt, sn, cs);
    const double lr = mag * cs, li = mag * sn, den = are * are + aim * aim;
    const double kr = ((lr - 1.0) * are + li * aim) / den, ki = (li * are - (lr - 1.0) * aim) / den;
    const double magT = exp_d(are * dt * (double)TC); double snT, csT; sincos_d(aim * dt * (double)TC, snT, csT);
    f32x2* lam = (f32x2*)(a->ws + WS_LAM); f32x2* lamT = (f32x2*)(a->ws + WS_LAMT);
    lam[gd * 64 + p] = (f32x2){(float)lr, (float)li};
    lamT[gd * 64 + p] = (f32x2){(float)(magT * csT), (float)(magT * snT)};
    bf16_t* Bcat = (bf16_t*)(a->ws + WS_BCAT) + (size_t)(gd * 128 + 2 * p) * 16;
    const float* bre = a->in[15] + (size_t)idx * 16; const float* bim = a->in[16] + (size_t)idx * 16;
#pragma unroll
    for (int h = 0; h < 16; h += 2) {
        const double br0 = bre[h], bi0 = bim[h], br1 = bre[h + 1], bi1 = bim[h + 1];
        *(unsigned*)(Bcat + h) = pk2((float)(kr * br0 - ki * bi0), (float)(kr * br1 - ki * bi1));
        *(unsigned*)(Bcat + 16 + h) = pk2((float)(kr * bi0 + ki * br0), (float)(kr * bi1 + ki * br1));
    }
    bf16_t* Cc = (bf16_t*)(a->ws + WS_CCAT);
    const float* cre = a->in[17] + (size_t)(d * NG + g) * 16 * 64 + p; const float* cim = a->in[18] + (size_t)(d * NG + g) * 16 * 64 + p;
#pragma unroll
    for (int part = 0; part < 2; ++part) {
        const int R = 2 * p + part, tau = R >> 5, rho = R & 31, s = rho >> 4, hh = (rho >> 2) & 1, j = ((rho >> 3) & 1) * 4 + (rho & 3);
        bf16_t* dst = Cc + ((size_t)(((gd * 4 + tau) * 2 + s) * 2 + hh) * 16) * 8 + j;
        for (int h = 0; h < 16; ++h) dst[h * 8] = f2bf(part == 0 ? cre[h * 64] : -cim[h * 64]);
    }
}

__device__ __forceinline__ void p0_s5_kend(CArgsP a, int idx, int seg) {
    const int d = idx >> 13, g = (idx >> 6) & 127, p = idx & 63, gd = g * 2 + d;
    const double are = a->in[13][idx], aim = a->in[14][idx];
    const double dt = exp_d((double)a->in[19][d * NG + g]);
    const double mag = exp_d(are * dt); double sn, cs; sincos_d(aim * dt, sn, cs);
    const double lr = mag * cs, li = mag * sn, den = are * are + aim * aim;
    const double kr = ((lr - 1.0) * are + li * aim) / den, ki = (li * are - (lr - 1.0) * aim) / den;
    const int t_lo = seg == 0 ? 0 : seg == 1 ? 9 : seg == 2 ? 18 : 26, t_hi = seg == 0 ? 9 : seg == 1 ? 18 : seg == 2 ? 26 : 34;
    const double pw = (double)(TC - t_hi);
    const double magP = exp_d(are * dt * pw); double snP, csP; sincos_d(aim * dt * pw, snP, csP);
    double pr = magP * csP, pi = magP * snP;
    float bbr[16], bbi[16];
    const float* bre = a->in[15] + (size_t)idx * 16; const float* bim = a->in[16] + (size_t)idx * 16;
#pragma unroll
    for (int h = 0; h < 16; ++h) { const double br = bre[h], bi = bim[h]; bbr[h] = (float)(kr * br - ki * bi); bbi[h] = (float)(kr * bi + ki * br); }
    for (int tt = t_hi - 1; tt >= t_lo; --tt) {
        const float fr = (float)pr, fi = (float)pi;
        bf16_t* dst = (bf16_t*)(a->ws + WS_KEND) + (((size_t)gd * TC + tt) * 128 + 2 * p) * 16;
        u32x4 w0, w1, w2, w3;
        w0.x = pk2(fr * bbr[0] - fi * bbi[0], fr * bbr[1] - fi * bbi[1]); w0.y = pk2(fr * bbr[2] - fi * bbi[2], fr * bbr[3] - fi * bbi[3]);
        w0.z = pk2(fr * bbr[4] - fi * bbi[4], fr * bbr[5] - fi * bbi[5]); w0.w = pk2(fr * bbr[6] - fi * bbi[6], fr * bbr[7] - fi * bbi[7]);
        w1.x = pk2(fr * bbr[8] - fi * bbi[8], fr * bbr[9] - fi * bbi[9]); w1.y = pk2(fr * bbr[10] - fi * bbi[10], fr * bbr[11] - fi * bbi[11]);
        w1.z = pk2(fr * bbr[12] - fi * bbi[12], fr * bbr[13] - fi * bbi[13]); w1.w = pk2(fr * bbr[14] - fi * bbi[14], fr * bbr[15] - fi * bbi[15]);
        w2.x = pk2(fr * bbi[0] + fi * bbr[0], fr * bbi[1] + fi * bbr[1]); w2.y = pk2(fr * bbi[2] + fi * bbr[2], fr * bbi[3] + fi * bbr[3]);
        w2.z = pk2(fr * bbi[4] + fi * bbr[4], fr * bbi[5] + fi * bbr[5]); w2.w = pk2(fr * bbi[6] + fi * bbr[6], fr * bbi[7] + fi * bbr[7]);
        w3.x = pk2(fr * bbi[8] + fi * bbr[8], fr * bbi[9] + fi * bbr[9]); w3.y = pk2(fr * bbi[10] + fi * bbr[10], fr * bbi[11] + fi * bbr[11]);
        w3.z = pk2(fr * bbi[12] + fi * bbr[12], fr * bbi[13] + fi * bbr[13]); w3.w = pk2(fr * bbi[14] + fi * bbr[14], fr * bbi[15] + fi * bbr[15]);
        *(u32x4*)dst = w0; *(u32x4*)(dst + 8) = w1; *(u32x4*)(dst + 16) = w2; *(u32x4*)(dst + 24) = w3;
        const double nr = pr * lr - pi * li, ni = pr * li + pi * lr; pr = nr; pi = ni;
    }
}

template <bool OUT_F32, int NR>
__device__ __forceinline__ void norm_rows(const float* (&src)[NR], const float* g, const float* (&shift)[NR], void* (&dst)[NR], const bool (&valid)[NR], int lane) {
    f32x4 v[NR][8];
#pragma unroll
    for (int r = 0; r < NR; ++r)
#pragma unroll
        for (int j = 0; j < 8; ++j) v[r][j] = __builtin_nontemporal_load((const f32x4*)src[r] + lane + 64 * j);
#pragma unroll
    for (int r = 0; r < NR; ++r) {
        float ss = 0.f;
#pragma unroll
        for (int j = 0; j < 8; ++j) ss += (v[r][j].x * v[r][j].x + v[r][j].y * v[r][j].y) + (v[r][j].z * v[r][j].z + v[r][j].w * v[r][j].w);
        ss = wave_sum(ss, lane);
        const float rstd = __builtin_amdgcn_rsqf(ss * (1.f / D) + 1e-6f);
        if (valid[r]) {
#pragma unroll
            for (int j = 0; j < 8; ++j) {
                const f32x4 gv = ((const f32x4*)g)[lane + 64 * j]; f32x4 y = v[r][j] * rstd * gv;
                if (OUT_F32) ((f32x4*)dst[r])[lane + 64 * j] = y;
                else { const f32x4 sh = ((const f32x4*)shift[r])[lane + 64 * j], sc = ((const f32x4*)(shift[r] + D))[lane + 64 * j]; y = y * (sc + 1.f) + sh;
                    u32x2 w; w.x = pk2(y.x, y.y); w.y = pk2(y.z, y.w); ((u32x2*)dst[r])[lane + 64 * j] = w; }
            }
        }
    }
}

#define MFMA32(a, b, c) __builtin_amdgcn_mfma_f32_32x32x16_bf16((a), (b), (c), 0, 0, 0)
__device__ __forceinline__ bf16x8 pack8(const f32x4& a, const f32x4& b) { u32x4 p; p.x = pk2(a.x, a.y); p.y = pk2(a.z, a.w); p.z = pk2(b.x, b.y); p.w = pk2(b.z, b.w); return __builtin_bit_cast(bf16x8, p); }
template <bool PASSB>
__device__ __forceinline__ void s5_pass(CArgsP a, LAS unsigned char* lds, int gw, int nw, int lane) {
    LAS unsigned char* cfl = lds + tid_opaque() * 16;
    LAS unsigned char* lamL = lds + 65536 + (tid_opaque() >> 6) * 512;
    const bf16_t* U = (const bf16_t*)(a->ws + WS_UB);
    const f32x2* lam = (const f32x2*)(a->ws + WS_LAM);
    const bf16_t* Bcat = (const bf16_t*)(a->ws + WS_BCAT);
    const bf16_t* Cc = (const bf16_t*)(a->ws + WS_CCAT);
    for (int item = gw; item < 2048; item += nw) {
        const int g = item & 127, tile = (item >> 7) & 7, d = item >> 10, gd = g * 2 + d;
        const int r = lane & 31, hh = lane >> 5, col = tile * 32 + r, b = col >> 7, c = col & 127;
        bf16x8 Bf[4];
#pragma unroll
        for (int tau = 0; tau < 4; ++tau) Bf[tau] = *(const bf16x8*)(Bcat + (size_t)(gd * 128 + 32 * tau + r) * 16 + 8 * hh);
        { const int p = lane, tau = p >> 4, pl = p & 15, q = ((pl >> 2) << 1) | (pl & 1), h2 = (pl >> 1) & 1;
          *(LAS f32x2*)(lamL + ((tau * 2 + h2) * 8 + q) * 8) = lam[gd * 64 + p]; }
        f32x16 S[4];
        float* Ebuf = (float*)(a->ws + (PASSB ? WS_SI : WS_E)) + ((size_t)gd * NCOL + col) * 128 + 4 * hh;
        if (PASSB) {
#pragma unroll
            for (int tau = 0; tau < 4; ++tau)
#pragma unroll
                for (int i4 = 0; i4 < 4; ++i4) { const f32x4 v = *(const f32x4*)(Ebuf + 32 * tau + 8 * i4); S[tau][4 * i4] = v.x; S[tau][4 * i4 + 1] = v.y; S[tau][4 * i4 + 2] = v.z; S[tau][4 * i4 + 3] = v.w; }
        } else {
#pragma unroll
            for (int tau = 0; tau < 4; ++tau)
#pragma unroll
                for (int i = 0; i < 16; ++i) S[tau][i] = 0.f;
        }
        if (PASSB) {
#pragma unroll
            for (int tau = 0; tau < 4; ++tau)
#pragma unroll
                for (int s = 0; s < 2; ++s) {
                    u32x4 z = {0u, 0u, 0u, 0u};
                    if (r < 16) z = *(const u32x4*)(Cc + ((size_t)((((gd * 4 + tau) * 2 + s) * 2 + hh) * 16 + r)) * 8);
                    *(LAS u32x4*)(cfl + (tau * 2 + s) * 8192) = z;
                }
        }
        bf16_t* Yd = (bf16_t*)(a->ws + (d == 0 ? WS_YF : WS_YR));
        const int pos0 = TC * c;
        auto memidx = [&](int pos) -> int { return d == 0 ? pos : (pos < CTXL ? (CTXL - 1 - pos) : (LT + CTXL - 1 - pos)); };
        const bf16_t* ub = U + (size_t)b * LT * D + g * 16 + 8 * hh;
        auto ldu = [&](int mem) -> bf16x8 { return *(const bf16x8*)(ub + (size_t)mem * D); };
        bf16x8 un[8];
#pragma unroll
        for (int j = 0; j < 8; ++j) un[j] = ldu(memidx(pos0 + j));
#pragma unroll 1
        for (int tb = 0; tb < TC; tb += 8) {
#pragma unroll
          for (int j = 0; j < 8; j += 2) {
            const int t = tb + j;
            if (t < TC) {
            asm volatile("" ::: "memory");
            const bf16x8 ufa = un[j], ufb = un[j + 1];
            const int posa = pos0 + t, mema = memidx(posa), memb = memidx(posa + 1);
            if (t + 8 < TC) { un[j] = ldu(memidx(posa + 8)); un[j + 1] = ldu(memidx(posa + 9)); }
            f32x16 Ya, Yb;
#pragma unroll
            for (int i = 0; i < 16; ++i) { Ya[i] = 0.f; Yb[i] = 0.f; }
#pragma unroll
            for (int tau = 0; tau < 4; ++tau) {
                const LAS f32x4* lp = (const LAS f32x4*)(lamL + (tau * 2 + hh) * 64);
                const f32x4 l0 = lp[0], l1 = lp[1], l2 = lp[2], l3 = lp[3];
                const float lrr[8] = {l0.x, l0.z, l1.x, l1.z, l2.x, l2.z, l3.x, l3.z}, lii[8] = {l0.y, l0.w, l1.y, l1.w, l2.y, l2.w, l3.y, l3.w};
                bf16x8 cf0, cf1;
                if (PASSB) { cf0 = *(const LAS bf16x8*)(cfl + (tau * 2 + 0) * 8192); cf1 = *(const LAS bf16x8*)(cfl + (tau * 2 + 1) * 8192); }
#pragma unroll
                for (int half = 0; half < 2; ++half) {
                    f32x16 C;
#pragma unroll
                    for (int q = 0; q < 8; ++q) { const float sr = S[tau][2 * q], si = S[tau][2 * q + 1];
                        C[2 * q] = lrr[q] * sr - lii[q] * si; C[2 * q + 1] = lrr[q] * si + lii[q] * sr; }
                    S[tau] = MFMA32(Bf[tau], half == 0 ? ufa : ufb, C);
                    if (PASSB) {
                        u32x4 p0, p1;
                        p0.x = pk2(S[tau][0], S[tau][1]); p0.y = pk2(S[tau][2], S[tau][3]); p0.z = pk2(S[tau][4], S[tau][5]); p0.w = pk2(S[tau][6], S[tau][7]);
                        p1.x = pk2(S[tau][8], S[tau][9]); p1.y = pk2(S[tau][10], S[tau][11]); p1.z = pk2(S[tau][12], S[tau][13]); p1.w = pk2(S[tau][14], S[tau][15]);
                        if (half == 0) { Ya = MFMA32(cf0, __builtin_bit_cast(bf16x8, p0), Ya); Ya = MFMA32(cf1, __builtin_bit_cast(bf16x8, p1), Ya); }
                        else { Yb = MFMA32(cf0, __builtin_bit_cast(bf16x8, p0), Yb); Yb = MFMA32(cf1, __builtin_bit_cast(bf16x8, p1), Yb); }
                    }
                }
            }
            if (PASSB) {
                { u32x2 w0, w1; w0.x = pk2(Ya[0], Ya[1]); w0.y = pk2(Ya[2], Ya[3]); w1.x = pk2(Ya[4], Ya[5]); w1.y = pk2(Ya[6], Ya[7]);
                  const u32x2 snd = hh ? w0 : w1; u32x2 rcv;
                  rcv.x = (unsigned)__builtin_amdgcn_ds_bpermute((lane ^ 32) << 2, (int)snd.x); rcv.y = (unsigned)__builtin_amdgcn_ds_bpermute((lane ^ 32) << 2, (int)snd.y);
                  if (posa >= CTXL) { bf16_t* yp = Yd + ((size_t)b * SEQ + (mema - CTXL)) * D + g * 16 + 8 * hh;
                      const u32x4 o = hh ? (u32x4){rcv.x, rcv.y, w1.x, w1.y} : (u32x4){w0.x, w0.y, rcv.x, rcv.y}; *(u32x4*)yp = o; } }
                { u32x2 w0, w1; w0.x = pk2(Yb[0], Yb[1]); w0.y = pk2(Yb[2], Yb[3]); w1.x = pk2(Yb[4], Yb[5]); w1.y = pk2(Yb[6], Yb[7]);
                  const u32x2 snd = hh ? w0 : w1; u32x2 rcv;
                  rcv.x = (unsigned)__builtin_amdgcn_ds_bpermute((lane ^ 32) << 2, (int)snd.x); rcv.y = (unsigned)__builtin_amdgcn_ds_bpermute((lane ^ 32) << 2, (int)snd.y);
                  if (posa + 1 >= CTXL) { bf16_t* yp = Yd + ((size_t)b * SEQ + (memb - CTXL)) * D + g * 16 + 8 * hh;
                      const u32x4 o = hh ? (u32x4){rcv.x, rcv.y, w1.x, w1.y} : (u32x4){w0.x, w0.y, rcv.x, rcv.y}; *(u32x4*)yp = o; } }
            }
            }
          }
        }
        if (!PASSB) {
#pragma unroll
            for (int tau = 0; tau < 4; ++tau)
#pragma unroll
                for (int i4 = 0; i4 < 4; ++i4) *(f32x4*)(Ebuf + 32 * tau + 8 * i4) = (f32x4){S[tau][4 * i4], S[tau][4 * i4 + 1], S[tau][4 * i4 + 2], S[tau][4 * i4 + 3]};
        }
    }
}

__device__ __forceinline__ void s5_passA(CArgsP a, int gw, int nw, int lane) {
    const bf16_t* U = (const bf16_t*)(a->ws + WS_UB);
    const bf16_t* KE = (const bf16_t*)(a->ws + WS_KEND);
    for (int item = gw; item < 2048; item += nw) {
        const int g = item & 127, tile = (item >> 7) & 7, d = item >> 10, gd = g * 2 + d;
        const int r = lane & 31, hh = lane >> 5, col = tile * 32 + r, b = col >> 7, c = col & 127;
        f32x16 S[4];
#pragma unroll
        for (int tau = 0; tau < 4; ++tau)
#pragma unroll
            for (int i = 0; i < 16; ++i) S[tau][i] = 0.f;
        float* Ebuf = (float*)(a->ws + WS_E) + ((size_t)gd * NCOL + col) * 128 + 4 * hh;
        const int pos0 = TC * c;
        auto memidx = [&](int pos) -> int { return d == 0 ? pos : (pos < CTXL ? (CTXL - 1 - pos) : (LT + CTXL - 1 - pos)); };
        const bf16_t* ub = U + (size_t)b * LT * D + g * 16 + 8 * hh;
        const bf16_t* kb = KE + ((size_t)gd * TC * 128 + r) * 16 + 8 * hh;
        bf16x8 un[8], af[4][4];
#pragma unroll
        for (int j = 0; j < 8; ++j) un[j] = *(const bf16x8*)(ub + (size_t)memidx(pos0 + j) * D);
#pragma unroll
        for (int j = 0; j < 4; ++j)
#pragma unroll
            for (int tau = 0; tau < 4; ++tau) af[j][tau] = *(const bf16x8*)(kb + ((size_t)j * 128 + 32 * tau) * 16);
#pragma unroll 1
        for (int tb = 0; tb < TC; tb += 8) {
#pragma unroll
            for (int j = 0; j < 8; ++j) {
                const int t = tb + j;
                if (t < TC) {
                    const bf16x8 uf = un[j];
                    const bf16x8 a0 = af[j & 3][0], a1 = af[j & 3][1], a2 = af[j & 3][2], a3 = af[j & 3][3];
                    if (t + 8 < TC) un[j] = *(const bf16x8*)(ub + (size_t)memidx(pos0 + t + 8) * D);
                    if (t + 4 < TC) {
#pragma unroll
                        for (int tau = 0; tau < 4; ++tau) af[j & 3][tau] = *(const bf16x8*)(kb + ((size_t)(t + 4) * 128 + 32 * tau) * 16); }
                    S[0] = MFMA32(a0, uf, S[0]); S[1] = MFMA32(a1, uf, S[1]); S[2] = MFMA32(a2, uf, S[2]); S[3] = MFMA32(a3, uf, S[3]);
                }
            }
        }
#pragma unroll
        for (int tau = 0; tau < 4; ++tau)
#pragma unroll
            for (int i4 = 0; i4 < 4; ++i4) *(f32x4*)(Ebuf + 32 * tau + 8 * i4) = (f32x4){S[tau][4 * i4], S[tau][4 * i4 + 1], S[tau][4 * i4 + 2], S[tau][4 * i4 + 3]};
    }
}

__device__ __forceinline__ float dot2bf(unsigned z, unsigned w, float acc) { return __builtin_amdgcn_fdot2_f32_bf16(__builtin_bit_cast(bf16x2v, z), __builtin_bit_cast(bf16x2v, w), acc, false); }
__device__ __forceinline__ void conv_phase(CArgsP a, LAS unsigned char* lds, int layer, int first, int stride) {
    const int t0 = tid_opaque();
    const bf16_t* Z = (const bf16_t*)(a->ws + WS_Z); bf16_t* A3 = (bf16_t*)(a->ws + WS_A3);
    const float* cw = a->in[9] + (size_t)layer * 9 * F2; const float* cb = a->in[10] + (size_t)layer * F2;
    LAS unsigned* wl = (LAS unsigned*)lds;
    for (int task = first; task < 704; task += stride) {
        const int t = launder_i(t0), o = t & 15, c = (t >> 4) + 32 * ((task / 44) & 1);
        const int cbk = task % 44, rb = (task / 88) & 3, b = task / 352;
        __syncthreads();
#pragma unroll
        for (int it = 0; it < 5; ++it) { const int i = t + it * NTHREADS; { const int tap = i >> 8, half = (i >> 7) & 1, ch = i & 127; const int gch = half * FF + cbk * 128 + ch;
            const float wv = tap < 9 ? cw[(size_t)tap * F2 + gch] : cb[gch];
            wl[i] = tap < 9 ? ((ch & 1) ? (pk2(0.f, wv)) : (pk2(wv, 0.f))) : __builtin_bit_cast(unsigned, wv); } }
        __syncthreads();
        const u32x4 zero4 = {0u, 0u, 0u, 0u};
        u32x4 win[6][3][2];
        const size_t chg = (size_t)cbk * 128 + 8 * o;
        auto ldrow = [&](int rrow, u32x4 (&w)[3][2]) {
#pragma unroll
            for (int dj = 0; dj < 3; ++dj) { const int cc2 = c + dj - 1; const bool ok = (rrow >= 0) && (rrow < 64) && (cc2 >= 0) && (cc2 < 64);
                if (ok) { const bf16_t* zp = Z + ((size_t)b * SEQ + rrow * 64 + cc2) * F2 + chg; w[dj][0] = *(const u32x4*)zp; w[dj][1] = *(const u32x4*)(zp + FF); }
                else { w[dj][0] = zero4; w[dj][1] = zero4; } }
        };
        const int r0 = rb * 16;
        ldrow(r0 - 1, win[0]); ldrow(r0, win[1]); ldrow(r0 + 1, win[2]); ldrow(r0 + 2, win[3]);
#pragma unroll
        for (int q = 0; q < 8; ++q) {
                asm volatile("" ::: "memory");
                const int row = r0 + 2 * q;
                if (q <= 6) { ldrow(row + 3, win[(2 * q + 4) % 6]); ldrow(row + 4, win[(2 * q + 5) % 6]); }
                float ag[2][8], av[2][8];
                { const LAS f32x4* bp = (const LAS f32x4*)(wl + 9 * 256 + 8 * o); const f32x4 b0 = bp[0], b1 = bp[1], b2 = bp[32], b3 = bp[33];
#pragma unroll
                  for (int rr = 0; rr < 2; ++rr)
#pragma unroll
                  for (int j = 0; j < 4; ++j) { ag[rr][j] = b0[j]; ag[rr][4 + j] = b1[j]; av[rr][j] = b2[j]; av[rr][4 + j] = b3[j]; } }
#pragma unroll
                for (int di = 0; di < 3; ++di)
#pragma unroll
                    for (int dj = 0; dj < 3; ++dj) {
                        asm volatile("" ::: "memory");
                        const LAS u32x4* wp = (const LAS u32x4*)(wl + (di * 3 + dj) * 256 + 8 * o);
                        const u32x4 wg0 = wp[0], wg1 = wp[1], wv0 = wp[32], wv1 = wp[33];
#pragma unroll
                        for (int rr = 0; rr < 2; ++rr) {
                            const u32x4 zg = win[(2 * q + rr + di) % 6][dj][0], zv = win[(2 * q + rr + di) % 6][dj][1];
                            ag[rr][0] = dot2bf(zg.x, wg0.x, ag[rr][0]); ag[rr][1] = dot2bf(zg.x, wg0.y, ag[rr][1]); ag[rr][2] = dot2bf(zg.y, wg0.z, ag[rr][2]); ag[rr][3] = dot2bf(zg.y, wg0.w, ag[rr][3]);
                            ag[rr][4] = dot2bf(zg.z, wg1.x, ag[rr][4]); ag[rr][5] = dot2bf(zg.z, wg1.y, ag[rr][5]); ag[rr][6] = dot2bf(zg.w, wg1.z, ag[rr][6]); ag[rr][7] = dot2bf(zg.w, wg1.w, ag[rr][7]);
                            av[rr][0] = dot2bf(zv.x, wv0.x, av[rr][0]); av[rr][1] = dot2bf(zv.x, wv0.y, av[rr][1]); av[rr][2] = dot2bf(zv.y, wv0.z, av[rr][2]); av[rr][3] = dot2bf(zv.y, wv0.w, av[rr][3]);
                            av[rr][4] = dot2bf(zv.z, wv1.x, av[rr][4]); av[rr][5] = dot2bf(zv.z, wv1.y, av[rr][5]); av[rr][6] = dot2bf(zv.w, wv1.z, av[rr][6]); av[rr][7] = dot2bf(zv.w, wv1.w, av[rr][7]);
                        }
                    }
#pragma unroll
                for (int rr = 0; rr < 2; ++rr) {
                    u32x4 w;
                    w.x = pk2(silu_f(ag[rr][0]) * av[rr][0], silu_f(ag[rr][1]) * av[rr][1]); w.y = pk2(silu_f(ag[rr][2]) * av[rr][2], silu_f(ag[rr][3]) * av[rr][3]);
                    w.z = pk2(silu_f(ag[rr][4]) * av[rr][4], silu_f(ag[rr][5]) * av[rr][5]); w.w = pk2(silu_f(ag[rr][6]) * av[rr][6], silu_f(ag[rr][7]) * av[rr][7]);
                    *(u32x4*)(A3 + ((size_t)b * SEQ + (row + rr) * 64 + c) * FF + chg) = w; }
        }
    }
}

constexpr int SP_PITCH = 136;
constexpr int SP_WS_OFF = 0, SP_VT_OFF = 128 * SP_PITCH * 2  , SP_O_OFF = SP_VT_OFF  , SP_OPITCH = 264;
__device__ __forceinline__ void spatial_phase(CArgsP a, LAS unsigned char* lds, int first, int stride) {
    const int t = tid_opaque(), lane = t & 63, wid = t >> 6;
    const bf16_t* ZS = (const bf16_t*)(a->ws + WS_ZS); bf16_t* GT = (bf16_t*)(a->ws + WS_GT);
    const float* st = (const float*)(a->ws + WS_LNST);
    const float* lng = a->in[25]; const float* lnb = a->in[26]; const float* wsp = a->in[27]; const float* bsp = a->in[28];
    LAS bf16_t* Ws = (LAS bf16_t*)(lds + SP_WS_OFF); LAS bf16_t* Vt = (LAS bf16_t*)(lds + SP_VT_OFF); LAS bf16_t* Ot = (LAS bf16_t*)(lds + SP_O_OFF);
    int g_loaded = -1;
    u32x4 va[4], vb[4]; f32x4 st4[4];
    auto load_v = [&](int item) {
        const int g = item & 15, cn = item >> 4; const size_t tok0 = (size_t)cn * 128;
#pragma unroll
        for (int it = 0; it < 4; ++it) { const int i = t + it * NTHREADS; const int oc = i & 3, kp = (i >> 2) & 63, og = i >> 8, c0 = (og * 4 + oc) * 8;
            const size_t ra = tok0 + 2 * kp;
            va[it] = __builtin_nontemporal_load((const u32x4*)(ZS + ra * SD2 + SD + g * 256 + c0)); vb[it] = __builtin_nontemporal_load((const u32x4*)(ZS + (ra + 1) * SD2 + SD + g * 256 + c0));
            st4[it] = *(const f32x4*)(st + 2 * ra); }
    };
    if (first < 1024) load_v(first);
    for (int item = first; item < 1024; item += stride) {
        const int g = item & 15, cn = item >> 4;
        const size_t tok0 = (size_t)cn * 128;
        __syncthreads();
        if (g != g_loaded) { g_loaded = g;
        for (int i = t; i < 128 * 32; i += NTHREADS) { const int q = i >> 5, k4 = i & 31; const f32x4 w = *(const f32x4*)(wsp + ((size_t)g * 128 + q) * 128 + 4 * k4);
            u32x2 pw; pw.x = pk2(w.x, w.y); pw.y = pk2(w.z, w.w); *(LAS u32x2*)(Ws + q * SP_PITCH + 4 * k4) = pw; } }
#pragma unroll
        for (int it = 0; it < 4; ++it) {
            const int i = t + it * NTHREADS; const int oc = i & 3, kp = (i >> 2) & 63, og = i >> 8, c0 = (og * 4 + oc) * 8;
            const float mua = st4[it].x * (1.f / SD), mub = st4[it].z * (1.f / SD);
            const float rsa = __builtin_amdgcn_rsqf(st4[it].y * (1.f / SD) - mua * mua + 1e-5f), rsb = __builtin_amdgcn_rsqf(st4[it].w * (1.f / SD) - mub * mub + 1e-5f);
            const f32x4 g0 = *(const f32x4*)(lng + g * 256 + c0), g1 = *(const f32x4*)(lng + g * 256 + c0 + 4), b0 = *(const f32x4*)(lnb + g * 256 + c0), b1 = *(const f32x4*)(lnb + g * 256 + c0 + 4);
            const unsigned wa[4] = {va[it].x, va[it].y, va[it].z, va[it].w}, wb[4] = {vb[it].x, vb[it].y, vb[it].z, vb[it].w};
#pragma unroll
            for (int j = 0; j < 4; ++j) {
                const float gl = j < 2 ? g0[2 * j] : g1[2 * j - 4], gh = j < 2 ? g0[2 * j + 1] : g1[2 * j - 3];
                const float bl = j < 2 ? b0[2 * j] : b1[2 * j - 4], bh = j < 2 ? b0[2 * j + 1] : b1[2 * j - 3];
                const float al = (bf_lo(wa[j]) - mua) * rsa * gl + bl, ah = (bf_hi(wa[j]) - mua) * rsa * gh + bh;
                const float bl2 = (bf_lo(wb[j]) - mub) * rsb * gl + bl, bh2 = (bf_hi(wb[j]) - mub) * rsb * gh + bh;
                *(LAS unsigned*)(Vt + (c0 + 2 * j) * SP_PITCH + 2 * kp) = pk2(al, bl2);
                *(LAS unsigned*)(Vt + (c0 + 2 * j + 1) * SP_PITCH + 2 * kp) = pk2(ah, bh2);
            }
        }
        __syncthreads();
        if (item + stride < 1024) load_v(item + stride);
        u32x4 uvr[8];
#pragma unroll
        for (int it = 0; it < 8; ++it) { const int i = t + it * NTHREADS; const int q = i >> 5, oct = i & 31; uvr[it] = __builtin_nontemporal_load((const u32x4*)(ZS + (tok0 + q) * SD2 + g * 256 + 8 * oct)); }
        const int r = lane & 31, hh = lane >> 5;
        f32x16 acc[4];
#pragma unroll
        for (int mt = 0; mt < 4; ++mt)
#pragma unroll
            for (int i = 0; i < 16; ++i) acc[mt][i] = 0.f;
#pragma unroll
        for (int ks = 0; ks < 8; ++ks) {
            const bf16x8 bfr = *(const LAS bf16x8*)(Vt + (32 * wid + r) * SP_PITCH + 16 * ks + 8 * hh);
#pragma unroll
            for (int mt = 0; mt < 4; ++mt) { const bf16x8 afr = *(const LAS bf16x8*)(Ws + (32 * mt + r) * SP_PITCH + 16 * ks + 8 * hh); acc[mt] = MFMA32(afr, bfr, acc[mt]); }
        }
        __syncthreads();
#pragma unroll
        for (int mt = 0; mt < 4; ++mt)
#pragma unroll
            for (int i = 0; i < 16; ++i) { const int q = 32 * mt + (i & 3) + 8 * (i >> 2) + 4 * hh; Ot[q * SP_OPITCH + 32 * wid + r] = f2bf(acc[mt][i] + bsp[g * 128 + q]); }
        __syncthreads();
#pragma unroll
        for (int it = 0; it < 8; ++it) { const int i = t + it * NTHREADS; const int q = i >> 5, oct = i & 31;
            const u32x4 uv = uvr[it];
            const u32x4 sv = *(const LAS u32x4*)(Ot + q * SP_OPITCH + 8 * oct);
            u32x4 w;
            w.x = pk2(bf_lo(uv.x) * bf_lo(sv.x), bf_hi(uv.x) * bf_hi(sv.x)); w.y = pk2(bf_lo(uv.y) * bf_lo(sv.y), bf_hi(uv.y) * bf_hi(sv.y));
            w.z = pk2(bf_lo(uv.z) * bf_lo(sv.z), bf_hi(uv.z) * bf_hi(sv.z)); w.w = pk2(bf_lo(uv.w) * bf_lo(sv.w), bf_hi(uv.w) * bf_hi(sv.w));
            *(u32x4*)(GT + (tok0 + q) * SD + g * 256 + 8 * oct) = w; }
    }
}

#define XB_TMO      128
#define XB_XCNT(j)  (256  + 64 * (j))
#define XB_XSUB(j)  (1280 + 64 * (j))
#define XB_XGEN(j)  (2304 + 64 * (j))
#define XB_TOP      3328
#define XB_TOPGEN   3392
#define XCD_BAR_WORDS 3456
#define XB_SPIN_CAP (1u << 22)
__device__ __forceinline__ unsigned xb_ld(unsigned* p)              { return __hip_atomic_load(p, __ATOMIC_RELAXED, __HIP_MEMORY_SCOPE_AGENT); }
__device__ __forceinline__ unsigned xb_add(unsigned* p, unsigned v) { return __hip_atomic_fetch_add(p, v, __ATOMIC_RELAXED, __HIP_MEMORY_SCOPE_AGENT); }
__device__ __forceinline__ unsigned xb_xcc_id() { return (unsigned)__builtin_amdgcn_s_getreg((3 << 11) | 20) & 0xFu; }
#define XB_SPIN(cond, bar) do { unsigned _sp = 0; while (cond) { __builtin_amdgcn_s_sleep(1); \
    if ((++_sp & 255u) == 0u) { if (xb_ld(&(bar)[XB_TMO])) break; if (_sp > XB_SPIN_CAP) { atomicAdd(&(bar)[XB_TMO], 1u); break; } } } } while (0)
struct XcdBarrier { unsigned* bar; unsigned x; volatile LAS unsigned* st; };
__device__ __forceinline__ XcdBarrier xcd_barrier_post(unsigned* bar, volatile LAS unsigned* st) {
    XcdBarrier b; b.bar = bar; b.x = xb_xcc_id(); b.st = st;
    if (threadIdx.x == 0) (void)xb_add(&bar[XB_XCNT(b.x)], 1u);
    return b;
}
__device__ __forceinline__ void xcd_barrier_complete(unsigned* bar, unsigned x, unsigned& nloc, unsigned& nx) {
    const unsigned G = gridDim.x * gridDim.y * gridDim.z;
    unsigned sum, cnt, mine, sp = 0u;
    for (;;) {
        sum = 0u; cnt = 0u; mine = 0u;
#pragma unroll
        for (unsigned j = 0; j < 16; ++j) { const unsigned c = xb_ld(&bar[XB_XCNT(j)]); sum += c; cnt += (c > 0u) ? 1u : 0u; mine = (j == x) ? c : mine; }
        if (sum == G) break;
        __builtin_amdgcn_s_sleep(1);
        if ((++sp & 255u) == 0u) { if (xb_ld(&bar[XB_TMO])) break; if (sp > XB_SPIN_CAP) { atomicAdd(&bar[XB_TMO], 1u); break; } }
    }
    nloc = mine > 0u ? mine : 1u; nx = cnt > 0u ? cnt : 1u;
}
__device__ __forceinline__ void xcd_barrier(const XcdBarrier& b) {
    asm volatile("s_waitcnt vmcnt(0)" ::: "memory");
    __syncthreads();
    if (threadIdx.x == 0) {
        unsigned* bar = b.bar;
        __builtin_amdgcn_s_waitcnt(0);
        unsigned nloc = b.st[0], nx = b.st[1];
        if (nloc == 0u) { xcd_barrier_complete(bar, b.x, nloc, nx); b.st[0] = nloc; b.st[1] = nx; }
        const unsigned old = xb_add(&bar[XB_XSUB(b.x)], 1u);
        const unsigned gen = old / nloc;
        if (old + 1u == (gen + 1u) * nloc) {
            __builtin_amdgcn_fence(__ATOMIC_RELEASE, "agent");
            asm volatile("s_waitcnt vmcnt(0)" ::: "memory");
            const unsigned og = xb_add(&bar[XB_TOP], 1u);
            const unsigned tg = og / nx;
            if (og + 1u == (tg + 1u) * nx) xb_add(&bar[XB_TOPGEN], 1u);
            else XB_SPIN(xb_ld(&bar[XB_TOPGEN]) == tg, bar);
            __builtin_amdgcn_fence(__ATOMIC_ACQUIRE, "agent");
            xb_add(&bar[XB_XGEN(b.x)], 1u);
            asm volatile("s_waitcnt vmcnt(0)" ::: "memory");
        } else {
            XB_SPIN(xb_ld(&bar[XB_XGEN(b.x)]) == gen, bar);
            __builtin_amdgcn_fence(__ATOMIC_ACQUIRE, "agent");
            asm volatile("s_waitcnt vmcnt(0)" ::: "memory");
        }
    }
    __syncthreads();
}

__global__ void __launch_bounds__(NTHREADS, 2) fwd_kernel(Args a_unused) {
    extern __shared__ __attribute__((aligned(16))) unsigned char lds_raw[];
    LAS unsigned char* lds = (LAS unsigned char*)lds_raw;
    cg::grid_group grid = cg::this_grid();
        int lo, hi; { CArgsP a0 = get_args(); lo = a0->ph_lo; hi = a0->ph_hi; }
    int ph = 0;
    const unsigned long long t_entry = PROBE_MASK ? __builtin_amdgcn_s_memrealtime() : 0ull;
    if (PROBE_MASK && blockIdx.x == 0 && threadIdx.x == 0) { CArgsP a0 = get_args(); *(volatile unsigned long long*)(a0->ws + WS_PROBE) = 0ull; }
    if (threadIdx.x < 2) ((volatile LAS unsigned*)(lds + LDS_BARST))[threadIdx.x] = 0u;
    __syncthreads();
    XcdBarrier xbar; xbar.bar = nullptr; xbar.x = 0; xbar.st = (volatile LAS unsigned*)(lds + LDS_BARST);
    bool xb_ready = false;
#define GRID_SYNC() do { if (!xb_ready) { grid.sync(); CArgsP _a = get_args(); xbar = xcd_barrier_post((unsigned*)(_a->ws + WS_BAR), (volatile LAS unsigned*)(lds + LDS_BARST)); xb_ready = true; } else { xcd_barrier(xbar); } } while (0)
#ifndef ONLY_KIND
#define ONLY_KIND -1
#endif
#define PHASE_BEGIN(kind) if ((ONLY_KIND < 0 || ONLY_KIND == (kind)) && ph >= lo && ph < hi) { CArgsP a = get_args(); unsigned char* ws = a->ws; float* modbuf = (float*)(ws + WS_MOD); (void)modbuf; const int t = tid_opaque(), lane = t & 63, wave = __builtin_amdgcn_readfirstlane(t >> 6); const int G = gridDim.x, bx = blockIdx.x; const int gw = bx * NWAVES + wave, NGW = G * NWAVES; (void)lane; (void)gw; (void)NGW; \
    unsigned long long _pt0 = 0; const bool _pon = PROBE_MASK && ((PROBE_MASK >> (kind)) & 1u) && bx == 0 && t == 0; if (_pon) _pt0 = __builtin_amdgcn_s_memrealtime();
#define PHASE_END   if (ph + 1 < hi) { GRID_SYNC(); } if (_pon) { *(volatile unsigned long long*)(ws + WS_PROBE) += __builtin_amdgcn_s_memrealtime() - _pt0; } } ++ph;

    PHASE_BEGIN(0)
        for (int i = bx * NTHREADS + t; i < M * 2; i += G * NTHREADS) ((float*)(ws + WS_LNST))[i] = 0.f;
        for (int i = bx * NTHREADS + t; i < 6 * F2; i += G * NTHREADS) ((float*)(ws + WS_BIAS))[i] = 0.f;
        for (int i = bx * NTHREADS + t; i < 4 * M; i += G * NTHREADS) ((float*)(ws + WS_ROWSS))[i] = 0.f;
        if (bx == 0) for (int i = t; i < XCD_BAR_WORDS; i += NTHREADS) ((unsigned*)(ws + WS_BAR))[i] = 0u;
        for (int tk = bx; tk < 768; tk += G) p0_gemv_task(a, lds, tk);
    PHASE_END
    PHASE_BEGIN(1)
        for (int i = bx * NTHREADS + t; i < 3 * NB * D; i += G * NTHREADS) { const int site = i / (NB * D), b = (i / D) % NB, k = i % D;
            const float gg = site == 0 ? a->in[5][k] : site == 1 ? a->in[4][D + k] : a->in[5][D + k];
            const float sc = site == 0 ? modbuf[b * D6 + 4 * D + k] : site == 1 ? modbuf[(3 + b) * D6 + D + k] : modbuf[(3 + b) * D6 + 4 * D + k];
            ((float*)(ws + WS_GP))[i] = gg * (1.f + sc); }
        for (int m0 = gw; m0 < MU; m0 += 4 * NGW) {
            const float* src[4]; const float* sh[4]; void* dst[4]; bool valid[4];
#pragma unroll
            for (int k = 0; k < 4; ++k) { const int mm = m0 + k * NGW; valid[k] = mm < MU; const int m = valid[k] ? mm : MU - 1; const int b = m / LT, j = m % LT;
                src[k] = j < CTXL ? a->in[2] + ((size_t)b * CTXL + j) * D : a->in[0] + ((size_t)b * SEQ + (j - CTXL)) * D;
                sh[k] = modbuf + (j < CTXL ? 2 : b) * D6; dst[k] = (bf16_t*)(ws + WS_A0) + (size_t)m * D; }
            norm_rows<false, 4>(src, a->in[4], sh, dst, valid, lane); }
        __syncthreads();
        p0_transpose_all<1>(a, lds, bx, G, TRC_END - 512);
    PHASE_END
    PHASE_BEGIN(2)
        pg8::Gemm g{(const bf16_t*)(ws + WS_A0), (const bf16_t*)(ws + WS_WIN), MU, D, D, D}; pg8::StaticOrder S; S.init(MU, D, G, bx);
        pg8::EpiF32 E{nullptr, D, (bf16_t*)(ws + WS_UB)};
        pg8::gemm_phase<pg8::EpiF32, true, true>(lds, g, S, E);
        if (bx >= 16) { __syncthreads(); p0_transpose_all<0>(a, lds, TRC_UP1_B + (bx - 16), G - 16, TRC_UP1_E);
            for (int idx = (bx - 16) * NTHREADS + t; idx < 2 * NG * NP; idx += (G - 16) * NTHREADS) p0_s5_tables(a, idx);
            for (int w = (bx - 16) * NTHREADS + t; w < 2 * NG * NP * 4; w += (G - 16) * NTHREADS) p0_s5_kend(a, w >> 2, w & 3); }
    PHASE_END
    PHASE_BEGIN(3)
        s5_passA(a, gw, NGW, lane);
    PHASE_END
    PHASE_BEGIN(4)
        if (t < 128) {
            const f32x2* lamT = (const f32x2*)(ws + WS_LAMT);
            for (int idx = bx * 128 + t; idx < 2 * NG * 2 * NP; idx += G * 128) {
                const int p = idx & 63, b = (idx >> 6) & 1, gd = idx >> 7;
                const f32x2 lt = lamT[gd * 64 + p]; float sr = 0.f, si = 0.f;
                const f32x2* e = (const f32x2*)((const float*)(ws + WS_E) + ((size_t)gd * NCOL + b * 128) * 128) + p;
                f32x2* so = (f32x2*)((float*)(ws + WS_SI) + ((size_t)gd * NCOL + b * 128) * 128) + p;
#pragma unroll 8
                for (int c = 0; c < 128; ++c) { so[c * 64] = (f32x2){sr, si}; const f32x2 ev = e[c * 64];
                    const float nr = lt.x * sr - lt.y * si + ev.x, ni = lt.x * si + lt.y * sr + ev.y; sr = nr; si = ni; }
            }
        }
    PHASE_END
    PHASE_BEGIN(5)
        s5_pass<true>(a, lds, gw, NGW, lane);
    PHASE_END
    PHASE_BEGIN(6)
        const bf16_t* UBp = (const bf16_t*)(ws + WS_UB); const u32x4* YF = (const u32x4*)(ws + WS_YF); const u32x4* YR = (const u32x4*)(ws + WS_YR);
        const float* dsk = a->in[20]; u32x4* Gm = (u32x4*)(ws + WS_G);
        for (int i = bx * NTHREADS + t; i < M * (D / 8); i += G * NTHREADS) {
            const int m = i >> 8, c8 = i & 255, b = m >> 12, tt = m & 4095;
            const u32x4 u = __builtin_nontemporal_load((const u32x4*)(UBp + ((size_t)b * LT + CTXL + tt) * D + 8 * c8));
            const u32x4 yf = __builtin_nontemporal_load(YF + i), yr = __builtin_nontemporal_load(YR + i); const f32x4 d0 = ((const f32x4*)dsk)[2 * c8], d1 = ((const f32x4*)dsk)[2 * c8 + 1];
            u32x4 w;
            w.x = pk2(gelu_tanh_f(d0.x * bf_lo(u.x) + bf_lo(yf.x) + bf_lo(yr.x)), gelu_tanh_f(d0.y * bf_hi(u.x) + bf_hi(yf.x) + bf_hi(yr.x)));
            w.y = pk2(gelu_tanh_f(d0.z * bf_lo(u.y) + bf_lo(yf.y) + bf_lo(yr.y)), gelu_tanh_f(d0.w * bf_hi(u.y) + bf_hi(yf.y) + bf_hi(yr.y)));
            w.z = pk2(gelu_tanh_f(d1.x * bf_lo(u.z) + bf_lo(yf.z) + bf_lo(yr.z)), gelu_tanh_f(d1.y * bf_hi(u.z) + bf_hi(yf.z) + bf_hi(yr.z)));
            w.w = pk2(gelu_tanh_f(d1.z * bf_lo(u.w) + bf_lo(yf.w) + bf_lo(yr.w)), gelu_tanh_f(d1.w * bf_hi(u.w) + bf_hi(yf.w) + bf_hi(yr.w)));
            Gm[i] = w; }
    PHASE_END
    PHASE_BEGIN(7)
        pg8::Gemm g{(const bf16_t*)(ws + WS_G), (const bf16_t*)(ws + WS_WGLU), M, D, D, D}; pg8::StaticOrder S; S.init(M, D, G, bx);
        pg8::EpiGlu E{(const bf16_t*)(ws + WS_G), (bf16_t*)(ws + WS_A2), a->in[22]};
        pg8::gemm_phase<pg8::EpiGlu, true, true>(lds, g, S, E);
    PHASE_END
    PHASE_BEGIN(8)
        pg8::Gemm g{(const bf16_t*)(ws + WS_A2), (const bf16_t*)(ws + WS_WOUT), M, D, D, D}; pg8::StaticOrder S; S.init(M, D, G, bx);
        pg8::EpiResidNorm E{a->in[0], (float*)(ws + WS_X), modbuf + 2 * D, (const float*)(ws + WS_GP), (bf16_t*)(ws + WS_A0), (float*)(ws + WS_ROWSS)};
        pg8::gemm_phase<pg8::EpiResidNorm, true, true>(lds, g, S, E);
    PHASE_END
#pragma unroll
    for (int layer = 0; layer < 2; ++layer) {
        if (layer == 1) {
            PHASE_BEGIN(10)
                pg8::Gemm g{(const bf16_t*)(ws + WS_A0), (const bf16_t*)(ws + WS_SIN_W), M, SD2, D, D}; pg8::StaticOrder S; S.init(M, SD2, G, bx);
                pg8::EpiBf16<1> E{(bf16_t*)(ws + WS_ZS), SD2, (float*)(ws + WS_LNST), 16, (const float*)(ws + WS_ROWSS) + M, (const float*)(ws + WS_BIAS) + 2 * F2};
                pg8::gemm_phase<pg8::EpiBf16<1>, true, true>(lds, g, S, E);
            PHASE_END
            PHASE_BEGIN(11)
                spatial_phase(a, lds, bx, G);
            PHASE_END
            PHASE_BEGIN(12)
                pg8::Gemm g{(const bf16_t*)(ws + WS_GT), (const bf16_t*)(ws + WS_SOUT_W), M, D, SD, SD}; pg8::StaticOrder S; S.init(M, D, G, bx);
                pg8::EpiResidNorm E{(const float*)(ws + WS_X), (float*)(ws + WS_X), modbuf + 3 * D6 + 2 * D, (const float*)(ws + WS_GP) + 2 * NB * D, (bf16_t*)(ws + WS_A0), (float*)(ws + WS_ROWSS) + 2 * M};
                pg8::gemm_phase<pg8::EpiResidNorm, true, true>(lds, g, S, E);
            PHASE_END
        }
        PHASE_BEGIN(14)
            pg8::Gemm g{(const bf16_t*)(ws + WS_A0), (const bf16_t*)(ws + (layer ? WS_UP1 : WS_UP0)), M, F2, D, D}; pg8::StaticOrder S; S.init(M, F2, G, bx);
            pg8::EpiBf16<0> E{(bf16_t*)(ws + WS_Z), F2, nullptr, 1 << 30, (const float*)(ws + WS_ROWSS) + (layer ? 2 * M : 0), (const float*)(ws + WS_BIAS) + (layer ? 4 * F2 : 0)};
            pg8::gemm_phase<pg8::EpiBf16<0>, true, true>(lds, g, S, E);
            if (bx >= 128) { __syncthreads();
                if (layer == 0) p0_transpose_all<0>(a, lds, TRC_END - 512 + (bx - 128), G - 128, TRC_END); else p0_transpose_all<0>(a, lds, TRC_DN1_B + (bx - 128), G - 128, TRC_DN1_E); }
        PHASE_END
        PHASE_BEGIN(15)
            conv_phase(a, lds, layer, bx, G);
        PHASE_END
        PHASE_BEGIN(16)
            pg8::Gemm g{(const bf16_t*)(ws + WS_A3), (const bf16_t*)(ws + (layer ? WS_DN1 : WS_DN0)), M, D, FF, FF}; pg8::StaticOrder S; S.init(M, D, G, bx);
            if (layer == 0) { pg8::EpiResidNorm E{(const float*)(ws + WS_X), (float*)(ws + WS_X), modbuf + 5 * D, (const float*)(ws + WS_GP) + NB * D, (bf16_t*)(ws + WS_A0), (float*)(ws + WS_ROWSS) + M};
                pg8::gemm_phase<pg8::EpiResidNorm, true, true>(lds, g, S, E); }
            else { pg8::EpiResid E{(const float*)(ws + WS_X), (float*)(ws + WS_X), modbuf + 3 * D6 + 5 * D, (float*)(ws + WS_ROWSS) + 3 * M};
                pg8::gemm_phase<pg8::EpiResid, true, true>(lds, g, S, E); }
        PHASE_END
    }
    PHASE_BEGIN(17)
        { const f32x4* xp = (const f32x4*)(ws + WS_X); const float* rs = (const float*)(ws + WS_ROWSS) + 3 * M; const f32x4* gp = (const f32x4*)a->in[30]; f32x4* op = (f32x4*)a->out;
#pragma unroll 8
          for (int i = bx * NTHREADS + t; i < M * (D / 4); i += G * NTHREADS) { const float rstd = __builtin_amdgcn_rsqf(rs[i >> 9] * (1.f / D) + 1e-6f); op[i] = __builtin_nontemporal_load(xp + i) * rstd * gp[i & 511]; } }
        if (PROBE_MASK) { GRID_SYNC(); }
    PHASE_END
    if (PROBE_MASK) {
        CArgsP a = get_args(); unsigned char* ws = a->ws; const int t = tid_opaque(), bx = blockIdx.x, G = gridDim.x;
        if ((PROBE_MASK >> 20) & 1u) {
            unsigned long long t0 = 0; if (bx == 0 && t == 0) t0 = __builtin_amdgcn_s_memrealtime();
            f32x4 acc4 = {0.f, 0.f, 0.f, 0.f}; const f32x4* xp = (const f32x4*)(ws + WS_X);
#pragma unroll 8
            for (int i = bx * NTHREADS + t; i < M * (D / 4); i += G * NTHREADS) acc4 += xp[i];
            ((float*)(ws + WS_PROBE + 65536))[bx * NTHREADS + t] = acc4.x + acc4.y + acc4.z + acc4.w;
            GRID_SYNC();
            if (bx == 0 && t == 0) *(volatile unsigned long long*)(ws + WS_PROBE) += __builtin_amdgcn_s_memrealtime() - t0;
        }
        if ((PROBE_MASK >> 21) & 1u) {
            unsigned long long t0 = 0; if (bx == 0 && t == 0) t0 = __builtin_amdgcn_s_memrealtime();
            f32x4* zp = (f32x4*)(ws + WS_ZS); const f32x4 v = {1.f, 2.f, 3.f, (float)t};
#pragma unroll 8
            for (int i = bx * NTHREADS + t; i < M * (D / 4); i += G * NTHREADS) zp[i] = v;
            GRID_SYNC();
            if (bx == 0 && t == 0) *(volatile unsigned long long*)(ws + WS_PROBE) += __builtin_amdgcn_s_memrealtime() - t0;
        }
        if ((PROBE_MASK >> 22) & 1u) {
            unsigned long long t0 = 0; if (bx == 0 && t == 0) t0 = __builtin_amdgcn_s_memrealtime();
            f32x4* zp = (f32x4*)(ws + WS_ZS); const f32x4* xp = (const f32x4*)(ws + WS_X);
#pragma unroll 8
            for (int i = bx * NTHREADS + t; i < M * (D / 4); i += G * NTHREADS) zp[i] = xp[i];
            GRID_SYNC();
            if (bx == 0 && t == 0) *(volatile unsigned long long*)(ws + WS_PROBE) += __builtin_amdgcn_s_memrealtime() - t0;
        }
        if ((PROBE_MASK >> 19) & 1u) {
            unsigned long long t0 = 0; if (bx == 0 && t == 0) t0 = __builtin_amdgcn_s_memrealtime();
            for (int i = 0; i < 10; ++i) { GRID_SYNC(); }
            if (bx == 0 && t == 0) *(volatile unsigned long long*)(ws + WS_PROBE) += __builtin_amdgcn_s_memrealtime() - t0;
        }
        if ((PROBE_MASK >> 18) & 1u) { if (bx == 0 && t == 0) *(volatile unsigned long long*)(ws + WS_PROBE) += __builtin_amdgcn_s_memrealtime() - t_entry; }
        grid.sync();
        const unsigned long long tk = *(volatile unsigned long long*)(ws + WS_PROBE); const float pd = sqrtf((float)tk * 1e-10f);
        for (int i = bx * NTHREADS + t; i < M * (D / 4); i += G * NTHREADS) { f32x4 y = ((f32x4*)a->out)[i]; y.x += pd; y.y -= pd; y.z += pd; y.w -= pd; ((f32x4*)a->out)[i] = y; }
    }
}
constexpr int N_PHASES = 19;

extern "C" void kernel_launch(void* const* d_in, const int* in_sizes, int n_in, void* d_out, int out_size, void* d_ws, size_t ws_size, hipStream_t stream) {
    static int grid = 0;
    if (grid == 0) {
        if (n_in != 31 || out_size != M * D || ws_size < WS_END) { fprintf(stderr, "kernel_launch: unexpected shapes (n_in %d out %d ws %zu need %zu)\n", n_in, out_size, ws_size, (size_t)WS_END); grid = -1; return; }
        int dev = 0, cus = 0, per_cu = 0;
        hipGetDevice(&dev); hipDeviceGetAttribute(&cus, hipDeviceAttributeMultiprocessorCount, dev);
        if (hipFuncSetAttribute((const void*)fwd_kernel, hipFuncAttributeMaxDynamicSharedMemorySize, LDS_BYTES) != hipSuccess) { fprintf(stderr, "kernel_launch: hipFuncSetAttribute failed\n"); grid = -1; return; }
        if (hipOccupancyMaxActiveBlocksPerMultiprocessor(&per_cu, (const void*)fwd_kernel, NTHREADS, LDS_BYTES) != hipSuccess || per_cu < 1) { fprintf(stderr, "kernel_launch: occupancy query gave %d\n", per_cu); per_cu = 1; }
        (void)hipGetLastError();
        grid = cus * 1;
    }
    if (grid < 0) return;
    Args a{};
    for (int i = 0; i < 31; ++i) a.in[i] = (const float*)d_in[i];
    a.out = (float*)d_out; a.ws = (unsigned char*)d_ws; a.ph_lo = 0; a.ph_hi = N_PHASES;
    void* args[] = {&a};
    hipError_t e = hipLaunchCooperativeKernel((const void*)fwd_kernel, dim3(grid), dim3(NTHREADS), args, LDS_BYTES, stream);
    if (e != hipSuccess) fprintf(stderr, "kernel_launch: cooperative launch failed: %s (grid %d)\n", hipGetErrorString(e), grid);
}
```

```cpp
#include <hip/hip_runtime.h>
#include <hip/hip_cooperative_groups.h>
#include <cstdio>
#include <cstdint>
namespace cg = cooperative_groups;

#ifndef PROBE_MASK
#define PROBE_MASK 0u
#endif
#define LAS __attribute__((address_space(3)))
typedef unsigned short bf16_t;
typedef short bf16x8 __attribute__((ext_vector_type(8)));
typedef float f32x2 __attribute__((ext_vector_type(2)));
typedef float f32x4 __attribute__((ext_vector_type(4)));
typedef float f32x16 __attribute__((ext_vector_type(16)));
typedef unsigned u32x2 __attribute__((ext_vector_type(2)));
typedef unsigned u32x4 __attribute__((ext_vector_type(4)));
typedef __bf16 bf16x2v __attribute__((ext_vector_type(2)));

constexpr int D = 2048, NB = 2, SEQ = 4096, CTXL = 256, M = NB * SEQ, LT = SEQ + CTXL, MU = NB * LT;
constexpr int NG = 128, NP = 64, NH = 16, TC = 34, NCOL = 256;
constexpr int F2 = 11264, FF = 5632, SD = 4096, SD2 = 8192, D6 = 12288;
constexpr int NTHREADS = 512, NWAVES = 8;
constexpr int LDS_BYTES = 147456;

constexpr size_t MiB = 1u << 20;
constexpr size_t WS_MOD = 0;
constexpr size_t WS_LAM = 512 * 1024;
constexpr size_t WS_LAMT = 768 * 1024;
constexpr size_t WS_BCAT = 1 * MiB;
constexpr size_t WS_CCAT = 2 * MiB;
constexpr size_t WS_LNST = 3 * MiB;
constexpr size_t WS_PROBE = 4 * MiB;
constexpr size_t WS_BIAS = 6 * MiB;
constexpr size_t WS_ROWSS = 7 * MiB;
constexpr size_t WS_GP = 7 * MiB + 512 * 1024;
constexpr size_t WS_BAR = 5 * MiB;
constexpr int LDS_BARST = LDS_BYTES - 64;
constexpr size_t WS_W = 16 * MiB;
constexpr size_t WS_WIN = WS_W, WS_WGLU = WS_WIN + 8 * MiB, WS_WOUT = WS_WGLU + 8 * MiB;
constexpr size_t WS_UP0 = WS_WOUT + 8 * MiB, WS_UP1 = WS_UP0 + 44 * MiB;
constexpr size_t WS_DN0 = WS_UP1 + 44 * MiB, WS_DN1 = WS_DN0 + 22 * MiB;
constexpr size_t WS_SIN_W = WS_DN1 + 22 * MiB, WS_SOUT_W = WS_SIN_W + 32 * MiB;
constexpr size_t WS_X = WS_SOUT_W + 16 * MiB;
constexpr size_t WS_A0 = WS_X + 64 * MiB;
constexpr size_t WS_G = WS_A0 + 34 * MiB;
constexpr size_t WS_A2 = WS_G + 32 * MiB;
constexpr size_t WS_BIG1 = WS_A2 + 32 * MiB;
constexpr size_t WS_U = WS_BIG1;
constexpr size_t WS_YF = WS_BIG1 + 68 * MiB;
constexpr size_t WS_Z = WS_BIG1;
constexpr size_t WS_ZS = WS_BIG1;
constexpr size_t WS_BIG2 = WS_BIG1 + 176 * MiB;
constexpr size_t WS_YR = WS_BIG2;
constexpr size_t WS_E = WS_BIG2 + 64 * MiB;
constexpr size_t WS_SI = WS_BIG2 + 96 * MiB;
constexpr size_t WS_A3 = WS_BIG2;
constexpr size_t WS_GT = WS_BIG2;
constexpr size_t WS_UB = WS_BIG2 + 128 * MiB;
constexpr size_t WS_KEND = WS_UB + 34 * MiB;
constexpr size_t WS_END = WS_KEND + 36 * MiB;

struct Args { const float* in[31]; float* out; unsigned char* ws; int ph_lo, ph_hi; };
typedef const Args __attribute__((address_space(4)))* CArgsP;
__device__ __forceinline__ CArgsP get_args() { CArgsP p = (CArgsP)__builtin_amdgcn_kernarg_segment_ptr(); asm volatile("" : "+s"(p)); return p; }

__device__ __forceinline__ void store16_wt(void* p, f32x4 v) { asm volatile("global_store_dwordx4 %0, %1, off sc1" :: "v"(p), "v"(v) : "memory"); }
__device__ __forceinline__ int launder_i(int v) { asm volatile("" : "+v"(v)); return v; }
__device__ __forceinline__ int tid_opaque() { int t = threadIdx.x; asm volatile("" : "+v"(t)); return t; }
__device__ __forceinline__ unsigned pk2(float lo, float hi) { f32x2 v = {lo, hi}; bf16x2v r = __builtin_convertvector(v, bf16x2v); return __builtin_bit_cast(unsigned, r); }
__device__ __forceinline__ bf16_t f2bf(float f) { return (bf16_t)(pk2(f, 0.f) & 0xffffu); }
__device__ __forceinline__ float bf_lo(unsigned w) { return __builtin_bit_cast(float, w << 16); }
__device__ __forceinline__ float bf_hi(unsigned w) { return __builtin_bit_cast(float, w & 0xffff0000u); }
__device__ __forceinline__ float shfl_xor_l(float v, int m, int lane) { return __builtin_bit_cast(float, __builtin_amdgcn_ds_bpermute((lane ^ m) << 2, __builtin_bit_cast(int, v))); }
__device__ __forceinline__ float wave_sum(float v, int lane) {
#pragma unroll
    for (int o = 1; o < 64; o <<= 1) v += shfl_xor_l(v, o, lane);
    return v;
}
__device__ __forceinline__ float sigmoid_f(float x) { return __builtin_amdgcn_rcpf(1.f + __expf(-x)); }
__device__ __forceinline__ float silu_f(float x) { return x * sigmoid_f(x); }
__device__ __forceinline__ float gelu_tanh_f(float x) { const float t = 1.5957691216f * (x + 0.044715f * x * x * x); return x * sigmoid_f(t); }

namespace pg8 {
constexpr int BM = 256, BK = 64, HALF = 128, HTB = HALF * BK * 2, STAGE_BYTES = 8 * HTB, NXCD = 8, WGM = 8;
__device__ __forceinline__ int lds_byte(int r, int c) { const int st = (r >> 4) * 2 + (c >> 5), rr = r & 15, cc = c & 31, ob = rr * 64 + cc * 2; return st * 1024 + (ob ^ (((ob >> 9) & 1) << 5)); }
__device__ __forceinline__ void stage_rc(int b, int& R, int& C) { const int st = b / 1024, sb = b % 1024, swz = sb ^ (((sb >> 9) & 1) << 5); R = (st >> 1) * 16 + swz / 64; C = (st & 1) * 32 + (swz % 64) / 2; }
__device__ __forceinline__ int perm32(int rho) { const int n = rho >> 4, i = rho & 15; return 8 * (i >> 2) + 4 * n + (i & 3); }
struct Unit { int pm, pn; };
struct Gemm { const bf16_t* A; const bf16_t* Bt; int M, N, K, ld; };
struct StaticOrder {
    int nM, nN, nwg, G, c;
    __device__ void init(int M_, int N_, int G_, int c_) { nM = M_ / BM; nN = N_ / BM; nwg = nM * nN; G = G_; c = c_; }
    __device__ bool next(int i, Unit& u) const {
        const long L = (long)i * G + c; if (L >= nwg) return false;
        int wgid = (int)L; { const int q = nwg / NXCD, r = nwg % NXCD, xcd = wgid % NXCD, off = wgid / NXCD; wgid = (xcd < r ? xcd * (q + 1) : r * (q + 1) + (xcd - r) * q) + off; }
        const int nig = WGM * nN, gid = wgid / nig, fm = gid * WGM, gsz = (nM - fm) < WGM ? (nM - fm) : WGM;
        u.pm = fm + ((wgid % nig) % gsz); u.pn = (wgid % nig) / gsz; return true;
    }
};

template <class Epi, bool ALIGN_EPI, bool SP2>
__device__ __forceinline__ void gemm_phase(LAS unsigned char* lds, const Gemm g, const StaticOrder& S, const Epi& E) {
    const int tid = tid_opaque(), wid = __builtin_amdgcn_readfirstlane(tid >> 6), lane = tid & 63, wr = wid >> 2, wc = wid & 3, fr = lane & 15, fq = lane >> 4;
    const int K = g.ld, nt = g.K / BK;
    unsigned voffA[2], voffB[2];
#pragma unroll
    for (int i = 0; i < 2; ++i) { int R, C; stage_rc(tid * 16 + i * 8192, R, C); const int Rb = Epi::PERM ? ((R & ~31) + perm32(R & 31)) : R;
        voffA[i] = (unsigned)(R * K + C) * 2u; voffB[i] = (unsigned)(Rb * K + C) * 2u; }
    const size_t kstep = (size_t)(BK * 2);
    const size_t hstep = (size_t)HALF * K * 2;
    const size_t tstep = 2 * hstep;
    const unsigned ldsw = (unsigned)wid * 1024u;
    const int aoff = lds_byte(wr * 64 + fr, fq * 8), boff = lds_byte(wc * 32 + fr, fq * 8);
#define PG8_SA(b, h) (((b) * 2 + (h)) * HTB)
#define PG8_SB(b, h) ((4 + (b) * 2 + (h)) * HTB)
#define PG8_STAGE(bufoff, gbase, voff) do { _Pragma("unroll") for (int _i = 0; _i < 2; ++_i) \
        __builtin_amdgcn_global_load_lds((const unsigned*)((const char*)(gbase) + (voff)[_i]), (LAS unsigned*)(lds + (bufoff) + ldsw + _i * 8192), 16, 0, 0); } while (0)
#define PG8_LDA(dst, b, h) do { _Pragma("unroll") for (int m = 0; m < 4; ++m) _Pragma("unroll") for (int k = 0; k < 2; ++k) dst[m][k] = *(const LAS bf16x8*)(lds + PG8_SA(b, h) + aoff + m * 2048 + k * 1024); } while (0)
#define PG8_LDB(dst, b, h) do { _Pragma("unroll") for (int n = 0; n < 2; ++n) _Pragma("unroll") for (int k = 0; k < 2; ++k) dst[n][k] = *(const LAS bf16x8*)(lds + PG8_SB(b, h) + boff + n * 2048 + k * 1024); } while (0)
#define PG8_MMA(ai, bj, At, Bt) do { __builtin_amdgcn_s_setprio(1); _Pragma("unroll") for (int m = 0; m < 4; ++m) _Pragma("unroll") for (int n = 0; n < 2; ++n) _Pragma("unroll") for (int k = 0; k < 2; ++k) \
        acc[ai][bj][m][n] = __builtin_amdgcn_mfma_f32_16x16x32_bf16(Bt[n][k], At[m][k], acc[ai][bj][m][n], 0, 0, 0); __builtin_amdgcn_s_setprio(0); } while (0)
#define PG8_WAIT_V(n) asm volatile("s_waitcnt vmcnt(" #n ")" ::: "memory")
#define PG8_WAIT_L(n) asm volatile("s_waitcnt lgkmcnt(" #n ")" ::: "memory")
#define PG8_BAR __builtin_amdgcn_s_barrier()
#define PG8_SCHED __builtin_amdgcn_sched_barrier(0)
    Unit cur, nxt; int ui = 0;
    if (!S.next(0, cur)) return;
    f32x4 acc[2][2][4][2];
#pragma unroll
    for (int a = 0; a < 2; ++a)
#pragma unroll
        for (int b = 0; b < 2; ++b)
#pragma unroll
            for (int m = 0; m < 4; ++m)
#pragma unroll
                for (int n = 0; n < 2; ++n) acc[a][b][m][n] = (f32x4){0.f, 0.f, 0.f, 0.f};
    bf16x8 At[4][2], B0[2][2], B1[2][2];
    const char* cA = (const char*)g.A + (size_t)cur.pm * tstep; const char* cB = (const char*)g.Bt + (size_t)cur.pn * tstep;
    if constexpr (SP2) {
        PG8_STAGE(PG8_SB(0, 0), cB, voffB); PG8_STAGE(PG8_SB(0, 1), cB + hstep, voffB); PG8_STAGE(PG8_SA(0, 0), cA, voffA); PG8_STAGE(PG8_SA(0, 1), cA + hstep, voffA);
        if (wr == 1) PG8_BAR;
        PG8_WAIT_V(2); PG8_BAR;
        PG8_STAGE(PG8_SB(1, 0), cB + kstep, voffB); PG8_STAGE(PG8_SA(1, 0), cA + kstep, voffA); PG8_STAGE(PG8_SB(1, 1), cB + hstep + kstep, voffB);
        PG8_WAIT_V(6); PG8_BAR;
    } else {
        PG8_STAGE(PG8_SB(0, 0), cB, voffB); PG8_STAGE(PG8_SA(0, 0), cA, voffA); PG8_STAGE(PG8_SB(0, 1), cB + hstep, voffB); PG8_STAGE(PG8_SA(0, 1), cA + hstep, voffA);
        if (wr == 1) PG8_BAR;
        PG8_WAIT_V(4); PG8_BAR;
        PG8_STAGE(PG8_SB(1, 0), cB + kstep, voffB); PG8_STAGE(PG8_SA(1, 0), cA + kstep, voffA); PG8_STAGE(PG8_SB(1, 1), cB + hstep + kstep, voffB);
        PG8_WAIT_V(6); PG8_BAR;
    }
    for (;;) {
        const bool has_next = S.next(ui + 1, nxt);
        const char* nA = has_next ? (const char*)g.A + (size_t)nxt.pm * tstep : cA; const char* nB = has_next ? (const char*)g.Bt + (size_t)nxt.pn * tstep : cB;
        for (int t = 0; t < nt; t += 2) {
            const bool last = (t == nt - 2);
            const char* a1 = cA + (size_t)(t + 1) * kstep;
            const char* a2 = last ? nA : cA + (size_t)(t + 2) * kstep; const char* b2 = last ? nB : cB + (size_t)(t + 2) * kstep;
            const char* a3 = a2 + kstep; const char* b3 = b2 + kstep;
            if constexpr (SP2) {
            PG8_LDB(B0, 0, 0); PG8_LDB(B1, 0, 1); PG8_SCHED; PG8_LDA(At, 0, 0); PG8_STAGE(PG8_SA(1, 1), a1 + hstep, voffA);
            PG8_WAIT_V(8); PG8_WAIT_L(0); PG8_BAR; PG8_MMA(0, 0, At, B0); PG8_MMA(0, 1, At, B1); PG8_BAR; PG8_SCHED;
            PG8_LDA(At, 0, 1); PG8_STAGE(PG8_SB(0, 0), b2, voffB); PG8_STAGE(PG8_SB(0, 1), b2 + hstep, voffB); PG8_STAGE(PG8_SA(0, 0), a2, voffA);
            PG8_WAIT_V(8); PG8_WAIT_L(0); PG8_BAR; PG8_MMA(1, 0, At, B0); PG8_MMA(1, 1, At, B1); PG8_BAR; PG8_SCHED;
            PG8_LDB(B0, 1, 0); PG8_LDB(B1, 1, 1); PG8_SCHED; PG8_LDA(At, 1, 0); PG8_STAGE(PG8_SA(0, 1), a2 + hstep, voffA);
            PG8_WAIT_V(8); PG8_WAIT_L(0); PG8_BAR; PG8_MMA(0, 0, At, B0); PG8_MMA(0, 1, At, B1); PG8_BAR; PG8_SCHED;
            PG8_LDA(At, 1, 1); PG8_STAGE(PG8_SB(1, 0), b3, voffB); PG8_STAGE(PG8_SB(1, 1), b3 + hstep, voffB); PG8_STAGE(PG8_SA(1, 0), a3, voffA);
            PG8_WAIT_V(8); PG8_WAIT_L(0); PG8_BAR; PG8_MMA(1, 0, At, B0); PG8_MMA(1, 1, At, B1); PG8_BAR; PG8_SCHED;
            } else {
            PG8_LDB(B0, 0, 0); PG8_SCHED; PG8_LDA(At, 0, 0); PG8_STAGE(PG8_SA(1, 1), a1 + hstep, voffA);
            PG8_WAIT_L(8); PG8_BAR; PG8_WAIT_L(0); PG8_MMA(0, 0, At, B0); PG8_BAR; PG8_SCHED;
            PG8_LDB(B1, 0, 1); PG8_STAGE(PG8_SB(0, 0), b2, voffB);
            PG8_BAR; PG8_WAIT_L(0); PG8_MMA(0, 1, At, B1); PG8_BAR;
            PG8_LDA(At, 0, 1); PG8_STAGE(PG8_SA(0, 0), a2, voffA);
            PG8_BAR; PG8_WAIT_L(0); PG8_MMA(1, 0, At, B0); PG8_BAR; PG8_SCHED;
            PG8_STAGE(PG8_SB(0, 1), b2 + hstep, voffB);
            PG8_WAIT_V(6); PG8_BAR; PG8_MMA(1, 1, At, B1); PG8_BAR;
            PG8_LDB(B0, 1, 0); PG8_SCHED; PG8_LDA(At, 1, 0); PG8_STAGE(PG8_SA(0, 1), a2 + hstep, voffA);
            PG8_WAIT_L(8); PG8_BAR; PG8_WAIT_L(0); PG8_MMA(0, 0, At, B0); PG8_BAR; PG8_SCHED;
            PG8_LDB(B1, 1, 1); PG8_STAGE(PG8_SB(1, 0), b3, voffB);
            PG8_BAR; PG8_WAIT_L(0); PG8_MMA(0, 1, At, B1); PG8_BAR;
            PG8_LDA(At, 1, 1); PG8_STAGE(PG8_SA(1, 0), a3, voffA);
            PG8_BAR; PG8_WAIT_L(0); PG8_MMA(1, 0, At, B0); PG8_BAR; PG8_SCHED;
            PG8_STAGE(PG8_SB(1, 1), b3 + hstep, voffB);
            PG8_WAIT_V(6); PG8_BAR; PG8_MMA(1, 1, At, B1); PG8_BAR;
            }
        }
        if constexpr (ALIGN_EPI) { if (wr == 0) PG8_BAR; }
        E(acc, cur, wr, wc, fr, fq);
        if (!has_next) break;
#pragma unroll
        for (int a = 0; a < 2; ++a)
#pragma unroll
            for (int b = 0; b < 2; ++b)
#pragma unroll
                for (int m = 0; m < 4; ++m)
#pragma unroll
                    for (int n = 0; n < 2; ++n) acc[a][b][m][n] = (f32x4){0.f, 0.f, 0.f, 0.f};
        cur = nxt; cA = nA; cB = nB; ++ui;
        if constexpr (ALIGN_EPI) { if (wr == 1) PG8_BAR; }
    }
    PG8_WAIT_V(0);
    if constexpr (!ALIGN_EPI) { if (wr == 0) PG8_BAR; }
    PG8_BAR;
#undef PG8_SA
#undef PG8_SB
#undef PG8_STAGE
#undef PG8_LDA
#undef PG8_LDB
#undef PG8_MMA
#undef PG8_WAIT_V
#undef PG8_WAIT_L
#undef PG8_BAR
#undef PG8_SCHED
}

typedef f32x4 AccT[2][2][4][2];
struct EpiF32 {
    static constexpr bool PERM = false;
    float* C; int ldc; bf16_t* Cb;
    __device__ __forceinline__ void operator()(const AccT& acc, const Unit& u, int wr, int wc, int fr, int fq) const {
        const int row0 = u.pm * BM + wr * 64 + fr, col0 = u.pn * BM + wc * 32 + 4 * fq;
#pragma unroll
        for (int ai = 0; ai < 2; ++ai)
#pragma unroll
            for (int m = 0; m < 4; ++m) { float* rowp = C + (size_t)(row0 + ai * HALF + m * 16) * ldc + col0;
#pragma unroll
                for (int bj = 0; bj < 2; ++bj)
#pragma unroll
                    for (int n = 0; n < 2; ++n) { const f32x4 v = acc[ai][bj][m][n]; if (C) *(f32x4*)(rowp + bj * HALF + n * 16) = v;
                        u32x2 w; w.x = pk2(v.x, v.y); w.y = pk2(v.z, v.w); *(u32x2*)(Cb + (size_t)(row0 + ai * HALF + m * 16) * ldc + col0 + bj * HALF + n * 16) = w; } }
    }
};
struct EpiF32Atomic {
    static constexpr bool PERM = false;
    float* C; int ldc;
    __device__ __forceinline__ void operator()(const AccT& acc, const Unit& u, int wr, int wc, int fr, int fq) const {
        const int row0 = u.pm * BM + wr * 64 + fr, col0 = u.pn * BM + wc * 32 + 4 * fq;
#pragma unroll
        for (int ai = 0; ai < 2; ++ai)
#pragma unroll
            for (int m = 0; m < 4; ++m) { float* rowp = C + (size_t)(row0 + ai * HALF + m * 16) * ldc + col0;
#pragma unroll
                for (int bj = 0; bj < 2; ++bj)
#pragma unroll
                    for (int n = 0; n < 2; ++n)
#pragma unroll
                        for (int j = 0; j < 4; ++j) atomicAdd(rowp + bj * HALF + n * 16 + j, acc[ai][bj][m][n][j]); }
    }
};
struct EpiResid {
    static constexpr bool PERM = false;
    const float* base; float* out; const float* gate0; float* rowss;
    __device__ __forceinline__ void operator()(const AccT& acc, const Unit& u, int wr, int wc, int fr, int fq) const {
        const int row0 = u.pm * BM + wr * 64 + fr, col0 = u.pn * BM + wc * 32 + 4 * fq;
        const float* gate = gate0 + (u.pm >> 4) * D6;
        f32x4 gv[2][2];
#pragma unroll
        for (int bj = 0; bj < 2; ++bj)
#pragma unroll
            for (int n = 0; n < 2; ++n) gv[bj][n] = *(const f32x4*)(gate + col0 + bj * HALF + n * 16);
#pragma unroll
        for (int ai = 0; ai < 2; ++ai)
#pragma unroll
            for (int m = 0; m < 4; ++m) { const size_t off = (size_t)(row0 + ai * HALF + m * 16) * D + col0; float ss = 0.f;
#pragma unroll
                for (int bj = 0; bj < 2; ++bj)
#pragma unroll
                    for (int n = 0; n < 2; ++n) { const f32x4 bs = *(const f32x4*)(base + off + bj * HALF + n * 16); const f32x4 xo = bs + gv[bj][n] * acc[ai][bj][m][n]; *(f32x4*)(out + off + bj * HALF + n * 16) = xo;
                        ss += (xo.x * xo.x + xo.y * xo.y) + (xo.z * xo.z + xo.w * xo.w); }
                if (rowss) { const int ln = fr + 16 * fq; ss += shfl_xor_l(ss, 16, ln); ss += shfl_xor_l(ss, 32, ln); if (fq == 0) atomicAdd(rowss + row0 + ai * HALF + m * 16, ss); }
                asm volatile("" ::: "memory"); }
    }
};
struct EpiResidNorm {
    static constexpr bool PERM = true;
    const float* base; float* out; const float* gate0; const float* gp0; bf16_t* XG; float* rowss;
    __device__ __forceinline__ void operator()(const AccT& acc, const Unit& u, int wr, int wc, int fr, int fq) const {
        const int row0 = u.pm * BM + wr * 64 + fr, col0 = u.pn * BM + wc * 32 + 8 * fq, bb = u.pm >> 4, ln = fr + 16 * fq;
        const float* gate = gate0 + bb * D6; const float* gp = gp0 + bb * D;
        f32x4 gv[2][2], pv[2][2];
#pragma unroll
        for (int bj = 0; bj < 2; ++bj)
#pragma unroll
            for (int n = 0; n < 2; ++n) { gv[bj][n] = *(const f32x4*)(gate + col0 + bj * HALF + 4 * n); pv[bj][n] = *(const f32x4*)(gp + col0 + bj * HALF + 4 * n); }
#pragma unroll
        for (int ai = 0; ai < 2; ++ai)
#pragma unroll
            for (int m = 0; m < 4; ++m) { const int row = row0 + ai * HALF + m * 16; const size_t off = (size_t)row * D + col0; float ss = 0.f;
#pragma unroll
                for (int bj = 0; bj < 2; ++bj) {
                    const f32x4 b0 = *(const f32x4*)(base + off + bj * HALF), b1 = *(const f32x4*)(base + off + bj * HALF + 4);
                    const f32x4 x0 = b0 + gv[bj][0] * acc[ai][bj][m][0], x1 = b1 + gv[bj][1] * acc[ai][bj][m][1];
                    *(f32x4*)(out + off + bj * HALF) = x0; *(f32x4*)(out + off + bj * HALF + 4) = x1;
                    ss += (x0.x * x0.x + x0.y * x0.y) + (x0.z * x0.z + x0.w * x0.w) + (x1.x * x1.x + x1.y * x1.y) + (x1.z * x1.z + x1.w * x1.w);
                    const f32x4 y0 = x0 * pv[bj][0], y1 = x1 * pv[bj][1];
                    u32x4 w; w.x = pk2(y0.x, y0.y); w.y = pk2(y0.z, y0.w); w.z = pk2(y1.x, y1.y); w.w = pk2(y1.z, y1.w);
                    *(u32x4*)(XG + off + bj * HALF) = w; }
                ss += shfl_xor_l(ss, 16, ln); ss += shfl_xor_l(ss, 32, ln);
                if (fq == 0) atomicAdd(rowss + row, ss);
                asm volatile("" ::: "memory"); }
    }
};
template <int ACT> struct EpiBf16 {
    static constexpr bool PERM = true;
    bf16_t* O; int ldc; float* stats; int stat_pn0; const float* rowss; const float* bias0;
    __device__ __forceinline__ void operator()(const AccT& acc, const Unit& u, int wr, int wc, int fr, int fq) const {
        const int row0 = u.pm * BM + wr * 64 + fr, col0 = u.pn * BM + wc * 32 + 8 * fq;
        const bool do_stats = (ACT == 1) && (u.pn >= stat_pn0);
        const float* bias = bias0 + (u.pm >> 4) * F2;
        f32x4 bv[2][2];
#pragma unroll
        for (int bj = 0; bj < 2; ++bj)
#pragma unroll
            for (int n = 0; n < 2; ++n) bv[bj][n] = *(const f32x4*)(bias + col0 + bj * HALF + 4 * n);
#pragma unroll
        for (int ai = 0; ai < 2; ++ai)
#pragma unroll
            for (int m = 0; m < 4; ++m) { const int row = row0 + ai * HALF + m * 16; bf16_t* rowp = O + (size_t)row * ldc + col0; float s = 0.f, q = 0.f;
                const float rstd = __builtin_amdgcn_rsqf(rowss[row] * (1.f / D) + 1e-6f);
#pragma unroll
                for (int bj = 0; bj < 2; ++bj) { f32x4 v0 = acc[ai][bj][m][0] * rstd + bv[bj][0], v1 = acc[ai][bj][m][1] * rstd + bv[bj][1];
                    if (ACT == 1) {
#pragma unroll
                        for (int j = 0; j < 4; ++j) { v0[j] = gelu_tanh_f(v0[j]); v1[j] = gelu_tanh_f(v1[j]); s += v0[j] + v1[j]; q += v0[j] * v0[j] + v1[j] * v1[j]; } }
                    u32x4 w; w.x = pk2(v0[0], v0[1]); w.y = pk2(v0[2], v0[3]); w.z = pk2(v1[0], v1[1]); w.w = pk2(v1[2], v1[3]);
                    *(u32x4*)(rowp + bj * HALF) = w; }
                if (ACT == 1) { if (do_stats) { const int ln = fr + 16 * fq; s += shfl_xor_l(s, 16, ln); s += shfl_xor_l(s, 32, ln); q += shfl_xor_l(q, 16, ln); q += shfl_xor_l(q, 32, ln);
                    if (fq == 0) { atomicAdd(stats + 2 * row, s); atomicAdd(stats + 2 * row + 1, q); } } } }
    }
};
struct EpiGlu {
    static constexpr bool PERM = true;
    const bf16_t* Gm; bf16_t* O; const float* bias;
    __device__ __forceinline__ void operator()(const AccT& acc, const Unit& u, int wr, int wc, int fr, int fq) const {
        const int row0 = u.pm * BM + wr * 64 + fr, col0 = u.pn * BM + wc * 32 + 8 * fq;
        f32x4 bv[2][2];
#pragma unroll
        for (int bj = 0; bj < 2; ++bj)
#pragma unroll
            for (int n = 0; n < 2; ++n) bv[bj][n] = *(const f32x4*)(bias + col0 + bj * HALF + 4 * n);
#pragma unroll
        for (int ai = 0; ai < 2; ++ai)
#pragma unroll
            for (int m = 0; m < 4; ++m) { const size_t off = (size_t)(row0 + ai * HALF + m * 16) * D + col0;
#pragma unroll
                for (int bj = 0; bj < 2; ++bj) { const f32x4 v0 = acc[ai][bj][m][0] + bv[bj][0], v1 = acc[ai][bj][m][1] + bv[bj][1];
                    const u32x4 gw = *(const u32x4*)(Gm + off + bj * HALF);
                    u32x4 w;
                    w.x = pk2(bf_lo(gw.x) * sigmoid_f(v0[0]), bf_hi(gw.x) * sigmoid_f(v0[1]));
                    w.y = pk2(bf_lo(gw.y) * sigmoid_f(v0[2]), bf_hi(gw.y) * sigmoid_f(v0[3]));
                    w.z = pk2(bf_lo(gw.z) * sigmoid_f(v1[0]), bf_hi(gw.z) * sigmoid_f(v1[1]));
                    w.w = pk2(bf_lo(gw.w) * sigmoid_f(v1[2]), bf_hi(gw.w) * sigmoid_f(v1[3]));
                    *(u32x4*)(O + off + bj * HALF) = w; } }
    }
};
}

__device__ __forceinline__ void p0_gemv_task(CArgsP a, LAS unsigned char* lds, int tk) {
    const int t = tid_opaque();
    LAS float* sv = (LAS float*)lds;
    LAS float* red = (LAS float*)(lds + 24576);
    const int l = tk / 384, n0 = (tk % 384) * 32;
    const float* c = a->in[1]; const float* cc = a->in[3];
    for (int i = t; i < 3 * D; i += NTHREADS) { const float x = i < 2 * D ? c[i] : cc[i - 2 * D]; sv[i] = silu_f(x); }
    __syncthreads();
    const int cq = t & 7, ks = t >> 3;
    const float* W = a->in[6] + (size_t)l * D * D6 + n0 + 4 * cq;
    f32x4 acc0 = {0.f, 0.f, 0.f, 0.f}, acc1 = acc0, acc2 = acc0;
#pragma unroll 8
    for (int kk = 0; kk < 32; ++kk) { const int k = ks * 32 + kk; const f32x4 w = __builtin_nontemporal_load((const f32x4*)(W + (size_t)k * D6));
        const float s0 = sv[k], s1 = sv[D + k], s2 = sv[2 * D + k]; acc0 += w * s0; acc1 += w * s1; acc2 += w * s2; }
    LAS float* rp = red + ks * 96 + cq * 12;
#pragma unroll
    for (int j = 0; j < 4; ++j) { rp[j] = acc0[j]; rp[4 + j] = acc1[j]; rp[8 + j] = acc2[j]; }
    __syncthreads();
    if (t < 96) { float s = 0.f;
#pragma unroll 8
        for (int j = 0; j < 64; ++j) s += red[j * 96 + t];
        const int q = t / 12, i = t % 12, v = i >> 2, comp = i & 3, n = n0 + 4 * q + comp;
        float* modbuf = (float*)(a->ws + WS_MOD);
        modbuf[(l * 3 + v) * D6 + n] = s + a->in[7][l * D6 + n]; }
    __syncthreads();
}

struct TMat { const float* W; bf16_t* Wt; int K, N; float* bias; const float* shift; };
__device__ __forceinline__ bool tr_decode(CArgsP a, int task, int t_end, TMat& m, int& k0, int& n0) {
    constexpr int C0 = 256, C1 = 512, C2 = 768, C3 = C2 + 1408, C4 = C3 + 1408, C5 = C4 + 704, C6 = C5 + 704, C7 = C6 + 1024, C8 = C7 + 512;
    if (task >= t_end) return false;
    int base;
    float* BI = (float*)(a->ws + WS_BIAS); const float* MD = (const float*)(a->ws + WS_MOD);
    if (task < C0) { m = {a->in[12], (bf16_t*)(a->ws + WS_WIN), D, D, nullptr, nullptr}; base = 0; }
    else if (task < C1) { m = {a->in[21], (bf16_t*)(a->ws + WS_WGLU), D, D, nullptr, nullptr}; base = C0; }
    else if (task < C2) { m = {a->in[23], (bf16_t*)(a->ws + WS_WOUT), D, D, nullptr, nullptr}; base = C1; }
    else if (task < C3) { m = {a->in[8], (bf16_t*)(a->ws + WS_UP0), D, F2, BI, MD + 3 * D}; base = C2; }
    else if (task < C4) { m = {a->in[8] + (size_t)D * F2, (bf16_t*)(a->ws + WS_UP1), D, F2, BI + 4 * F2, MD + 3 * D6 + 3 * D}; base = C3; }
    else if (task < C5) { m = {a->in[11], (bf16_t*)(a->ws + WS_DN0), FF, D, nullptr, nullptr}; base = C4; }
    else if (task < C6) { m = {a->in[11] + (size_t)FF * D, (bf16_t*)(a->ws + WS_DN1), FF, D, nullptr, nullptr}; base = C5; }
    else if (task < C7) { m = {a->in[24], (bf16_t*)(a->ws + WS_SIN_W), D, SD2, BI + 2 * F2, MD + 3 * D6}; base = C6; }
    else { m = {a->in[29], (bf16_t*)(a->ws + WS_SOUT_W), SD, D, nullptr, nullptr}; base = C7; }
    const int idx = task - base, ntn = m.N >> 7;
    k0 = (idx / ntn) * 128; n0 = (idx % ntn) * 128;
    return true;
}
__device__ __forceinline__ void tr_load(const TMat& m, int k0, int n0, int t, f32x4 (&r)[8]) {
    const int c4 = t & 31, rr = t >> 5;
#pragma unroll
    for (int i = 0; i < 8; ++i) r[i] = __builtin_nontemporal_load((const f32x4*)(m.W + (size_t)(k0 + rr + 16 * i) * m.N + n0 + 4 * c4));
}
constexpr int TR_PITCH = 132;
constexpr int TRC_UP1_B = 768 + 1408, TRC_UP1_E = TRC_UP1_B + 1408, TRC_DN1_B = TRC_UP1_E + 704, TRC_DN1_E = TRC_DN1_B + 704, TRC_END = TRC_DN1_E + 1024 + 512;
__device__ __forceinline__ int tr_remap(int v) {
    if (v >= TRC_UP1_B) v += 1408; if (v >= TRC_DN1_B) v += 704; return v; }
__device__ __forceinline__ void tr_step(LAS float* tile, LAS float* shl, int t, f32x4 (&r)[8], const TMat& m, int k0, int n0, bool nok, const TMat& nm, int nk0, int nn0) {
    { const int c4 = t & 31, rr = t >> 5;
#pragma unroll
      for (int i = 0; i < 8; ++i) *(LAS f32x4*)(tile + (rr + 16 * i) * TR_PITCH + 4 * c4) = r[i];
      if (m.bias && t < 256) shl[t] = m.shift[(t >> 7) * D6 + k0 + (t & 127)]; }
    __syncthreads();
    if (nok) tr_load(nm, nk0, nn0, t, r);
    { const int n = t & 127, kq = t >> 7; const LAS float* s = tile + (32 * kq) * TR_PITCH + n;
      bf16_t* dst = m.Wt + (size_t)(n0 + n) * m.K + k0 + 32 * kq;
#pragma unroll
      for (int h = 0; h < 4; ++h) { u32x4 o0;
        o0.x = pk2(s[(8 * h + 0) * TR_PITCH], s[(8 * h + 1) * TR_PITCH]); o0.y = pk2(s[(8 * h + 2) * TR_PITCH], s[(8 * h + 3) * TR_PITCH]);
        o0.z = pk2(s[(8 * h + 4) * TR_PITCH], s[(8 * h + 5) * TR_PITCH]); o0.w = pk2(s[(8 * h + 6) * TR_PITCH], s[(8 * h + 7) * TR_PITCH]);
        *(u32x4*)(dst + 8 * h) = o0; }
      if (m.bias) { float p0 = 0.f, p1 = 0.f;
#pragma unroll 8
        for (int i = 0; i < 32; ++i) { const float w = s[i * TR_PITCH]; p0 += w * shl[32 * kq + i]; p1 += w * shl[128 + 32 * kq + i]; }
        atomicAdd(m.bias + n0 + n, p0); atomicAdd(m.bias + F2 + n0 + n, p1); } }
    __syncthreads();
}
template <int MODE>
__device__ __forceinline__ void p0_transpose_all(CArgsP a, LAS unsigned char* lds, int first, int stride, int t_end) {
    const int t = tid_opaque();
    LAS float* tile = (LAS float*)lds;
    LAS float* shl = (LAS float*)(lds + 128 * TR_PITCH * 4);
    TMat ma, mb; int ka, na, kb, nb; f32x4 ra[8], rb[8];
    int task = first;
    bool oka = tr_decode(a, MODE == 1 ? tr_remap(task) : task, t_end, ma, ka, na); if (oka) tr_load(ma, ka, na, t, ra);
    task += stride;
    bool okb = tr_decode(a, MODE == 1 ? tr_remap(task) : task, t_end, mb, kb, nb); if (okb) tr_load(mb, kb, nb, t, rb);
    while (oka) {
        { TMat nm; int nk, nn; task += stride; const bool nok = tr_decode(a, MODE == 1 ? tr_remap(task) : task, t_end, nm, nk, nn);
          tr_step(tile, shl, t, ra, ma, ka, na, nok, nm, nk, nn); oka = nok; ma = nm; ka = nk; na = nn; }
        if (!okb) break;
        { TMat nm; int nk, nn; task += stride; const bool nok = tr_decode(a, MODE == 1 ? tr_remap(task) : task, t_end, nm, nk, nn);
          tr_step(tile, shl, t, rb, mb, kb, nb, nok, nm, nk, nn); okb = nok; mb = nm; kb = nk; nb = nn; }
    }
}

__device__ __forceinline__ void sincos_d(double x, double& s, double& c) {
    const double k = __builtin_rint(x * 0.63661977236758134308);
    double r = __builtin_fma(-k, 1.57079632679489655800e+00, x);
    r = __builtin_fma(-k, 6.12323399573676603587e-17, r);
    const double r2 = r * r;
    double sp = -7.6471637318198164759e-13; sp = sp * r2 + 1.6059043836821614599e-10; sp = sp * r2 - 2.5052108385441718775e-08; sp = sp * r2 + 2.7557319223985890653e-06;
    sp = sp * r2 - 1.9841269841269841270e-04; sp = sp * r2 + 8.3333333333333333333e-03; sp = sp * r2 - 1.6666666666666666667e-01; sp = r + r * r2 * sp;
    double cp = 4.7794773323873852974e-14; cp = cp * r2 - 1.1470745597729724714e-11; cp = cp * r2 + 2.0876756987868098979e-09; cp = cp * r2 - 2.7557319223985890653e-07;
    cp = cp * r2 + 2.4801587301587301587e-05; cp = cp * r2 - 1.3888888888888888889e-03; cp = cp * r2 + 4.1666666666666666667e-02; cp = cp * r2 - 0.5; cp = 1.0 + r2 * cp;
    const int q = ((int)(long long)k) & 3;
    s = (q == 0) ? sp : (q == 1) ? cp : (q == 2) ? -sp : -cp;
    c = (q == 0) ? cp : (q == 1) ? -sp : (q == 2) ? -cp : sp;
}
__device__ __forceinline__ double exp_d(double x) {
    const double k = __builtin_rint(x * 1.44269504088896340736);
    double r = __builtin_fma(-k, 6.93147180369123816490e-01, x);
    r = __builtin_fma(-k, 1.90821492927058770002e-10, r);
    double p = 1.0 / 479001600.0;
    p = p * r + 1.0 / 39916800.0; p = p * r + 1.0 / 3628800.0; p = p * r + 1.0 / 362880.0; p = p * r + 1.0 / 40320.0; p = p * r + 1.0 / 5040.0;
    p = p * r + 1.0 / 720.0; p = p * r + 1.0 / 120.0; p = p * r + 1.0 / 24.0; p = p * r + 1.0 / 6.0; p = p * r + 0.5; p = p * r + 1.0; p = p * r + 1.0;
    const long long e = (long long)k + 1023;
    return p * __builtin_bit_cast(double, (unsigned long long)e << 52);
}
__device__ __forceinline__ void p0_s5_tables(CArgsP a, int idx) {
    const int d = idx >> 13, g = (idx >> 6) & 127, p = idx & 63, gd = g * 2 + d;
    const double are = a->in[13][idx], aim = a->in[14][idx];
    const double dt = exp_d((double)a->in[19][d * NG + g]);
    const double mag = exp_d(are * dt); double sn, cs; sincos_d(aim * dt, sn, cs);
    const double lr = mag * cs, li = mag * sn, den = are * are + aim * aim;
    const double kr = ((lr - 1.0) * are + li * aim) / den, ki = (li * are - (lr - 1.0) * aim) / den;
    const double magT = exp_d(are * dt * (double)TC); double snT, csT; sincos_d(aim * dt * (double)TC, snT, csT);
    f32x2* lam = (f32x2*)(a->ws + WS_LAM); f32x2* lamT = (f32x2*)(a->ws + WS_LAMT);
    lam[gd * 64 + p] = (f32x2){(float)lr, (float)li};
    lamT[gd * 64 + p] = (f32x2){(float)(magT * csT), (float)(magT * snT)};
    bf16_t* Bcat = (bf16_t*)(a->ws + WS_BCAT) + (size_t)(gd * 128 + 2 * p) * 16;
    const float* bre = a->in[15] + (size_t)idx * 16; const float* bim = a->in[16] + (size_t)idx * 16;
#pragma unroll
    for (int h = 0; h < 16; h += 2) {
        const double br0 = bre[h], bi0 = bim[h], br1 = bre[h + 1], bi1 = bim[h + 1];
        *(unsigned*)(Bcat + h) = pk2((float)(kr * br0 - ki * bi0), (float)(kr * br1 - ki * bi1));
        *(unsigned*)(Bcat + 16 + h) = pk2((float)(kr * bi0 + ki * br0), (float)(kr * bi1 + ki * br1));
    }
    bf16_t* Cc = (bf16_t*)(a->ws + WS_CCAT);
    const float* cre = a->in[17] + (size_t)(d * NG + g) * 16 * 64 + p; const float* cim = a->in[18] + (size_t)(d * NG + g) * 16 * 64 + p;
#pragma unroll
    for (int part = 0; part < 2; ++part) {
        const int R = 2 * p + part, tau = R >> 5, rho = R & 31, s = rho >> 4, hh = (rho >> 2) & 1, j = ((rho >> 3) & 1) * 4 + (rho & 3);
        bf16_t* dst = Cc + ((size_t)(((gd * 4 + tau) * 2 + s) * 2 + hh) * 16) * 8 + j;
        for (int h = 0; h < 16; ++h) dst[h * 8] = f2bf(part == 0 ? cre[h * 64] : -cim[h * 64]);
    }
}

__device__ __forceinline__ void p0_s5_kend(CArgsP a, int idx, int seg) {
    const int d = idx >> 13, g = (idx >> 6) & 127, p = idx & 63, gd = g * 2 + d;
    const double are = a->in[13][idx], aim = a->in[14][idx];
    const double dt = exp_d((double)a->in[19][d * NG + g]);
    const double mag = exp_d(are * dt); double sn, cs; sincos_d(aim * dt, sn, cs);
    const double lr = mag * cs, li = mag * sn, den = are * are + aim * aim;
    const double kr = ((lr - 1.0) * are + li * aim) / den, ki = (li * are - (lr - 1.0) * aim) / den;
    const int t_lo = seg == 0 ? 0 : seg == 1 ? 9 : seg == 2 ? 18 : 26, t_hi = seg == 0 ? 9 : seg == 1 ? 18 : seg == 2 ? 26 : 34;
    const double pw = (double)(TC - t_hi);
    const double magP = exp_d(are * dt * pw); double snP, csP; sincos_d(aim * dt * pw, snP, csP);
    double pr = magP * csP, pi = magP * snP;
    float bbr[16], bbi[16];
    const float* bre = a->in[15] + (size_t)idx * 16; const float* bim = a->in[16] + (size_t)idx * 16;
#pragma unroll
    for (int h = 0; h < 16; ++h) { const double br = bre[h], bi = bim[h]; bbr[h] = (float)(kr * br - ki * bi); bbi[h] = (float)(kr * bi + ki * br); }
    for (int tt = t_hi - 1; tt >= t_lo; --tt) {
        const float fr = (float)pr, fi = (float)pi;
        bf16_t* dst = (bf16_t*)(a->ws + WS_KEND) + (((size_t)gd * TC + tt) * 128 + 2 * p) * 16;
        u32x4 w0, w1, w2, w3;
        w0.x = pk2(fr * bbr[0] - fi * bbi[0], fr * bbr[1] - fi * bbi[1]); w0.y = pk2(fr * bbr[2] - fi * bbi[2], fr * bbr[3] - fi * bbi[3]);
        w0.z = pk2(fr * bbr[4] - fi * bbi[4], fr * bbr[5] - fi * bbi[5]); w0.w = pk2(fr * bbr[6] - fi * bbi[6], fr * bbr[7] - fi * bbi[7]);
        w1.x = pk2(fr * bbr[8] - fi * bbi[8], fr * bbr[9] - fi * bbi[9]); w1.y = pk2(fr * bbr[10] - fi * bbi[10], fr * bbr[11] - fi * bbi[11]);
        w1.z = pk2(fr * bbr[12] - fi * bbi[12], fr * bbr[13] - fi * bbi[13]); w1.w = pk2(fr * bbr[14] - fi * bbi[14], fr * bbr[15] - fi * bbi[15]);
        w2.x = pk2(fr * bbi[0] + fi * bbr[0], fr * bbi[1] + fi * bbr[1]); w2.y = pk2(fr * bbi[2] + fi * bbr[2], fr * bbi[3] + fi * bbr[3]);
        w2.z = pk2(fr * bbi[4] + fi * bbr[4], fr * bbi[5] + fi * bbr[5]); w2.w = pk2(fr * bbi[6] + fi * bbr[6], fr * bbi[7] + fi * bbr[7]);
        w3.x = pk2(fr * bbi[8] + fi * bbr[8], fr * bbi[9] + fi * bbr[9]); w3.y = pk2(fr * bbi[10] + fi * bbr[10], fr * bbi[11] + fi * bbr[11]);
        w3.z = pk2(fr * bbi[12] + fi * bbr[12], fr * bbi[13] + fi * bbr[13]); w3.w = pk2(fr * bbi[14] + fi * bbr[14], fr * bbi[15] + fi * bbr[15]);
        *(u32x4*)dst = w0; *(u32x4*)(dst + 8) = w1; *(u32x4*)(dst + 16) = w2; *(u32x4*)(dst + 24) = w3;
        const double nr = pr * lr - pi * li, ni = pr * li + pi * lr; pr = nr; pi = ni;
    }
}

template <bool OUT_F32, int NR>
__device__ __forceinline__ void norm_rows(const float* (&src)[NR], const float* g, const float* (&shift)[NR], void* (&dst)[NR], const bool (&valid)[NR], int lane) {
    f32x4 v[NR][8];
#pragma unroll
    for (int r = 0; r < NR; ++r)
#pragma unroll
        for (int j = 0; j < 8; ++j) v[r][j] = __builtin_nontemporal_load((const f32x4*)src[r] + lane + 64 * j);
#pragma unroll
    for (int r = 0; r < NR; ++r) {
        float ss = 0.f;
#pragma unroll
        for (int j = 0; j < 8; ++j) ss += (v[r][j].x * v[r][j].x + v[r][j].y * v[r][j].y) + (v[r][j].z * v[r][j].z + v[r][j].w * v[r][j].w);
        ss = wave_sum(ss, lane);
        const float rstd = __builtin_amdgcn_rsqf(ss * (1.f / D) + 1e-6f);
        if (valid[r]) {
#pragma unroll
            for (int j = 0; j < 8; ++j) {
                const f32x4 gv = ((const f32x4*)g)[lane + 64 * j]; f32x4 y = v[r][j] * rstd * gv;
                if (OUT_F32) ((f32x4*)dst[r])[lane + 64 * j] = y;
                else { const f32x4 sh = ((const f32x4*)shift[r])[lane + 64 * j], sc = ((const f32x4*)(shift[r] + D))[lane + 64 * j]; y = y * (sc + 1.f) + sh;
                    u32x2 w; w.x = pk2(y.x, y.y); w.y = pk2(y.z, y.w); ((u32x2*)dst[r])[lane + 64 * j] = w; }
            }
        }
    }
}

#define MFMA32(a, b, c) __builtin_amdgcn_mfma_f32_32x32x16_bf16((a), (b), (c), 0, 0, 0)
__device__ __forceinline__ bf16x8 pack8(const f32x4& a, const f32x4& b) { u32x4 p; p.x = pk2(a.x, a.y); p.y = pk2(a.z, a.w); p.z = pk2(b.x, b.y); p.w = pk2(b.z, b.w); return __builtin_bit_cast(bf16x8, p); }
template <bool PASSB>
__device__ __forceinline__ void s5_pass(CArgsP a, LAS unsigned char* lds, int gw, int nw, int lane) {
    LAS unsigned char* cfl = lds + tid_opaque() * 16;
    LAS unsigned char* lamL = lds + 65536 + (tid_opaque() >> 6) * 512;
    const bf16_t* U = (const bf16_t*)(a->ws + WS_UB);
    const f32x2* lam = (const f32x2*)(a->ws + WS_LAM);
    const bf16_t* Bcat = (const bf16_t*)(a->ws + WS_BCAT);
    const bf16_t* Cc = (const bf16_t*)(a->ws + WS_CCAT);
    for (int item = gw; item < 2048; item += nw) {
        const int g = item & 127, tile = (item >> 7) & 7, d = item >> 10, gd = g * 2 + d;
        const int r = lane & 31, hh = lane >> 5, col = tile * 32 + r, b = col >> 7, c = col & 127;
        bf16x8 Bf[4];
#pragma unroll
        for (int tau = 0; tau < 4; ++tau) Bf[tau] = *(const bf16x8*)(Bcat + (size_t)(gd * 128 + 32 * tau + r) * 16 + 8 * hh);
        { const int p = lane, tau = p >> 4, pl = p & 15, q = ((pl >> 2) << 1) | (pl & 1), h2 = (pl >> 1) & 1;
          *(LAS f32x2*)(lamL + ((tau * 2 + h2) * 8 + q) * 8) = lam[gd * 64 + p]; }
        f32x16 S[4];
        float* Ebuf = (float*)(a->ws + (PASSB ? WS_SI : WS_E)) + ((size_t)gd * NCOL + col) * 128 + 4 * hh;
        if (PASSB) {
#pragma unroll
            for (int tau = 0; tau < 4; ++tau)
#pragma unroll
                for (int i4 = 0; i4 < 4; ++i4) { const f32x4 v = *(const f32x4*)(Ebuf + 32 * tau + 8 * i4); S[tau][4 * i4] = v.x; S[tau][4 * i4 + 1] = v.y; S[tau][4 * i4 + 2] = v.z; S[tau][4 * i4 + 3] = v.w; }
        } else {
#pragma unroll
            for (int tau = 0; tau < 4; ++tau)
#pragma unroll
                for (int i = 0; i < 16; ++i) S[tau][i] = 0.f;
        }
        if (PASSB) {
#pragma unroll
            for (int tau = 0; tau < 4; ++tau)
#pragma unroll
                for (int s = 0; s < 2; ++s) {
                    u32x4 z = {0u, 0u, 0u, 0u};
                    if (r < 16) z = *(const u32x4*)(Cc + ((size_t)((((gd * 4 + tau) * 2 + s) * 2 + hh) * 16 + r)) * 8);
                    *(LAS u32x4*)(cfl + (tau * 2 + s) * 8192) = z;
                }
        }
        bf16_t* Yd = (bf16_t*)(a->ws + (d == 0 ? WS_YF : WS_YR));
        const int pos0 = TC * c;
        auto memidx = [&](int pos) -> int { return d == 0 ? pos : (pos < CTXL ? (CTXL - 1 - pos) : (LT + CTXL - 1 - pos)); };
        const bf16_t* ub = U + (size_t)b * LT * D + g * 16 + 8 * hh;
        auto ldu = [&](int mem) -> bf16x8 { return *(const bf16x8*)(ub + (size_t)mem * D); };
        bf16x8 un[8];
#pragma unroll
        for (int j = 0; j < 8; ++j) un[j] = ldu(memidx(pos0 + j));
#pragma unroll 1
        for (int tb = 0; tb < TC; tb += 8) {
#pragma unroll
          for (int j = 0; j < 8; j += 2) {
            const int t = tb + j;
            if (t < TC) {
            asm volatile("" ::: "memory");
            const bf16x8 ufa = un[j], ufb = un[j + 1];
            const int posa = pos0 + t, mema = memidx(posa), memb = memidx(posa + 1);
            if (t + 8 < TC) { un[j] = ldu(memidx(posa + 8)); un[j + 1] = ldu(memidx(posa + 9)); }
            f32x16 Ya, Yb;
#pragma unroll
            for (int i = 0; i < 16; ++i) { Ya[i] = 0.f; Yb[i] = 0.f; }
#pragma unroll
            for (int tau = 0; tau < 4; ++tau) {
                const LAS f32x4* lp = (const LAS f32x4*)(lamL + (tau * 2 + hh) * 64);
                const f32x4 l0 = lp[0], l1 = lp[1], l2 = lp[2], l3 = lp[3];
                const float lrr[8] = {l0.x, l0.z, l1.x, l1.z, l2.x, l2.z, l3.x, l3.z}, lii[8] = {l0.y, l0.w, l1.y, l1.w, l2.y, l2.w, l3.y, l3.w};
                bf16x8 cf0, cf1;
                if (PASSB) { cf0 = *(const LAS bf16x8*)(cfl + (tau * 2 + 0) * 8192); cf1 = *(const LAS bf16x8*)(cfl + (tau * 2 + 1) * 8192); }
#pragma unroll
                for (int half = 0; half < 2; ++half) {
                    f32x16 C;
#pragma unroll
                    for (int q = 0; q < 8; ++q) { const float sr = S[tau][2 * q], si = S[tau][2 * q + 1];
                        C[2 * q] = lrr[q] * sr - lii[q] * si; C[2 * q + 1] = lrr[q] * si + lii[q] * sr; }
                    S[tau] = MFMA32(Bf[tau], half == 0 ? ufa : ufb, C);
                    if (PASSB) {
                        u32x4 p0, p1;
                        p0.x = pk2(S[tau][0], S[tau][1]); p0.y = pk2(S[tau][2], S[tau][3]); p0.z = pk2(S[tau][4], S[tau][5]); p0.w = pk2(S[tau][6], S[tau][7]);
                        p1.x = pk2(S[tau][8], S[tau][9]); p1.y = pk2(S[tau][10], S[tau][11]); p1.z = pk2(S[tau][12], S[tau][13]); p1.w = pk2(S[tau][14], S[tau][15]);
                        if (half == 0) { Ya = MFMA32(cf0, __builtin_bit_cast(bf16x8, p0), Ya); Ya = MFMA32(cf1, __builtin_bit_cast(bf16x8, p1), Ya); }
                        else { Yb = MFMA32(cf0, __builtin_bit_cast(bf16x8, p0), Yb); Yb = MFMA32(cf1, __builtin_bit_cast(bf16x8, p1), Yb); }
                    }
                }
            }
            if (PASSB) {
                if (posa >= CTXL) {
                    bf16_t* yp = Yd + ((size_t)b * SEQ + (mema - CTXL)) * D + g * 16 + 4 * hh;
                    u32x2 w0, w1; w0.x = pk2(Ya[0], Ya[1]); w0.y = pk2(Ya[2], Ya[3]); w1.x = pk2(Ya[4], Ya[5]); w1.y = pk2(Ya[6], Ya[7]);
                    *(u32x2*)yp = w0; *(u32x2*)(yp + 8) = w1;
                }
                if (posa + 1 >= CTXL) {
                    bf16_t* yp = Yd + ((size_t)b * SEQ + (memb - CTXL)) * D + g * 16 + 4 * hh;
                    u32x2 w0, w1; w0.x = pk2(Yb[0], Yb[1]); w0.y = pk2(Yb[2], Yb[3]); w1.x = pk2(Yb[4], Yb[5]); w1.y = pk2(Yb[6], Yb[7]);
                    *(u32x2*)yp = w0; *(u32x2*)(yp + 8) = w1;
                }
            }
            }
          }
        }
        if (!PASSB) {
#pragma unroll
            for (int tau = 0; tau < 4; ++tau)
#pragma unroll
                for (int i4 = 0; i4 < 4; ++i4) *(f32x4*)(Ebuf + 32 * tau + 8 * i4) = (f32x4){S[tau][4 * i4], S[tau][4 * i4 + 1], S[tau][4 * i4 + 2], S[tau][4 * i4 + 3]};
        }
    }
}

__device__ __forceinline__ void s5_passA(CArgsP a, int gw, int nw, int lane) {
    const bf16_t* U = (const bf16_t*)(a->ws + WS_UB);
    const bf16_t* KE = (const bf16_t*)(a->ws + WS_KEND);
    for (int item = gw; item < 2048; item += nw) {
        const int g = item & 127, tile = (item >> 7) & 7, d = item >> 10, gd = g * 2 + d;
        const int r = lane & 31, hh = lane >> 5, col = tile * 32 + r, b = col >> 7, c = col & 127;
        f32x16 S[4];
#pragma unroll
        for (int tau = 0; tau < 4; ++tau)
#pragma unroll
            for (int i = 0; i < 16; ++i) S[tau][i] = 0.f;
        float* Ebuf = (float*)(a->ws + WS_E) + ((size_t)gd * NCOL + col) * 128 + 4 * hh;
        const int pos0 = TC * c;
        auto memidx = [&](int pos) -> int { return d == 0 ? pos : (pos < CTXL ? (CTXL - 1 - pos) : (LT + CTXL - 1 - pos)); };
        const bf16_t* ub = U + (size_t)b * LT * D + g * 16 + 8 * hh;
        const bf16_t* kb = KE + ((size_t)gd * TC * 128 + r) * 16 + 8 * hh;
        bf16x8 un[8], af[4][4];
#pragma unroll
        for (int j = 0; j < 8; ++j) un[j] = *(const bf16x8*)(ub + (size_t)memidx(pos0 + j) * D);
#pragma unroll
        for (int j = 0; j < 4; ++j)
#pragma unroll
            for (int tau = 0; tau < 4; ++tau) af[j][tau] = *(const bf16x8*)(kb + ((size_t)j * 128 + 32 * tau) * 16);
#pragma unroll 1
        for (int tb = 0; tb < TC; tb += 8) {
#pragma unroll
            for (int j = 0; j < 8; ++j) {
                const int t = tb + j;
                if (t < TC) {
                    const bf16x8 uf = un[j];
                    const bf16x8 a0 = af[j & 3][0], a1 = af[j & 3][1], a2 = af[j & 3][2], a3 = af[j & 3][3];
                    if (t + 8 < TC) un[j] = *(const bf16x8*)(ub + (size_t)memidx(pos0 + t + 8) * D);
                    if (t + 4 < TC) {
#pragma unroll
                        for (int tau = 0; tau < 4; ++tau) af[j & 3][tau] = *(const bf16x8*)(kb + ((size_t)(t + 4) * 128 + 32 * tau) * 16); }
                    S[0] = MFMA32(a0, uf, S[0]); S[1] = MFMA32(a1, uf, S[1]); S[2] = MFMA32(a2, uf, S[2]); S[3] = MFMA32(a3, uf, S[3]);
                }
            }
        }
#pragma unroll
        for (int tau = 0; tau < 4; ++tau)
#pragma unroll
            for (int i4 = 0; i4 < 4; ++i4) *(f32x4*)(Ebuf + 32 * tau + 8 * i4) = (f32x4){S[tau][4 * i4], S[tau][4 * i4 + 1], S[tau][4 * i4 + 2], S[tau][4 * i4 + 3]};
    }
}

__device__ __forceinline__ float dot2bf(unsigned z, unsigned w, float acc) { return __builtin_amdgcn_fdot2_f32_bf16(__builtin_bit_cast(bf16x2v, z), __builtin_bit_cast(bf16x2v, w), acc, false); }
__device__ __forceinline__ void conv_phase(CArgsP a, LAS unsigned char* lds, int layer, int first, int stride) {
    const int t0 = tid_opaque();
    const bf16_t* Z = (const bf16_t*)(a->ws + WS_Z); bf16_t* A3 = (bf16_t*)(a->ws + WS_A3);
    const float* cw = a->in[9] + (size_t)layer * 9 * F2; const float* cb = a->in[10] + (size_t)layer * F2;
    LAS unsigned* wl = (LAS unsigned*)lds;
    for (int task = first; task < 704; task += stride) {
        const int t = launder_i(t0), o = t & 15, c = (t >> 4) + 32 * ((task / 44) & 1);
        const int cbk = task % 44, rb = (task / 88) & 3, b = task / 352;
        __syncthreads();
#pragma unroll
        for (int it = 0; it < 5; ++it) { const int i = t + it * NTHREADS; { const int tap = i >> 8, half = (i >> 7) & 1, ch = i & 127; const int gch = half * FF + cbk * 128 + ch;
            const float wv = tap < 9 ? cw[(size_t)tap * F2 + gch] : cb[gch];
            wl[i] = tap < 9 ? ((ch & 1) ? (pk2(0.f, wv)) : (pk2(wv, 0.f))) : __builtin_bit_cast(unsigned, wv); } }
        __syncthreads();
        const u32x4 zero4 = {0u, 0u, 0u, 0u};
        u32x4 win[6][3][2];
        const size_t chg = (size_t)cbk * 128 + 8 * o;
        auto ldrow = [&](int rrow, u32x4 (&w)[3][2]) {
#pragma unroll
            for (int dj = 0; dj < 3; ++dj) { const int cc2 = c + dj - 1; const bool ok = (rrow >= 0) && (rrow < 64) && (cc2 >= 0) && (cc2 < 64);
                if (ok) { const bf16_t* zp = Z + ((size_t)b * SEQ + rrow * 64 + cc2) * F2 + chg; w[dj][0] = *(const u32x4*)zp; w[dj][1] = *(const u32x4*)(zp + FF); }
                else { w[dj][0] = zero4; w[dj][1] = zero4; } }
        };
        const int r0 = rb * 16;
        ldrow(r0 - 1, win[0]); ldrow(r0, win[1]); ldrow(r0 + 1, win[2]); ldrow(r0 + 2, win[3]);
#pragma unroll
        for (int q = 0; q < 8; ++q) {
                asm volatile("" ::: "memory");
                const int row = r0 + 2 * q;
                if (q <= 6) { ldrow(row + 3, win[(2 * q + 4) % 6]); ldrow(row + 4, win[(2 * q + 5) % 6]); }
                float ag[2][8], av[2][8];
                { const LAS f32x4* bp = (const LAS f32x4*)(wl + 9 * 256 + 8 * o); const f32x4 b0 = bp[0], b1 = bp[1], b2 = bp[32], b3 = bp[33];
#pragma unroll
                  for (int rr = 0; rr < 2; ++rr)
#pragma unroll
                  for (int j = 0; j < 4; ++j) { ag[rr][j] = b0[j]; ag[rr][4 + j] = b1[j]; av[rr][j] = b2[j]; av[rr][4 + j] = b3[j]; } }
#pragma unroll
                for (int di = 0; di < 3; ++di)
#pragma unroll
                    for (int dj = 0; dj < 3; ++dj) {
                        asm volatile("" ::: "memory");
                        const LAS u32x4* wp = (const LAS u32x4*)(wl + (di * 3 + dj) * 256 + 8 * o);
                        const u32x4 wg0 = wp[0], wg1 = wp[1], wv0 = wp[32], wv1 = wp[33];
#pragma unroll
                        for (int rr = 0; rr < 2; ++rr) {
                            const u32x4 zg = win[(2 * q + rr + di) % 6][dj][0], zv = win[(2 * q + rr + di) % 6][dj][1];
                            ag[rr][0] = dot2bf(zg.x, wg0.x, ag[rr][0]); ag[rr][1] = dot2bf(zg.x, wg0.y, ag[rr][1]); ag[rr][2] = dot2bf(zg.y, wg0.z, ag[rr][2]); ag[rr][3] = dot2bf(zg.y, wg0.w, ag[rr][3]);
                            ag[rr][4] = dot2bf(zg.z, wg1.x, ag[rr][4]); ag[rr][5] = dot2bf(zg.z, wg1.y, ag[rr][5]); ag[rr][6] = dot2bf(zg.w, wg1.z, ag[rr][6]); ag[rr][7] = dot2bf(zg.w, wg1.w, ag[rr][7]);
                            av[rr][0] = dot2bf(zv.x, wv0.x, av[rr][0]); av[rr][1] = dot2bf(zv.x, wv0.y, av[rr][1]); av[rr][2] = dot2bf(zv.y, wv0.z, av[rr][2]); av[rr][3] = dot2bf(zv.y, wv0.w, av[rr][3]);
                            av[rr][4] = dot2bf(zv.z, wv1.x, av[rr][4]); av[rr][5] = dot2bf(zv.z, wv1.y, av[rr][5]); av[rr][6] = dot2bf(zv.w, wv1.z, av[rr][6]); av[rr][7] = dot2bf(zv.w, wv1.w, av[rr][7]);
                        }
                    }
#pragma unroll
                for (int rr = 0; rr < 2; ++rr) {
                    u32x4 w;
                    w.x = pk2(silu_f(ag[rr][0]) * av[rr][0], silu_f(ag[rr][1]) * av[rr][1]); w.y = pk2(silu_f(ag[rr][2]) * av[rr][2], silu_f(ag[rr][3]) * av[rr][3]);
                    w.z = pk2(silu_f(ag[rr][4]) * av[rr][4], silu_f(ag[rr][5]) * av[rr][5]); w.w = pk2(silu_f(ag[rr][6]) * av[rr][6], silu_f(ag[rr][7]) * av[rr][7]);
                    *(u32x4*)(A3 + ((size_t)b * SEQ + (row + rr) * 64 + c) * FF + chg) = w; }
        }
    }
}

constexpr int SP_PITCH = 136;
constexpr int SP_WS_OFF = 0, SP_VT_OFF = 128 * SP_PITCH * 2  , SP_O_OFF = SP_VT_OFF  , SP_OPITCH = 264;
__device__ __forceinline__ void spatial_phase(CArgsP a, LAS unsigned char* lds, int first, int stride) {
    const int t = tid_opaque(), lane = t & 63, wid = t >> 6;
    const bf16_t* ZS = (const bf16_t*)(a->ws + WS_ZS); bf16_t* GT = (bf16_t*)(a->ws + WS_GT);
    const float* st = (const float*)(a->ws + WS_LNST);
    const float* lng = a->in[25]; const float* lnb = a->in[26]; const float* wsp = a->in[27]; const float* bsp = a->in[28];
    LAS bf16_t* Ws = (LAS bf16_t*)(lds + SP_WS_OFF); LAS bf16_t* Vt = (LAS bf16_t*)(lds + SP_VT_OFF); LAS bf16_t* Ot = (LAS bf16_t*)(lds + SP_O_OFF);
    int g_loaded = -1;
    u32x4 va[4], vb[4]; f32x4 st4[4];
    auto load_v = [&](int item) {
        const int g = item & 15, cn = item >> 4; const size_t tok0 = (size_t)cn * 128;
#pragma unroll
        for (int it = 0; it < 4; ++it) { const int i = t + it * NTHREADS; const int oc = i & 3, kp = (i >> 2) & 63, og = i >> 8, c0 = (og * 4 + oc) * 8;
            const size_t ra = tok0 + 2 * kp;
            va[it] = __builtin_nontemporal_load((const u32x4*)(ZS + ra * SD2 + SD + g * 256 + c0)); vb[it] = __builtin_nontemporal_load((const u32x4*)(ZS + (ra + 1) * SD2 + SD + g * 256 + c0));
            st4[it] = *(const f32x4*)(st + 2 * ra); }
    };
    if (first < 1024) load_v(first);
    for (int item = first; item < 1024; item += stride) {
        const int g = item & 15, cn = item >> 4;
        const size_t tok0 = (size_t)cn * 128;
        __syncthreads();
        if (g != g_loaded) { g_loaded = g;
        for (int i = t; i < 128 * 32; i += NTHREADS) { const int q = i >> 5, k4 = i & 31; const f32x4 w = *(const f32x4*)(wsp + ((size_t)g * 128 + q) * 128 + 4 * k4);
            u32x2 pw; pw.x = pk2(w.x, w.y); pw.y = pk2(w.z, w.w); *(LAS u32x2*)(Ws + q * SP_PITCH + 4 * k4) = pw; } }
#pragma unroll
        for (int it = 0; it < 4; ++it) {
            const int i = t + it * NTHREADS; const int oc = i & 3, kp = (i >> 2) & 63, og = i >> 8, c0 = (og * 4 + oc) * 8;
            const float mua = st4[it].x * (1.f / SD), mub = st4[it].z * (1.f / SD);
            const float rsa = __builtin_amdgcn_rsqf(st4[it].y * (1.f / SD) - mua * mua + 1e-5f), rsb = __builtin_amdgcn_rsqf(st4[it].w * (1.f / SD) - mub * mub + 1e-5f);
            const f32x4 g0 = *(const f32x4*)(lng + g * 256 + c0), g1 = *(const f32x4*)(lng + g * 256 + c0 + 4), b0 = *(const f32x4*)(lnb + g * 256 + c0), b1 = *(const f32x4*)(lnb + g * 256 + c0 + 4);
            const unsigned wa[4] = {va[it].x, va[it].y, va[it].z, va[it].w}, wb[4] = {vb[it].x, vb[it].y, vb[it].z, vb[it].w};
#pragma unroll
            for (int j = 0; j < 4; ++j) {
                const float gl = j < 2 ? g0[2 * j] : g1[2 * j - 4], gh = j < 2 ? g0[2 * j + 1] : g1[2 * j - 3];
                const float bl = j < 2 ? b0[2 * j] : b1[2 * j - 4], bh = j < 2 ? b0[2 * j + 1] : b1[2 * j - 3];
                const float al = (bf_lo(wa[j]) - mua) * rsa * gl + bl, ah = (bf_hi(wa[j]) - mua) * rsa * gh + bh;
                const float bl2 = (bf_lo(wb[j]) - mub) * rsb * gl + bl, bh2 = (bf_hi(wb[j]) - mub) * rsb * gh + bh;
                *(LAS unsigned*)(Vt + (c0 + 2 * j) * SP_PITCH + 2 * kp) = pk2(al, bl2);
                *(LAS unsigned*)(Vt + (c0 + 2 * j + 1) * SP_PITCH + 2 * kp) = pk2(ah, bh2);
            }
        }
        __syncthreads();
        if (item + stride < 1024) load_v(item + stride);
        u32x4 uvr[8];
#pragma unroll
        for (int it = 0; it < 8; ++it) { const int i = t + it * NTHREADS; const int q = i >> 5, oct = i & 31; uvr[it] = __builtin_nontemporal_load((const u32x4*)(ZS + (tok0 + q) * SD2 + g * 256 + 8 * oct)); }
        const int r = lane & 31, hh = lane >> 5;
        f32x16 acc[4];
#pragma unroll
        for (int mt = 0; mt < 4; ++mt)
#pragma unroll
            for (int i = 0; i < 16; ++i) acc[mt][i] = 0.f;
#pragma unroll
        for (int ks = 0; ks < 8; ++ks) {
            const bf16x8 bfr = *(const LAS bf16x8*)(Vt + (32 * wid + r) * SP_PITCH + 16 * ks + 8 * hh);
#pragma unroll
            for (int mt = 0; mt < 4; ++mt) { const bf16x8 afr = *(const LAS bf16x8*)(Ws + (32 * mt + r) * SP_PITCH + 16 * ks + 8 * hh); acc[mt] = MFMA32(afr, bfr, acc[mt]); }
        }
        __syncthreads();
#pragma unroll
        for (int mt = 0; mt < 4; ++mt)
#pragma unroll
            for (int i = 0; i < 16; ++i) { const int q = 32 * mt + (i & 3) + 8 * (i >> 2) + 4 * hh; Ot[q * SP_OPITCH + 32 * wid + r] = f2bf(acc[mt][i] + bsp[g * 128 + q]); }
        __syncthreads();
#pragma unroll
        for (int it = 0; it < 8; ++it) { const int i = t + it * NTHREADS; const int q = i >> 5, oct = i & 31;
            const u32x4 uv = uvr[it];
            const u32x4 sv = *(const LAS u32x4*)(Ot + q * SP_OPITCH + 8 * oct);
            u32x4 w;
            w.x = pk2(bf_lo(uv.x) * bf_lo(sv.x), bf_hi(uv.x) * bf_hi(sv.x)); w.y = pk2(bf_lo(uv.y) * bf_lo(sv.y), bf_hi(uv.y) * bf_hi(sv.y));
            w.z = pk2(bf_lo(uv.z) * bf_lo(sv.z), bf_hi(uv.z) * bf_hi(sv.z)); w.w = pk2(bf_lo(uv.w) * bf_lo(sv.w), bf_hi(uv.w) * bf_hi(sv.w));
            *(u32x4*)(GT + (tok0 + q) * SD + g * 256 + 8 * oct) = w; }
    }
}

#define XB_TMO      128
#define XB_XCNT(j)  (256  + 64 * (j))
#define XB_XSUB(j)  (1280 + 64 * (j))
#define XB_XGEN(j)  (2304 + 64 * (j))
#define XB_TOP      3328
#define XB_TOPGEN   3392
#define XCD_BAR_WORDS 3456
#define XB_SPIN_CAP (1u << 22)
__device__ __forceinline__ unsigned xb_ld(unsigned* p)              { return __hip_atomic_load(p, __ATOMIC_RELAXED, __HIP_MEMORY_SCOPE_AGENT); }
__device__ __forceinline__ unsigned xb_add(unsigned* p, unsigned v) { return __hip_atomic_fetch_add(p, v, __ATOMIC_RELAXED, __HIP_MEMORY_SCOPE_AGENT); }
__device__ __forceinline__ unsigned xb_xcc_id() { return (unsigned)__builtin_amdgcn_s_getreg((3 << 11) | 20) & 0xFu; }
#define XB_SPIN(cond, bar) do { unsigned _sp = 0; while (cond) { __builtin_amdgcn_s_sleep(1); \
    if ((++_sp & 255u) == 0u) { if (xb_ld(&(bar)[XB_TMO])) break; if (_sp > XB_SPIN_CAP) { atomicAdd(&(bar)[XB_TMO], 1u); break; } } } } while (0)
struct XcdBarrier { unsigned* bar; unsigned x; volatile LAS unsigned* st; };
__device__ __forceinline__ XcdBarrier xcd_barrier_post(unsigned* bar, volatile LAS unsigned* st) {
    XcdBarrier b; b.bar = bar; b.x = xb_xcc_id(); b.st = st;
    if (threadIdx.x == 0) (void)xb_add(&bar[XB_XCNT(b.x)], 1u);
    return b;
}
__device__ __forceinline__ void xcd_barrier_complete(unsigned* bar, unsigned x, unsigned& nloc, unsigned& nx) {
    const unsigned G = gridDim.x * gridDim.y * gridDim.z;
    unsigned sum, cnt, mine, sp = 0u;
    for (;;) {
        sum = 0u; cnt = 0u; mine = 0u;
#pragma unroll
        for (unsigned j = 0; j < 16; ++j) { const unsigned c = xb_ld(&bar[XB_XCNT(j)]); sum += c; cnt += (c > 0u) ? 1u : 0u; mine = (j == x) ? c : mine; }
        if (sum == G) break;
        __builtin_amdgcn_s_sleep(1);
        if ((++sp & 255u) == 0u) { if (xb_ld(&bar[XB_TMO])) break; if (sp > XB_SPIN_CAP) { atomicAdd(&bar[XB_TMO], 1u); break; } }
    }
    nloc = mine > 0u ? mine : 1u; nx = cnt > 0u ? cnt : 1u;
}
__device__ __forceinline__ void xcd_barrier(const XcdBarrier& b) {
    asm volatile("s_waitcnt vmcnt(0)" ::: "memory");
    __syncthreads();
    if (threadIdx.x == 0) {
        unsigned* bar = b.bar;
        __builtin_amdgcn_s_waitcnt(0);
        unsigned nloc = b.st[0], nx = b.st[1];
        if (nloc == 0u) { xcd_barrier_complete(bar, b.x, nloc, nx); b.st[0] = nloc; b.st[1] = nx; }
        const unsigned old = xb_add(&bar[XB_XSUB(b.x)], 1u);
        const unsigned gen = old / nloc;
        if (old + 1u == (gen + 1u) * nloc) {
            __builtin_amdgcn_fence(__ATOMIC_RELEASE, "agent");
            asm volatile("s_waitcnt vmcnt(0)" ::: "memory");
            const unsigned og = xb_add(&bar[XB_TOP], 1u);
            const unsigned tg = og / nx;
            if (og + 1u == (tg + 1u) * nx) xb_add(&bar[XB_TOPGEN], 1u);
            else XB_SPIN(xb_ld(&bar[XB_TOPGEN]) == tg, bar);
            __builtin_amdgcn_fence(__ATOMIC_ACQUIRE, "agent");
            xb_add(&bar[XB_XGEN(b.x)], 1u);
            asm volatile("s_waitcnt vmcnt(0)" ::: "memory");
        } else {
            XB_SPIN(xb_ld(&bar[XB_XGEN(b.x)]) == gen, bar);
            __builtin_amdgcn_fence(__ATOMIC_ACQUIRE, "agent");
            asm volatile("s_waitcnt vmcnt(0)" ::: "memory");
        }
    }
    __syncthreads();
}

__global__ void __launch_bounds__(NTHREADS, 2) fwd_kernel(Args a_unused) {
    extern __shared__ __attribute__((aligned(16))) unsigned char lds_raw[];
    LAS unsigned char* lds = (LAS unsigned char*)lds_raw;
    cg::grid_group grid = cg::this_grid();
        int lo, hi; { CArgsP a0 = get_args(); lo = a0->ph_lo; hi = a0->ph_hi; }
    int ph = 0;
    const unsigned long long t_entry = PROBE_MASK ? __builtin_amdgcn_s_memrealtime() : 0ull;
    if (PROBE_MASK && blockIdx.x == 0 && threadIdx.x == 0) { CArgsP a0 = get_args(); *(volatile unsigned long long*)(a0->ws + WS_PROBE) = 0ull; }
    if (threadIdx.x < 2) ((volatile LAS unsigned*)(lds + LDS_BARST))[threadIdx.x] = 0u;
    __syncthreads();
    XcdBarrier xbar; xbar.bar = nullptr; xbar.x = 0; xbar.st = (volatile LAS unsigned*)(lds + LDS_BARST);
    bool xb_ready = false;
#define GRID_SYNC() do { if (!xb_ready) { grid.sync(); CArgsP _a = get_args(); xbar = xcd_barrier_post((unsigned*)(_a->ws + WS_BAR), (volatile LAS unsigned*)(lds + LDS_BARST)); xb_ready = true; } else { xcd_barrier(xbar); } } while (0)
#ifndef ONLY_KIND
#define ONLY_KIND -1
#endif
#define PHASE_BEGIN(kind) if ((ONLY_KIND < 0 || ONLY_KIND == (kind)) && ph >= lo && ph < hi) { CArgsP a = get_args(); unsigned char* ws = a->ws; float* modbuf = (float*)(ws + WS_MOD); (void)modbuf; const int t = tid_opaque(), lane = t & 63, wave = __builtin_amdgcn_readfirstlane(t >> 6); const int G = gridDim.x, bx = blockIdx.x; const int gw = bx * NWAVES + wave, NGW = G * NWAVES; (void)lane; (void)gw; (void)NGW; \
    unsigned long long _pt0 = 0; const bool _pon = PROBE_MASK && ((PROBE_MASK >> (kind)) & 1u) && bx == 0 && t == 0; if (_pon) _pt0 = __builtin_amdgcn_s_memrealtime();
#define PHASE_END   if (ph + 1 < hi) { GRID_SYNC(); } if (_pon) { *(volatile unsigned long long*)(ws + WS_PROBE) += __builtin_amdgcn_s_memrealtime() - _pt0; } } ++ph;

    PHASE_BEGIN(0)
        for (int i = bx * NTHREADS + t; i < M * 2; i += G * NTHREADS) ((float*)(ws + WS_LNST))[i] = 0.f;
        for (int i = bx * NTHREADS + t; i < 6 * F2; i += G * NTHREADS) ((float*)(ws + WS_BIAS))[i] = 0.f;
        for (int i = bx * NTHREADS + t; i < 4 * M; i += G * NTHREADS) ((float*)(ws + WS_ROWSS))[i] = 0.f;
        if (bx == 0) for (int i = t; i < XCD_BAR_WORDS; i += NTHREADS) ((unsigned*)(ws + WS_BAR))[i] = 0u;
        for (int tk = bx; tk < 768; tk += G) p0_gemv_task(a, lds, tk);
    PHASE_END
    PHASE_BEGIN(1)
        for (int i = bx * NTHREADS + t; i < 3 * NB * D; i += G * NTHREADS) { const int site = i / (NB * D), b = (i / D) % NB, k = i % D;
            const float gg = site == 0 ? a->in[5][k] : site == 1 ? a->in[4][D + k] : a->in[5][D + k];
            const float sc = site == 0 ? modbuf[b * D6 + 4 * D + k] : site == 1 ? modbuf[(3 + b) * D6 + D + k] : modbuf[(3 + b) * D6 + 4 * D + k];
            ((float*)(ws + WS_GP))[i] = gg * (1.f + sc); }
        for (int m0 = gw; m0 < MU; m0 += 4 * NGW) {
            const float* src[4]; const float* sh[4]; void* dst[4]; bool valid[4];
#pragma unroll
            for (int k = 0; k < 4; ++k) { const int mm = m0 + k * NGW; valid[k] = mm < MU; const int m = valid[k] ? mm : MU - 1; const int b = m / LT, j = m % LT;
                src[k] = j < CTXL ? a->in[2] + ((size_t)b * CTXL + j) * D : a->in[0] + ((size_t)b * SEQ + (j - CTXL)) * D;
                sh[k] = modbuf + (j < CTXL ? 2 : b) * D6; dst[k] = (bf16_t*)(ws + WS_A0) + (size_t)m * D; }
            norm_rows<false, 4>(src, a->in[4], sh, dst, valid, lane); }
        __syncthreads();
        p0_transpose_all<1>(a, lds, bx, G, TRC_END - 512);
    PHASE_END
    PHASE_BEGIN(2)
        pg8::Gemm g{(const bf16_t*)(ws + WS_A0), (const bf16_t*)(ws + WS_WIN), MU, D, D, D}; pg8::StaticOrder S; S.init(MU, D, G, bx);
        pg8::EpiF32 E{nullptr, D, (bf16_t*)(ws + WS_UB)};
        pg8::gemm_phase<pg8::EpiF32, true, true>(lds, g, S, E);
        if (bx >= 16) { __syncthreads(); p0_transpose_all<0>(a, lds, TRC_UP1_B + (bx - 16), G - 16, TRC_UP1_E);
            for (int idx = (bx - 16) * NTHREADS + t; idx < 2 * NG * NP; idx += (G - 16) * NTHREADS) p0_s5_tables(a, idx);
            for (int w = (bx - 16) * NTHREADS + t; w < 2 * NG * NP * 4; w += (G - 16) * NTHREADS) p0_s5_kend(a, w >> 2, w & 3); }
    PHASE_END
    PHASE_BEGIN(3)
        s5_passA(a, gw, NGW, lane);
    PHASE_END
    PHASE_BEGIN(4)
        if (t < 128) {
            const f32x2* lamT = (const f32x2*)(ws + WS_LAMT);
            for (int idx = bx * 128 + t; idx < 2 * NG * 2 * NP; idx += G * 128) {
                const int p = idx & 63, b = (idx >> 6) & 1, gd = idx >> 7;
                const f32x2 lt = lamT[gd * 64 + p]; float sr = 0.f, si = 0.f;
                const f32x2* e = (const f32x2*)((const float*)(ws + WS_E) + ((size_t)gd * NCOL + b * 128) * 128) + p;
                f32x2* so = (f32x2*)((float*)(ws + WS_SI) + ((size_t)gd * NCOL + b * 128) * 128) + p;
#pragma unroll 8
                for (int c = 0; c < 128; ++c) { so[c * 64] = (f32x2){sr, si}; const f32x2 ev = e[c * 64];
                    const float nr = lt.x * sr - lt.y * si + ev.x, ni = lt.x * si + lt.y * sr + ev.y; sr = nr; si = ni; }
            }
        }
    PHASE_END
    PHASE_BEGIN(5)
        s5_pass<true>(a, lds, gw, NGW, lane);
    PHASE_END
    PHASE_BEGIN(6)
        const bf16_t* UBp = (const bf16_t*)(ws + WS_UB); const u32x4* YF = (const u32x4*)(ws + WS_YF); const u32x4* YR = (const u32x4*)(ws + WS_YR);
        const float* dsk = a->in[20]; u32x4* Gm = (u32x4*)(ws + WS_G);
#pragma unroll 4
        for (int i = bx * NTHREADS + t; i < M * (D / 8); i += G * NTHREADS) {
            const int m = i >> 8, c8 = i & 255, b = m >> 12, tt = m & 4095;
            const u32x4 u = __builtin_nontemporal_load((const u32x4*)(UBp + ((size_t)b * LT + CTXL + tt) * D + 8 * c8));
            const u32x4 yf = __builtin_nontemporal_load(YF + i), yr = __builtin_nontemporal_load(YR + i); const f32x4 d0 = ((const f32x4*)dsk)[2 * c8], d1 = ((const f32x4*)dsk)[2 * c8 + 1];
            u32x4 w;
            w.x = pk2(gelu_tanh_f(d0.x * bf_lo(u.x) + bf_lo(yf.x) + bf_lo(yr.x)), gelu_tanh_f(d0.y * bf_hi(u.x) + bf_hi(yf.x) + bf_hi(yr.x)));
            w.y = pk2(gelu_tanh_f(d0.z * bf_lo(u.y) + bf_lo(yf.y) + bf_lo(yr.y)), gelu_tanh_f(d0.w * bf_hi(u.y) + bf_hi(yf.y) + bf_hi(yr.y)));
            w.z = pk2(gelu_tanh_f(d1.x * bf_lo(u.z) + bf_lo(yf.z) + bf_lo(yr.z)), gelu_tanh_f(d1.y * bf_hi(u.z) + bf_hi(yf.z) + bf_hi(yr.z)));
            w.w = pk2(gelu_tanh_f(d1.z * bf_lo(u.w) + bf_lo(yf.w) + bf_lo(yr.w)), gelu_tanh_f(d1.w * bf_hi(u.w) + bf_hi(yf.w) + bf_hi(yr.w)));
            Gm[i] = w; }
    PHASE_END
    PHASE_BEGIN(7)
        pg8::Gemm g{(const bf16_t*)(ws + WS_G), (const bf16_t*)(ws + WS_WGLU), M, D, D, D}; pg8::StaticOrder S; S.init(M, D, G, bx);
        pg8::EpiGlu E{(const bf16_t*)(ws + WS_G), (bf16_t*)(ws + WS_A2), a->in[22]};
        pg8::gemm_phase<pg8::EpiGlu, true, true>(lds, g, S, E);
    PHASE_END
    PHASE_BEGIN(8)
        pg8::Gemm g{(const bf16_t*)(ws + WS_A2), (const bf16_t*)(ws + WS_WOUT), M, D, D, D}; pg8::StaticOrder S; S.init(M, D, G, bx);
        pg8::EpiResidNorm E{a->in[0], (float*)(ws + WS_X), modbuf + 2 * D, (const float*)(ws + WS_GP), (bf16_t*)(ws + WS_A0), (float*)(ws + WS_ROWSS)};
        pg8::gemm_phase<pg8::EpiResidNorm, true, true>(lds, g, S, E);
    PHASE_END
#pragma unroll
    for (int layer = 0; layer < 2; ++layer) {
        if (layer == 1) {
            PHASE_BEGIN(10)
                pg8::Gemm g{(const bf16_t*)(ws + WS_A0), (const bf16_t*)(ws + WS_SIN_W), M, SD2, D, D}; pg8::StaticOrder S; S.init(M, SD2, G, bx);
                pg8::EpiBf16<1> E{(bf16_t*)(ws + WS_ZS), SD2, (float*)(ws + WS_LNST), 16, (const float*)(ws + WS_ROWSS) + M, (const float*)(ws + WS_BIAS) + 2 * F2};
                pg8::gemm_phase<pg8::EpiBf16<1>, true, true>(lds, g, S, E);
            PHASE_END
            PHASE_BEGIN(11)
                spatial_phase(a, lds, bx, G);
            PHASE_END
            PHASE_BEGIN(12)
                pg8::Gemm g{(const bf16_t*)(ws + WS_GT), (const bf16_t*)(ws + WS_SOUT_W), M, D, SD, SD}; pg8::StaticOrder S; S.init(M, D, G, bx);
                pg8::EpiResidNorm E{(const float*)(ws + WS_X), (float*)(ws + WS_X), modbuf + 3 * D6 + 2 * D, (const float*)(ws + WS_GP) + 2 * NB * D, (bf16_t*)(ws + WS_A0), (float*)(ws + WS_ROWSS) + 2 * M};
                pg8::gemm_phase<pg8::EpiResidNorm, true, true>(lds, g, S, E);
            PHASE_END
        }
        PHASE_BEGIN(14)
            pg8::Gemm g{(const bf16_t*)(ws + WS_A0), (const bf16_t*)(ws + (layer ? WS_UP1 : WS_UP0)), M, F2, D, D}; pg8::StaticOrder S; S.init(M, F2, G, bx);
            pg8::EpiBf16<0> E{(bf16_t*)(ws + WS_Z), F2, nullptr, 1 << 30, (const float*)(ws + WS_ROWSS) + (layer ? 2 * M : 0), (const float*)(ws + WS_BIAS) + (layer ? 4 * F2 : 0)};
            pg8::gemm_phase<pg8::EpiBf16<0>, true, true>(lds, g, S, E);
            if (bx >= 128) { __syncthreads();
                if (layer == 0) p0_transpose_all<0>(a, lds, TRC_END - 512 + (bx - 128), G - 128, TRC_END); else p0_transpose_all<0>(a, lds, TRC_DN1_B + (bx - 128), G - 128, TRC_DN1_E); }
        PHASE_END
        PHASE_BEGIN(15)
            conv_phase(a, lds, layer, bx, G);
        PHASE_END
        PHASE_BEGIN(16)
            pg8::Gemm g{(const bf16_t*)(ws + WS_A3), (const bf16_t*)(ws + (layer ? WS_DN1 : WS_DN0)), M, D, FF, FF}; pg8::StaticOrder S; S.init(M, D, G, bx);
            if (layer == 0) { pg8::EpiResidNorm E{(const float*)(ws + WS_X), (float*)(ws + WS_X), modbuf + 5 * D, (const float*)(ws + WS_GP) + NB * D, (bf16_t*)(ws + WS_A0), (float*)(ws + WS_ROWSS) + M};
                pg8::gemm_phase<pg8::EpiResidNorm, true, true>(lds, g, S, E); }
            else { pg8::EpiResid E{(const float*)(ws + WS_X), (float*)(ws + WS_X), modbuf + 3 * D6 + 5 * D, (float*)(ws + WS_ROWSS) + 3 * M};
                pg8::gemm_phase<pg8::EpiResid, true, true>(lds, g, S, E); }
        PHASE_END
    }
    PHASE_BEGIN(17)
        { const f32x4* xp = (const f32x4*)(ws + WS_X); const float* rs = (const float*)(ws + WS_ROWSS) + 3 * M; const f32x4* gp = (const f32x4*)a->in[30]; f32x4* op = (f32x4*)a->out;
#pragma unroll 8
          for (int i = bx * NTHREADS + t; i < M * (D / 4); i += G * NTHREADS) { const float rstd = __builtin_amdgcn_rsqf(rs[i >> 9] * (1.f / D) + 1e-6f); op[i] = __builtin_nontemporal_load(xp + i) * rstd * gp[i & 511]; } }
        if (PROBE_MASK) { GRID_SYNC(); }
    PHASE_END
    if (PROBE_MASK) {
        CArgsP a = get_args(); unsigned char* ws = a->ws; const int t = tid_opaque(), bx = blockIdx.x, G = gridDim.x;
        if ((PROBE_MASK >> 20) & 1u) {
            unsigned long long t0 = 0; if (bx == 0 && t == 0) t0 = __builtin_amdgcn_s_memrealtime();
            f32x4 acc4 = {0.f, 0.f, 0.f, 0.f}; const f32x4* xp = (const f32x4*)(ws + WS_X);
#pragma unroll 8
            for (int i = bx * NTHREADS + t; i < M * (D / 4); i += G * NTHREADS) acc4 += xp[i];
            ((float*)(ws + WS_PROBE + 65536))[bx * NTHREADS + t] = acc4.x + acc4.y + acc4.z + acc4.w;
            GRID_SYNC();
            if (bx == 0 && t == 0) *(volatile unsigned long long*)(ws + WS_PROBE) += __builtin_amdgcn_s_memrealtime() - t0;
        }
        if ((PROBE_MASK >> 21) & 1u) {
            unsigned long long t0 = 0; if (bx == 0 && t == 0) t0 = __builtin_amdgcn_s_memrealtime();
            f32x4* zp = (f32x4*)(ws + WS_ZS); const f32x4 v = {1.f, 2.f, 3.f, (float)t};
#pragma unroll 8
            for (int i = bx * NTHREADS + t; i < M * (D / 4); i += G * NTHREADS) zp[i] = v;
            GRID_SYNC();
            if (bx == 0 && t == 0) *(volatile unsigned long long*)(ws + WS_PROBE) += __builtin_amdgcn_s_memrealtime() - t0;
        }
        if ((PROBE_MASK >> 22) & 1u) {
            unsigned long long t0 = 0; if (bx == 0 && t == 0) t0 = __builtin_amdgcn_s_memrealtime();
            f32x4* zp = (f32x4*)(ws + WS_ZS); const f32x4* xp = (const f32x4*)(ws + WS_X);
#pragma unroll 8
            for (int i = bx * NTHREADS + t; i < M * (D / 4); i += G * NTHREADS) zp[i] = xp[i];
            GRID_SYNC();
            if (bx == 0 && t == 0) *(volatile unsigned long long*)(ws + WS_PROBE) += __builtin_amdgcn_s_memrealtime() - t0;
        }
        if ((PROBE_MASK >> 19) & 1u) {
            unsigned long long t0 = 0; if (bx == 0 && t == 0) t0 = __builtin_amdgcn_s_memrealtime();
            for (int i = 0; i < 10; ++i) { GRID_SYNC(); }
            if (bx == 0 && t == 0) *(volatile unsigned long long*)(ws + WS_PROBE) += __builtin_amdgcn_s_memrealtime() - t0;
        }
        if ((PROBE_MASK >> 18) & 1u) { if (bx == 0 && t == 0) *(volatile unsigned long long*)(ws + WS_PROBE) += __builtin_amdgcn_s_memrealtime() - t_entry; }
        grid.sync();
        const unsigned long long tk = *(volatile unsigned long long*)(ws + WS_PROBE); const float pd = sqrtf((float)tk * 1e-10f);
        for (int i = bx * NTHREADS + t; i < M * (D / 4); i += G * NTHREADS) { f32x4 y = ((f32x4*)a->out)[i]; y.x += pd; y.y -= pd; y.z += pd; y.w -= pd; ((f32x4*)a->out)[i] = y; }
    }
}
constexpr int N_PHASES = 19;

extern "C" void kernel_launch(void* const* d_in, const int* in_sizes, int n_in, void* d_out, int out_size, void* d_ws, size_t ws_size, hipStream_t stream) {
    static int grid = 0;
    if (grid == 0) {
        if (n_in != 31 || out_size != M * D || ws_size < WS_END) { fprintf(stderr, "kernel_launch: unexpected shapes (n_in %d out %d ws %zu need %zu)\n", n_in, out_size, ws_size, (size_t)WS_END); grid = -1; return; }
        int dev = 0, cus = 0, per_cu = 0;
        hipGetDevice(&dev); hipDeviceGetAttribute(&cus, hipDeviceAttributeMultiprocessorCount, dev);
        if (hipFuncSetAttribute((const void*)fwd_kernel, hipFuncAttributeMaxDynamicSharedMemorySize, LDS_BYTES) != hipSuccess) { fprintf(stderr, "kernel_launch: hipFuncSetAttribute failed\n"); grid = -1; return; }
        if (hipOccupancyMaxActiveBlocksPerMultiprocessor(&per_cu, (const void*)fwd_kernel, NTHREADS, LDS_BYTES) != hipSuccess || per_cu < 1) { fprintf(stderr, "kernel_launch: occupancy query gave %d\n", per_cu); per_cu = 1; }
        (void)hipGetLastError();
        grid = cus * 1;
    }
    if (grid < 0) return;
    Args a{};
    for (int i = 0; i < 31; ++i) a.in[i] = (const float*)d_in[i];
    a.out = (float*)d_out; a.ws = (unsigned char*)d_ws; a.ph_lo = 0; a.ph_hi = N_PHASES;
    void* args[] = {&a};
    hipError_t e = hipLaunchCooperativeKernel((const void*)fwd_kernel, dim3(grid), dim3(NTHREADS), args, LDS_BYTES, stream);
    if (e != hipSuccess) fprintf(stderr, "kernel_launch: cooperative launch failed: %s (grid %d)\n", hipGetErrorString(e), grid);
}
```
